# Optimizing an MI355X kernel written in HIP

```python
import jax, jax.numpy as jnp
from jax import lax
import numpy as np

D_MODEL = 1024
BATCH = 4
SEQ = 8192
DEPTH = 1

GDN_HEADS = 4
GDN_DK = 128
GDN_DV = 128
CONV_K = 4
GLA_HEADS = 4
GLA_DK = 64
GLA_DV = 128
GLA_RANK = 16
GLA_NORMALIZER = 16.0
CHUNK = 64
D_FF = 2816
ALPHA = (2.0 * DEPTH) ** 0.25
INIT_BETA = (8.0 * DEPTH) ** -0.25
LN_EPS = 1e-5
RMS_EPS = 1e-6

GDN_QK_W = GDN_HEADS * GDN_DK
GDN_V_W = GDN_HEADS * GDN_DV
GLA_QK_W = GLA_HEADS * GLA_DK
GLA_V_W = GLA_HEADS * GLA_DV
MIX_W = GDN_V_W + GLA_V_W
CONV_CH = 2 * GDN_QK_W + GDN_V_W
PROJ_SPLITS = (CONV_CH, GDN_V_W, GDN_HEADS, GDN_HEADS, GLA_QK_W, GLA_QK_W, GLA_V_W, GLA_V_W, GLA_RANK)
PROJ_DIM = sum(PROJ_SPLITS)

kernel_name = "hybrid_gdn_gla_macaron_deepnorm"


def _split_points(sizes):
    pts, acc = [], 0
    for s in sizes[:-1]:
        acc += s
        pts.append(acc)
    return pts


def _layer_norm(x, g, b):
    xf = x.astype(jnp.float32)
    mu = jnp.mean(xf, -1, keepdims=True)
    var = jnp.mean(jnp.square(xf - mu), -1, keepdims=True)
    return ((xf - mu) * lax.rsqrt(var + LN_EPS) * g + b).astype(x.dtype)


def _swiglu(x, w_gate, w_up, w_down):
    return (jax.nn.silu(x @ w_gate) * (x @ w_up)) @ w_down


def _causal_conv(x, w):
    return lax.conv_general_dilated(
        x, w[:, None, :].astype(x.dtype), window_strides=(1,), padding=((CONV_K - 1, 0),),
        dimension_numbers=("NWC", "WIO", "NWC"), feature_group_count=x.shape[-1])


def _l2norm(x):
    return x * lax.rsqrt(jnp.sum(jnp.square(x), -1, keepdims=True) + RMS_EPS)


def _gated_rmsnorm(o, gate, w):
    o = o * lax.rsqrt(jnp.mean(jnp.square(o), -1, keepdims=True) + RMS_EPS) * w
    return o * jax.nn.silu(gate)


def _to_chunks(t):
    b, l, h, d = t.shape
    return t.reshape(b, l // CHUNK, CHUNK, h, d).transpose(0, 3, 1, 2, 4)


def _scalars_to_chunks(t):
    b, l, h = t.shape
    return t.reshape(b, l // CHUNK, CHUNK, h).transpose(0, 3, 1, 2)


def _from_scan(o):
    n, b, h, c, d = o.shape
    return o.transpose(1, 0, 3, 2, 4).reshape(b, n * c, h, d)


def _gated_delta_rule(q, k, v, beta, g):
    dv = v.shape[-1]
    q = q * (GDN_DK ** -0.5)
    G = jnp.cumsum(g, axis=-1)
    causal = jnp.tril(jnp.ones((CHUNK, CHUNK), bool))
    strict = jnp.tril(jnp.ones((CHUNK, CHUNK), bool), -1)
    decay = jnp.exp(jnp.where(causal, G[..., :, None] - G[..., None, :], -jnp.inf))
    kk = jnp.einsum("bhncd,bhnsd->bhncs", k, k)
    a_low = jnp.where(strict, beta[..., None] * kk * decay, 0.0)
    eye = jnp.eye(CHUNK, dtype=q.dtype)
    rhs = jnp.concatenate([v * beta[..., None], k * (beta * jnp.exp(G))[..., None]], -1)
    sol = lax.linalg.triangular_solve(a_low + eye, rhs, left_side=True, lower=True,
                                      unit_diagonal=True)
    u, w = sol[..., :dv], sol[..., dv:]
    qk = jnp.einsum("bhncd,bhnsd->bhncs", q, k) * decay
    q_dec = q * jnp.exp(G)[..., None]
    k_dec = k * jnp.exp(G[..., -1:] - G)[..., None]
    g_last = jnp.exp(G[..., -1])

    def step(S, xs):
        u_c, w_c, qk_c, qd_c, kd_c, gl_c = xs
        v_new = u_c - jnp.einsum("bhcd,bhde->bhce", w_c, S)
        o = jnp.einsum("bhcd,bhde->bhce", qd_c, S) + jnp.einsum("bhcs,bhse->bhce", qk_c, v_new)
        S = S * gl_c[..., None, None] + jnp.einsum("bhcd,bhce->bhde", kd_c, v_new)
        return S, o

    xs = tuple(jnp.moveaxis(t, 2, 0) for t in (u, w, qk, q_dec, k_dec, g_last))
    b, h = q.shape[0], q.shape[1]
    S0 = jnp.zeros((b, h, GDN_DK, dv), q.dtype)
    _, o = lax.scan(step, S0, xs)
    return _from_scan(o)


def _gla(q, k, v, logg):
    dv = v.shape[-1]
    q = q * (GLA_DK ** -0.5)
    bcum = jnp.cumsum(logg, axis=-2)
    causal = jnp.tril(jnp.ones((CHUNK, CHUNK), bool))[..., None]

    def step(S, xs):
        q_c, k_c, v_c, b_c = xs
        diff = b_c[:, :, :, None, :] - b_c[:, :, None, :, :]
        dec = jnp.exp(jnp.where(causal, diff, -jnp.inf))
        att = jnp.einsum("bhik,bhjk,bhijk->bhij", q_c, k_c, dec)
        o = jnp.einsum("bhik,bhkv->bhiv", q_c * jnp.exp(b_c), S) + jnp.einsum("bhij,bhjv->bhiv", att, v_c)
        b_last = b_c[:, :, -1]
        S = S * jnp.exp(b_last)[..., None] + jnp.einsum(
            "bhjk,bhjv->bhkv", k_c * jnp.exp(b_last[:, :, None] - b_c), v_c)
        return S, o

    xs = tuple(jnp.moveaxis(t, 2, 0) for t in (q, k, v, bcum))
    b, h = q.shape[0], q.shape[1]
    S0 = jnp.zeros((b, h, GLA_DK, dv), q.dtype)
    _, o = lax.scan(step, S0, xs)
    return _from_scan(o)


def _token_mixer(h, w_in, conv_w, a_log, dt_bias, gdn_norm_w, w_gk, b_gk, gla_norm_w, w_out):
    bsz, l, _ = h.shape
    f32 = jnp.float32
    proj = h @ w_in
    qkv_a, z_a, beta_a, dec_a, q_b, k_b, v_b, g_b, lr_b = jnp.split(proj, _split_points(PROJ_SPLITS), -1)

    qkv = jax.nn.silu(_causal_conv(qkv_a, conv_w)).astype(f32)
    q_a, k_a, v_a = jnp.split(qkv, [GDN_QK_W, 2 * GDN_QK_W], -1)
    q_a = _l2norm(q_a.reshape(bsz, l, GDN_HEADS, GDN_DK))
    k_a = _l2norm(k_a.reshape(bsz, l, GDN_HEADS, GDN_DK))
    v_a = v_a.reshape(bsz, l, GDN_HEADS, GDN_DV)
    beta = jax.nn.sigmoid(beta_a.astype(f32))
    g = -jnp.exp(a_log.astype(f32)) * jax.nn.softplus(dec_a.astype(f32) + dt_bias.astype(f32))
    o_a = _gated_delta_rule(_to_chunks(q_a), _to_chunks(k_a), _to_chunks(v_a),
                            _scalars_to_chunks(beta), _scalars_to_chunks(g))
    o_a = _gated_rmsnorm(o_a, z_a.astype(f32).reshape(bsz, l, GDN_HEADS, GDN_DV),
                         gdn_norm_w.astype(f32)).reshape(bsz, l, GDN_V_W)

    logg = jax.nn.log_sigmoid((lr_b @ w_gk + b_gk).astype(f32)) / GLA_NORMALIZER
    q_b = q_b.astype(f32).reshape(bsz, l, GLA_HEADS, GLA_DK)
    k_b = k_b.astype(f32).reshape(bsz, l, GLA_HEADS, GLA_DK)
    v_b = v_b.astype(f32).reshape(bsz, l, GLA_HEADS, GLA_DV)
    logg = logg.reshape(bsz, l, GLA_HEADS, GLA_DK)
    o_b = _gla(_to_chunks(q_b), _to_chunks(k_b), _to_chunks(v_b), _to_chunks(logg))
    o_b = _gated_rmsnorm(o_b, g_b.astype(f32).reshape(bsz, l, GLA_HEADS, GLA_DV),
                         gla_norm_w.astype(f32)).reshape(bsz, l, GLA_V_W)

    mix = jnp.concatenate([o_a, o_b], -1).astype(h.dtype)
    return mix @ w_out


def setup_inputs(seed: int = 0) -> dict:
    key = jax.random.key(seed)
    ks = jax.random.split(key, 24)
    nrm = lambda k, shape, s: jax.random.normal(k, shape, jnp.float32) * s
    x = jax.random.normal(ks[0], (BATCH, SEQ, D_MODEL), jnp.float32)

    col_scale = jnp.concatenate([
        jnp.ones((2 * GDN_QK_W,)), jnp.full((GDN_V_W,), INIT_BETA), jnp.ones((GDN_V_W + 2 * GDN_HEADS,)),
        jnp.ones((2 * GLA_QK_W,)), jnp.full((GLA_V_W,), INIT_BETA), jnp.ones((GLA_V_W + GLA_RANK,))])
    w_in = nrm(ks[1], (DEPTH, D_MODEL, PROJ_DIM), D_MODEL ** -0.5) * col_scale
    conv_w = nrm(ks[2], (DEPTH, CONV_K, CONV_CH), CONV_K ** -0.5)
    a_log = jnp.log(jax.random.uniform(ks[3], (DEPTH, GDN_HEADS), jnp.float32, 1.0, 16.0))
    dt = jnp.exp(jax.random.uniform(ks[4], (DEPTH, GDN_HEADS), jnp.float32, np.log(1e-3), np.log(1e-1)))
    dt_bias = dt + jnp.log(-jnp.expm1(-dt))
    gdn_norm_w = 1.0 + nrm(ks[5], (DEPTH, GDN_DV), 0.02)
    w_gk = nrm(ks[6], (DEPTH, GLA_RANK, GLA_QK_W), GLA_RANK ** -0.5)
    b_gk = nrm(ks[7], (DEPTH, GLA_QK_W), 0.1)
    gla_norm_w = 1.0 + nrm(ks[8], (DEPTH, GLA_DV), 0.02)
    w_out = nrm(ks[9], (DEPTH, MIX_W, D_MODEL), MIX_W ** -0.5 * INIT_BETA)

    def ffn(k):
        k1, k2, k3 = jax.random.split(k, 3)
        return (nrm(k1, (DEPTH, D_MODEL, D_FF), D_MODEL ** -0.5),
                nrm(k2, (DEPTH, D_MODEL, D_FF), D_MODEL ** -0.5 * INIT_BETA),
                nrm(k3, (DEPTH, D_FF, D_MODEL), D_FF ** -0.5 * INIT_BETA))

    f1g, f1u, f1d = ffn(ks[10])
    f2g, f2u, f2d = ffn(ks[11])
    ln = lambda kg, kb: (1.0 + nrm(kg, (DEPTH, D_MODEL), 0.02), nrm(kb, (DEPTH, D_MODEL), 0.02))
    ln1_g, ln1_b = ln(ks[12], ks[13])
    ln2_g, ln2_b = ln(ks[14], ks[15])
    ln3_g, ln3_b = ln(ks[16], ks[17])
    return {"x": x,
            "ffn1_w_gate": f1g, "ffn1_w_up": f1u, "ffn1_w_down": f1d, "ln1_g": ln1_g, "ln1_b": ln1_b,
            "w_in": w_in, "conv_w": conv_w, "a_log": a_log, "dt_bias": dt_bias, "gdn_norm_w": gdn_norm_w,
            "w_gk": w_gk, "b_gk": b_gk, "gla_norm_w": gla_norm_w, "w_out": w_out,
            "ln2_g": ln2_g, "ln2_b": ln2_b,
            "ffn2_w_gate": f2g, "ffn2_w_up": f2u, "ffn2_w_down": f2d, "ln3_g": ln3_g, "ln3_b": ln3_b}


def reference(x, ffn1_w_gate, ffn1_w_up, ffn1_w_down, ln1_g, ln1_b,
              w_in, conv_w, a_log, dt_bias, gdn_norm_w, w_gk, b_gk, gla_norm_w, w_out,
              ln2_g, ln2_b, ffn2_w_gate, ffn2_w_up, ffn2_w_down, ln3_g, ln3_b):
    for i in range(DEPTH):
        x = _layer_norm(ALPHA * x + 0.5 * _swiglu(x, ffn1_w_gate[i], ffn1_w_up[i], ffn1_w_down[i]),
                        ln1_g[i], ln1_b[i])
        mix = _token_mixer(x, w_in[i], conv_w[i], a_log[i], dt_bias[i], gdn_norm_w[i],
                           w_gk[i], b_gk[i], gla_norm_w[i], w_out[i])
        x = _layer_norm(ALPHA * x + mix, ln2_g[i], ln2_b[i])
        x = _layer_norm(ALPHA * x + 0.5 * _swiglu(x, ffn2_w_gate[i], ffn2_w_up[i], ffn2_w_down[i]),
                        ln3_g[i], ln3_b[i])
    return x
```

```cpp
#include <hip/hip_runtime.h>
#include <hip/hip_cooperative_groups.h>
#include <cstdio>
#include <cstdint>
namespace cg = cooperative_groups;
namespace pg8 {
#define PG8_LAS __attribute__((address_space(3)))
typedef unsigned short bf16_t;
typedef short bf16x8 __attribute__((ext_vector_type(8)));
typedef float f32x4 __attribute__((ext_vector_type(4)));
typedef unsigned u32x4 __attribute__((ext_vector_type(4)));
constexpr int BM = 256, BK = 64, HALF = 128, HTB = HALF * BK * 2  , STAGE_BYTES = 8 * HTB, NXCD = 8, WGM = 8;

__host__ __device__ __forceinline__ int lds_byte(int r, int c) { const int st = (r >> 4) * 2 + (c >> 5), rr = r & 15, cc = c & 31, ob = rr * 64 + cc * 2; return st * 1024 + (ob ^ (((ob >> 9) & 1) << 5)); }
__host__ __device__ __forceinline__ void stage_rc(int b, int& R, int& C) { const int st = b / 1024, sb = b % 1024, swz = sb ^ (((sb >> 9) & 1) << 5); R = (st >> 1) * 16 + swz / 64; C = (st & 1) * 32 + (swz % 64) / 2; }
__host__ __device__ __forceinline__ int perm32(int rho) { const int n = rho >> 4, i = rho & 15; return 8 * (i >> 2) + 4 * n + (i & 3); }

struct Unit { int pm, pn; };
struct Gemm { const bf16_t* A; const bf16_t* Bt; int M, N, K; };

struct StaticOrder {
    int nM, nN, nwg, G, c;
    __host__ __device__ void init(int M, int N, int G_, int c_) { nM = M / BM; nN = N / BM; nwg = nM * nN; G = G_; c = c_; }
    __host__ __device__ bool next(int i, Unit& u) const {
        const long L = (long)i * G + c; if (L >= nwg) return false;
        int wgid = (int)L; { const int q = nwg / NXCD, r = nwg % NXCD, xcd = wgid % NXCD, off = wgid / NXCD; wgid = (xcd < r ? xcd * (q + 1) : r * (q + 1) + (xcd - r) * q) + off; }
        const int nig = WGM * nN, gid = wgid / nig, fm = gid * WGM, gsz = (nM - fm) < WGM ? (nM - fm) : WGM;
        u.pm = fm + ((wgid % nig) % gsz); u.pn = (wgid % nig) / gsz; return true;
    }
    __device__ __forceinline__ void a_ready(const Unit&) const {}
    __device__ __forceinline__ void done(const Unit&) const {}
};

__device__ __forceinline__ unsigned cvt_pk_bf16(float lo, float hi) { unsigned r; asm volatile("v_cvt_pk_bf16_f32 %0, %1, %2" : "=v"(r) : "v"(lo), "v"(hi)); return r; }
typedef float f32x2 __attribute__((ext_vector_type(2)));
template <class Epi, class Sched, bool ALIGN_EPI = false, bool SP2 = false>
__device__ __forceinline__ void gemm_phase(PG8_LAS unsigned char* lds, const Gemm g, const Sched& S, const Epi& E) {
    const int tid = threadIdx.x, wid = __builtin_amdgcn_readfirstlane(tid >> 6), lane = tid & 63, wr = wid >> 2, wc = wid & 3, fr = lane & 15, fq = lane >> 4;
    const int K = g.K, nt = K / BK;
    unsigned voffA[2], voffB[2];
#pragma unroll
    for (int i = 0; i < 2; ++i) { int R, C; stage_rc(tid * 16 + i * 8192, R, C); const int Rb = Epi::PERM ? ((R & ~31) + perm32(R & 31)) : R;
        voffA[i] = (unsigned)(R * K + C) * 2u; voffB[i] = (unsigned)(Rb * K + C) * 2u; }
    const size_t kstep = (size_t)(BK * 2);
    const size_t hstep = (size_t)HALF * K * 2;
    const size_t tstep = 2 * hstep;
    const unsigned ldsw = (unsigned)wid * 1024u;
    const int aoff = lds_byte(wr * 64 + fr, fq * 8), boff = lds_byte(wc * 32 + fr, fq * 8);
#define PG8_SA(b, h) (((b) * 2 + (h)) * HTB)
#define PG8_SB(b, h) ((4 + (b) * 2 + (h)) * HTB)
#define PG8_STAGE(bufoff, gbase, voff) do { _Pragma("unroll") for (int _i = 0; _i < 2; ++_i) \
        __builtin_amdgcn_global_load_lds((const unsigned*)((const char*)(gbase) + (voff)[_i]), (PG8_LAS unsigned*)(lds + (bufoff) + ldsw + _i * 8192), 16, 0, 0); } while (0)
#define PG8_LDA(dst, b, h) do { _Pragma("unroll") for (int m = 0; m < 4; ++m) _Pragma("unroll") for (int k = 0; k < 2; ++k) dst[m][k] = *(const PG8_LAS bf16x8*)(lds + PG8_SA(b, h) + aoff + m * 2048 + k * 1024); } while (0)
#define PG8_LDB(dst, b, h) do { _Pragma("unroll") for (int n = 0; n < 2; ++n) _Pragma("unroll") for (int k = 0; k < 2; ++k) dst[n][k] = *(const PG8_LAS bf16x8*)(lds + PG8_SB(b, h) + boff + n * 2048 + k * 1024); } while (0)
#define PG8_MMA(ai, bj, At, Bt) do { __builtin_amdgcn_s_setprio(1); _Pragma("unroll") for (int m = 0; m < 4; ++m) _Pragma("unroll") for (int n = 0; n < 2; ++n) _Pragma("unroll") for (int k = 0; k < 2; ++k) \
        acc[ai][bj][m][n] = __builtin_amdgcn_mfma_f32_16x16x32_bf16(Bt[n][k], At[m][k], acc[ai][bj][m][n], 0, 0, 0); __builtin_amdgcn_s_setprio(0); } while (0)
#define PG8_WAIT_V(n) asm volatile("s_waitcnt vmcnt(" #n ")" ::: "memory")
#define PG8_WAIT_L(n) asm volatile("s_waitcnt lgkmcnt(" #n ")" ::: "memory")
#define PG8_BAR __builtin_amdgcn_s_barrier()
#define PG8_SCHED __builtin_amdgcn_sched_barrier(0)
    Unit cur, nxt; int ui = 0;
    if (!S.next(0, cur)) return;
    f32x4 acc[2][2][4][2];
#pragma unroll
    for (int a = 0; a < 2; ++a)
#pragma unroll
        for (int b = 0; b < 2; ++b)
#pragma unroll
            for (int m = 0; m < 4; ++m)
#pragma unroll
                for (int n = 0; n < 2; ++n) acc[a][b][m][n] = (f32x4){0.f, 0.f, 0.f, 0.f};
    bf16x8 At[4][2], B0[2][2], B1[2][2];
    const char* cA = (const char*)g.A + (size_t)cur.pm * tstep; const char* cB = (const char*)g.Bt + (size_t)cur.pn * tstep;
    S.a_ready(cur);
    if constexpr (SP2) {
        PG8_STAGE(PG8_SB(0, 0), cB, voffB); PG8_STAGE(PG8_SB(0, 1), cB + hstep, voffB); PG8_STAGE(PG8_SA(0, 0), cA, voffA); PG8_STAGE(PG8_SA(0, 1), cA + hstep, voffA);
        if (wr == 1) PG8_BAR;
        PG8_WAIT_V(2); PG8_BAR;
        PG8_STAGE(PG8_SB(1, 0), cB + kstep, voffB); PG8_STAGE(PG8_SA(1, 0), cA + kstep, voffA); PG8_STAGE(PG8_SB(1, 1), cB + hstep + kstep, voffB);
        PG8_WAIT_V(6); PG8_BAR;
    } else {
        PG8_STAGE(PG8_SB(0, 0), cB, voffB); PG8_STAGE(PG8_SA(0, 0), cA, voffA); PG8_STAGE(PG8_SB(0, 1), cB + hstep, voffB); PG8_STAGE(PG8_SA(0, 1), cA + hstep, voffA);
        if (wr == 1) PG8_BAR;
        PG8_WAIT_V(4); PG8_BAR;
        PG8_STAGE(PG8_SB(1, 0), cB + kstep, voffB); PG8_STAGE(PG8_SA(1, 0), cA + kstep, voffA); PG8_STAGE(PG8_SB(1, 1), cB + hstep + kstep, voffB);
        PG8_WAIT_V(6); PG8_BAR;
    }
    for (;;) {
        const bool has_next = S.next(ui + 1, nxt);
        const char* nA = has_next ? (const char*)g.A + (size_t)nxt.pm * tstep : cA; const char* nB = has_next ? (const char*)g.Bt + (size_t)nxt.pn * tstep : cB;
        for (int t = 0; t < nt; t += 2) {
            const bool last = (t == nt - 2);
            const char* a1 = cA + (size_t)(t + 1) * kstep;
            const char* a2 = last ? nA : cA + (size_t)(t + 2) * kstep; const char* b2 = last ? nB : cB + (size_t)(t + 2) * kstep;
            const char* a3 = a2 + kstep; const char* b3 = b2 + kstep;
            if (last && has_next) S.a_ready(nxt);
            if constexpr (SP2) {
            PG8_LDB(B0, 0, 0); PG8_LDB(B1, 0, 1); PG8_SCHED; PG8_LDA(At, 0, 0); PG8_STAGE(PG8_SA(1, 1), a1 + hstep, voffA);
            PG8_WAIT_V(8); PG8_WAIT_L(0); PG8_BAR; PG8_MMA(0, 0, At, B0); PG8_MMA(0, 1, At, B1); PG8_BAR; PG8_SCHED;
            PG8_LDA(At, 0, 1); PG8_STAGE(PG8_SB(0, 0), b2, voffB); PG8_STAGE(PG8_SB(0, 1), b2 + hstep, voffB); PG8_STAGE(PG8_SA(0, 0), a2, voffA);
            PG8_WAIT_V(8); PG8_WAIT_L(0); PG8_BAR; PG8_MMA(1, 0, At, B0); PG8_MMA(1, 1, At, B1); PG8_BAR; PG8_SCHED;
            PG8_LDB(B0, 1, 0); PG8_LDB(B1, 1, 1); PG8_SCHED; PG8_LDA(At, 1, 0); PG8_STAGE(PG8_SA(0, 1), a2 + hstep, voffA);
            PG8_WAIT_V(8); PG8_WAIT_L(0); PG8_BAR; PG8_MMA(0, 0, At, B0); PG8_MMA(0, 1, At, B1); PG8_BAR; PG8_SCHED;
            PG8_LDA(At, 1, 1); PG8_STAGE(PG8_SB(1, 0), b3, voffB); PG8_STAGE(PG8_SB(1, 1), b3 + hstep, voffB); PG8_STAGE(PG8_SA(1, 0), a3, voffA);
            PG8_WAIT_V(8); PG8_WAIT_L(0); PG8_BAR; PG8_MMA(1, 0, At, B0); PG8_MMA(1, 1, At, B1); PG8_BAR; PG8_SCHED;
            } else {
            PG8_LDB(B0, 0, 0); PG8_SCHED; PG8_LDA(At, 0, 0); PG8_STAGE(PG8_SA(1, 1), a1 + hstep, voffA);
            PG8_WAIT_L(8); PG8_BAR; PG8_WAIT_L(0); PG8_MMA(0, 0, At, B0); PG8_BAR; PG8_SCHED;
            PG8_LDB(B1, 0, 1); PG8_STAGE(PG8_SB(0, 0), b2, voffB);
            PG8_BAR; PG8_WAIT_L(0); PG8_MMA(0, 1, At, B1); PG8_BAR;
            PG8_LDA(At, 0, 1); PG8_STAGE(PG8_SA(0, 0), a2, voffA);
            PG8_BAR; PG8_WAIT_L(0); PG8_MMA(1, 0, At, B0); PG8_BAR; PG8_SCHED;
            PG8_STAGE(PG8_SB(0, 1), b2 + hstep, voffB);
            PG8_WAIT_V(6); PG8_BAR; PG8_MMA(1, 1, At, B1); PG8_BAR;
            PG8_LDB(B0, 1, 0); PG8_SCHED; PG8_LDA(At, 1, 0); PG8_STAGE(PG8_SA(0, 1), a2 + hstep, voffA);
            PG8_WAIT_L(8); PG8_BAR; PG8_WAIT_L(0); PG8_MMA(0, 0, At, B0); PG8_BAR; PG8_SCHED;
            PG8_LDB(B1, 1, 1); PG8_STAGE(PG8_SB(1, 0), b3, voffB);
            PG8_BAR; PG8_WAIT_L(0); PG8_MMA(0, 1, At, B1); PG8_BAR;
            PG8_LDA(At, 1, 1); PG8_STAGE(PG8_SA(1, 0), a3, voffA);
            PG8_BAR; PG8_WAIT_L(0); PG8_MMA(1, 0, At, B0); PG8_BAR; PG8_SCHED;
            PG8_STAGE(PG8_SB(1, 1), b3 + hstep, voffB);
            PG8_WAIT_V(6); PG8_BAR; PG8_MMA(1, 1, At, B1); PG8_BAR;
            }
        }
        if constexpr (ALIGN_EPI) { if (wr == 0) PG8_BAR; }
        if constexpr (!Epi::AFTER_DRAIN) { E(acc, cur, wr, wc, fr, fq); S.done(cur); }
        if (!has_next) break;
#pragma unroll
        for (int a = 0; a < 2; ++a)
#pragma unroll
            for (int b = 0; b < 2; ++b)
#pragma unroll
                for (int m = 0; m < 4; ++m)
#pragma unroll
                    for (int n = 0; n < 2; ++n) acc[a][b][m][n] = (f32x4){0.f, 0.f, 0.f, 0.f};
        cur = nxt; cA = nA; cB = nB; ++ui;
        if constexpr (ALIGN_EPI) { if (wr == 1) PG8_BAR; }
    }
    PG8_WAIT_V(0);
    if constexpr (!ALIGN_EPI) { if (wr == 0) PG8_BAR; }
    PG8_BAR;
    if constexpr (Epi::AFTER_DRAIN) { E.fused(acc, cur, wr, wc, fr, fq, lds, wid, lane); S.done(cur); }
#undef PG8_SA
#undef PG8_SB
#undef PG8_STAGE
#undef PG8_LDA
#undef PG8_LDB
#undef PG8_MMA
#undef PG8_WAIT_V
#undef PG8_WAIT_L
#undef PG8_BAR
#undef PG8_SCHED
}
}

namespace pg8 {
__device__ __forceinline__ float silu_f(float x) { return x * __builtin_amdgcn_rcpf(1.0f + __expf(-x)); }
__device__ __forceinline__ float bflo_f(unsigned u) { return __uint_as_float(u << 16); }
__device__ __forceinline__ float bfhi_f(unsigned u) { return __uint_as_float(u & 0xffff0000u); }

struct EpiSwiglu {
    static constexpr bool PERM = true, AFTER_DRAIN = false;
    bf16_t* O; int ldc;
    __device__ __forceinline__ void operator()(const f32x4 (&acc)[2][2][4][2], const Unit& u, int wr, int wc, int fr, int fq) const {
        const int row0 = u.pm * BM + wr * 64 + fr, col0 = u.pn * HALF + wc * 32 + 8 * fq;
#pragma unroll
        for (int ai = 0; ai < 2; ++ai)
#pragma unroll
            for (int m = 0; m < 4; ++m) {
                bf16_t* rowp = O + (size_t)(row0 + ai * HALF + m * 16) * ldc + col0;
                const f32x4 g0 = acc[ai][0][m][0], g1 = acc[ai][0][m][1], u0 = acc[ai][1][m][0], u1 = acc[ai][1][m][1];
                u32x4 w;
                w.x = cvt_pk_bf16(silu_f(g0[0]) * u0[0], silu_f(g0[1]) * u0[1]);
                w.y = cvt_pk_bf16(silu_f(g0[2]) * u0[2], silu_f(g0[3]) * u0[3]);
                w.z = cvt_pk_bf16(silu_f(g1[0]) * u1[0], silu_f(g1[1]) * u1[1]);
                w.w = cvt_pk_bf16(silu_f(g1[2]) * u1[2], silu_f(g1[3]) * u1[3]);
                *(u32x4*)rowp = w;
            }
    }
};

template <bool RES_BF16> struct EpiRes {
    static constexpr bool PERM = true, AFTER_DRAIN = false;
    const void* res; float* out; float alpha, scale;
    __device__ __forceinline__ void operator()(const f32x4 (&acc)[2][2][4][2], const Unit& u, int wr, int wc, int fr, int fq) const {
#pragma unroll
        for (int ai = 0; ai < 2; ++ai)
#pragma unroll
            for (int m = 0; m < 4; ++m) {
                const int row = u.pm * BM + wr * 64 + fr + ai * HALF + m * 16;
#pragma unroll
                for (int bj = 0; bj < 2; ++bj) {
                    const int col = u.pn * BM + bj * HALF + wc * 32 + 8 * fq; const size_t off = (size_t)row * 1024 + col;
                    f32x4 r0, r1;
                    if (RES_BF16) { const u32x4 rw = *(const u32x4*)((const bf16_t*)res + off);
                        r0 = (f32x4){bflo_f(rw.x), bfhi_f(rw.x), bflo_f(rw.y), bfhi_f(rw.y)}; r1 = (f32x4){bflo_f(rw.z), bfhi_f(rw.z), bflo_f(rw.w), bfhi_f(rw.w)}; }
                    else { r0 = *(const f32x4*)((const float*)res + off); r1 = *(const f32x4*)((const float*)res + off + 4); }
                    const f32x4 o0 = r0 * alpha + acc[ai][bj][m][0] * scale, o1 = r1 * alpha + acc[ai][bj][m][1] * scale;
                    *(f32x4*)(out + off) = o0; *(f32x4*)(out + off + 4) = o1;
                }
            }
    }
};

struct EpiProj {
    static constexpr bool PERM = true, AFTER_DRAIN = false;
    bf16_t* P; float* SM;
    __device__ __forceinline__ void operator()(const f32x4 (&acc)[2][2][4][2], const Unit& u, int wr, int wc, int fr, int fq) const {
        const int row0 = u.pm * BM + wr * 64 + fr;
        if (u.pn < 14) {
            const int col0 = u.pn * BM + wc * 32 + 8 * fq;
#pragma unroll
            for (int ai = 0; ai < 2; ++ai)
#pragma unroll
                for (int m = 0; m < 4; ++m) { bf16_t* rowp = P + (size_t)(row0 + ai * HALF + m * 16) * 3584 + col0;
#pragma unroll
                    for (int bj = 0; bj < 2; ++bj) { const f32x4 v0 = acc[ai][bj][m][0], v1 = acc[ai][bj][m][1];
                        u32x4 w; w.x = cvt_pk_bf16(v0[0], v0[1]); w.y = cvt_pk_bf16(v0[2], v0[3]); w.z = cvt_pk_bf16(v1[0], v1[1]); w.w = cvt_pk_bf16(v1[2], v1[3]);
                        *(u32x4*)(rowp + bj * HALF) = w; } }
        } else if (wc == 0) {
#pragma unroll
            for (int ai = 0; ai < 2; ++ai)
#pragma unroll
                for (int m = 0; m < 4; ++m) { float* rowp = SM + (size_t)(row0 + ai * HALF + m * 16) * 32 + 8 * fq;
                    *(f32x4*)rowp = acc[ai][0][m][0]; *(f32x4*)(rowp + 4) = acc[ai][0][m][1]; }
        }
    }
};
}

#define LAS __attribute__((address_space(3)))
typedef unsigned short bf16;
typedef unsigned u32x4 __attribute__((ext_vector_type(4)));
typedef unsigned u32x2 __attribute__((ext_vector_type(2)));
typedef float f32x4 __attribute__((ext_vector_type(4)));
typedef short bf16x8 __attribute__((ext_vector_type(8)));
typedef float f32x2_t __attribute__((ext_vector_type(2)));
typedef __bf16 bf16x2_t __attribute__((ext_vector_type(2)));

constexpr int M = 32768, D = 1024, FF = 2816, NGU = 2 * FF, NPROJ = 3840, PW = 3584, SEQ = 8192, NCHK = 128, NCH = 2048;
constexpr int WIN_N = 3608;
constexpr float ALPHA = 1.189207115002721f;
constexpr float LN_EPS = 1e-5f, RMS_EPS = 1e-6f;
constexpr size_t MiB = 1u << 20;
constexpr size_t WS_WGU1 = 1 * MiB, WS_WD1 = 12 * MiB, WS_WIN = 18 * MiB, WS_WOUT = 26 * MiB, WS_WGU2 = 28 * MiB, WS_WD2 = 39 * MiB, WS_SMALL = 45 * MiB;
constexpr size_t WS_HP = 49 * MiB;
constexpr size_t WS_XB = 273 * MiB;
constexpr size_t WS_MIX = 337 * MiB;
constexpr size_t WS_DW = 401 * MiB, WS_DQ = 433 * MiB, WS_DK = 465 * MiB, WS_GE = 497 * MiB, WS_DGL = 498 * MiB, WS_END = 512 * MiB;
constexpr size_t OS_DU = 0, OS_GQ = 32 * MiB, OS_GA = 48 * MiB, OS_GK = 64 * MiB, OS_GV = 80 * MiB, OS_DQK = 112 * MiB;
constexpr int LDS_BYTES = 147456;
constexpr int NPART = 4, CW = 128 / NPART, NCWAVE = CW / 16;

__device__ __forceinline__ unsigned pk2(float lo, float hi) { f32x2_t v = {lo, hi}; bf16x2_t b = __builtin_convertvector(v, bf16x2_t); return __builtin_bit_cast(unsigned, b); }
__device__ __forceinline__ unsigned short f2bf(float f) { return (unsigned short)(pk2(f, 0.f) & 0xffffu); }
__device__ __forceinline__ float bf2f(unsigned short h) { return __uint_as_float((unsigned)h << 16); }
__device__ __forceinline__ float bflo(unsigned u) { return __uint_as_float(u << 16); }
__device__ __forceinline__ float bfhi(unsigned u) { return __uint_as_float(u & 0xffff0000u); }
__device__ __forceinline__ float silu(float x) { return x / (1.0f + __expf(-x)); }
__device__ __forceinline__ int kperm(int a) { return (a & ~31) | (((a >> 2) & 3) << 3) | (((a >> 4) & 1) << 2) | (a & 3); }
__device__ __forceinline__ float wave_sum(float v) {
#pragma unroll
    for (int o = 1; o < 64; o <<= 1) v += __shfl_xor(v, o);
    return v;
}
template <class T> __device__ __forceinline__ T opaque_v(T p) { asm volatile("" : "+v"(p)); return p; }
#define MFMA16(a, b, c) __builtin_amdgcn_mfma_f32_16x16x32_bf16((a), (b), (c), 0, 0, 0)
__device__ __forceinline__ bf16x8 pack8(const f32x4& lo, const f32x4& hi) {
    u32x4 p; p.x = pk2(lo[0], lo[1]); p.y = pk2(lo[2], lo[3]); p.z = pk2(hi[0], hi[1]); p.w = pk2(hi[2], hi[3]); return __builtin_bit_cast(bf16x8, p);
}

struct Args { const float* in[22]; float* out; unsigned char* ws; int ph_lo, ph_hi, coop, pad; };

struct ColGU { const float* g; const float* u; __device__ __forceinline__ const float* operator()(int d) const { const int t = d >> 8, w = d & 255;
    const uintptr_t gp = (uintptr_t)g, up = (uintptr_t)u; const uintptr_t base = gp + (uintptr_t)((w >> 7) & 1) * (up - gp); return (const float*)base + t * 128 + (w & 127); } };
struct ColPlain { const float* w; __device__ __forceinline__ const float* operator()(int d) const { return w + d; } };
struct ColWin { const float* w; __device__ __forceinline__ const float* operator()(int d) const {
    if (d < 2048) return w + d; if (d < 3584) return w + d + 8; if (d < 3592) return w + d - 1536; if (d < 3608) return w + d; return nullptr; } };

template <class ColPtr>
__device__ __forceinline__ void transpose_item(const ColPtr& cp, int nsrc, int K, bf16* WT, LAS float* scr, int kb, int nb, int lane) {
    const int k0 = 64 * kb, n0 = 32 * nb;
    const float* colp = cp(n0 + (lane & 31));
#pragma unroll 8
    for (int i = 0; i < 32; ++i) { const int kk = 2 * i + (lane >> 5); scr[kk * 33 + (lane & 31)] = colp ? colp[(size_t)(k0 + kk) * nsrc] : 0.f; }
    asm volatile("s_waitcnt lgkmcnt(0)" ::: "memory");
    const int c = lane & 7;
#pragma unroll
    for (int j = 0; j < 4; ++j) { const int n = (lane >> 3) + 8 * j; const LAS float* s = scr + (8 * c) * 33 + n;
        u32x4 o; o.x = pk2(s[0 * 33], s[1 * 33]); o.y = pk2(s[2 * 33], s[3 * 33]); o.z = pk2(s[4 * 33], s[5 * 33]); o.w = pk2(s[6 * 33], s[7 * 33]);
        *(u32x4*)(WT + (size_t)(n0 + n) * K + k0 + 8 * c) = o; }
    asm volatile("s_waitcnt lgkmcnt(0)" ::: "memory");
}

__device__ __forceinline__ void prologue(const Args& a, LAS unsigned char* lds, int gw, int NGW, int wave, int lane) {
    unsigned char* ws = a.ws;
    LAS float* scr = (LAS float*)(lds + wave * 16384);
    constexpr int I_GU = 16 * (NGU / 32), I_D = (FF / 64) * (D / 32), I_IN = 16 * (NPROJ / 32), I_O = 16 * (D / 32);
    constexpr int NITEMS = 2 * I_GU + 2 * I_D + I_IN + I_O;
    for (int it = gw; it < NITEMS; it += NGW) {
        int r = it;
        if (r < I_GU) { ColGU c{a.in[1], a.in[2]}; transpose_item(c, FF, D, (bf16*)(ws + WS_WGU1), scr, r / (NGU / 32), r % (NGU / 32), lane); continue; } r -= I_GU;
        if (r < I_GU) { ColGU c{a.in[17], a.in[18]}; transpose_item(c, FF, D, (bf16*)(ws + WS_WGU2), scr, r / (NGU / 32), r % (NGU / 32), lane); continue; } r -= I_GU;
        if (r < I_D) { ColPlain c{a.in[3]}; transpose_item(c, D, FF, (bf16*)(ws + WS_WD1), scr, r / (D / 32), r % (D / 32), lane); continue; } r -= I_D;
        if (r < I_D) { ColPlain c{a.in[19]}; transpose_item(c, D, FF, (bf16*)(ws + WS_WD2), scr, r / (D / 32), r % (D / 32), lane); continue; } r -= I_D;
        if (r < I_IN) { ColWin c{a.in[6]}; transpose_item(c, WIN_N, D, (bf16*)(ws + WS_WIN), scr, r / (NPROJ / 32), r % (NPROJ / 32), lane); continue; } r -= I_IN;
        { ColPlain c{a.in[14]}; transpose_item(c, D, D, (bf16*)(ws + WS_WOUT), scr, r / (D / 32), r % (D / 32), lane); }
    }
    const float* x = a.in[0]; bf16* xb = (bf16*)(ws + WS_XB);
    const size_t nthr = (size_t)NGW * 64, t0 = (size_t)gw * 64 + lane;
    for (size_t i = t0; i < (size_t)M * D / 8; i += nthr) {
        const f32x4 v0 = *(const f32x4*)(x + i * 8), v1 = *(const f32x4*)(x + i * 8 + 4);
        u32x4 o; o.x = pk2(v0[0], v0[1]); o.y = pk2(v0[2], v0[3]); o.z = pk2(v1[0], v1[1]); o.w = pk2(v1[2], v1[3]);
        *(u32x4*)(xb + i * 8) = o;
    }
}

__device__ __forceinline__ void ln_phase(const float* Y, float* Xf, bf16* Xb, const float* g, const float* b, int gw, int NGW, int lane) {
    f32x4 gv[4], bv[4];
#pragma unroll
    for (int j = 0; j < 4; ++j) { gv[j] = *(const f32x4*)(g + 4 * lane + 256 * j); bv[j] = *(const f32x4*)(b + 4 * lane + 256 * j); }
    for (int m = gw; m < M; m += NGW) {
        const f32x4* yr = (const f32x4*)(Y + (size_t)m * D) + lane;
        f32x4 v[4]; float s = 0.f;
#pragma unroll
        for (int j = 0; j < 4; ++j) { v[j] = yr[64 * j]; s += (v[j][0] + v[j][1]) + (v[j][2] + v[j][3]); }
        const float mean = wave_sum(s) * (1.f / D); float s2 = 0.f;
#pragma unroll
        for (int j = 0; j < 4; ++j) { v[j] = v[j] - mean; s2 += (v[j][0] * v[j][0] + v[j][1] * v[j][1]) + (v[j][2] * v[j][2] + v[j][3] * v[j][3]); }
        const float rstd = 1.0f / sqrtf(wave_sum(s2) * (1.f / D) + LN_EPS);
#pragma unroll
        for (int j = 0; j < 4; ++j) {
            const f32x4 o = v[j] * rstd * gv[j] + bv[j];
            if (Xf) *((f32x4*)(Xf + (size_t)m * D) + lane + 64 * j) = o;
            if (Xb) { u32x2 w; w.x = pk2(o[0], o[1]); w.y = pk2(o[2], o[3]); *((u32x2*)(Xb + (size_t)m * D) + lane + 64 * j) = w; }
        }
    }
}

__device__ __forceinline__ void gnorm_phase(bf16* MIX, const bf16* P, const float* wa, const float* wb, int gw, int NGW, int lane) {
    const int hd = lane >> 3, cc = (lane & 7) * 16;
    const float* wn = (hd < 4 ? wa : wb) + cc;
    float wv[16];
#pragma unroll
    for (int j = 0; j < 16; ++j) wv[j] = wn[j];
    const int gcol = (hd < 4 ? 1536 : 3072) + (hd & 3) * 128 + cc;
    for (int m = gw; m < M; m += NGW) {
        bf16* op = MIX + (size_t)m * D + lane * 16;
        const u32x4 o0 = *(const u32x4*)op, o1 = *(const u32x4*)(op + 8);
        const u32x4 g0 = *(const u32x4*)(P + (size_t)m * PW + gcol), g1 = *(const u32x4*)(P + (size_t)m * PW + gcol + 8);
        float o[16], g[16];
#pragma unroll
        for (int j = 0; j < 4; ++j) { o[2 * j] = bflo(o0[j]); o[2 * j + 1] = bfhi(o0[j]); o[8 + 2 * j] = bflo(o1[j]); o[9 + 2 * j] = bfhi(o1[j]);
                                      g[2 * j] = bflo(g0[j]); g[2 * j + 1] = bfhi(g0[j]); g[8 + 2 * j] = bflo(g1[j]); g[9 + 2 * j] = bfhi(g1[j]); }
        float ss = 0.f;
#pragma unroll
        for (int j = 0; j < 16; ++j) ss += o[j] * o[j];
        ss += __shfl_xor(ss, 1); ss += __shfl_xor(ss, 2); ss += __shfl_xor(ss, 4);
        const float rs = 1.0f / sqrtf(ss * (1.f / 128.f) + RMS_EPS);
        u32x4 r0, r1;
#pragma unroll
        for (int j = 0; j < 4; ++j) {
            r0[j] = pk2(o[2 * j] * rs * wv[2 * j] * silu(g[2 * j]), o[2 * j + 1] * rs * wv[2 * j + 1] * silu(g[2 * j + 1]));
            r1[j] = pk2(o[8 + 2 * j] * rs * wv[8 + 2 * j] * silu(g[8 + 2 * j]), o[9 + 2 * j] * rs * wv[9 + 2 * j] * silu(g[9 + 2 * j]));
        }
        *(u32x4*)op = r0; *(u32x4*)(op + 8) = r1;
    }
}

constexpr int PK_KN = 0, PK_QN = 17408, PK_RHS = 34816, PK_QF = 100352, PK_SC = 133120;
__device__ __forceinline__ void gdn_prep_item(const Args& a, LAS unsigned char* lds_in, int item, int tid_in) {
    const int tid = opaque_v(tid_in); LAS unsigned char* lds = opaque_v(lds_in);
    const int n = item & 127, bh = item >> 7, h = bh & 3, b = bh >> 2;
    const int t0 = b * SEQ + n * 64, ci = item;
    const int lane = tid & 63, wid = tid >> 6;
    unsigned char* ws = a.ws;
    const bf16* P = (const bf16*)(ws + WS_HP);
    const float* SMALL = (const float*)(ws + WS_SMALL);
    LAS float* RHS = opaque_v((LAS float*)(lds + PK_RHS)); LAS float* QF = opaque_v((LAS float*)(lds + PK_QF)); LAS float* AM = QF; LAS float* SC = opaque_v((LAS float*)(lds + PK_SC));
    LAS unsigned char* KNp = opaque_v(lds + PK_KN); LAS unsigned char* QNp = opaque_v(lds + PK_QN);
    bf16* DW = (bf16*)(ws + WS_DW) + (size_t)ci * 8192; bf16* DQ = (bf16*)(ws + WS_DQ) + (size_t)ci * 8192; bf16* DK = (bf16*)(ws + WS_DK) + (size_t)ci * 8192;
    bf16* DQK = (bf16*)((unsigned char*)a.out + OS_DQK) + (size_t)ci * 4096; bf16* DU = (bf16*)((unsigned char*)a.out + OS_DU) + (size_t)ci * 8192;
    float* DGL = (float*)(ws + WS_DGL);
    if (tid < 64) {
        const float* sm = SMALL + (size_t)(t0 + tid) * 32;
        const float be = 1.0f / (1.0f + __expf(-sm[h]));
        const float xx = sm[4 + h] + a.in[9][h];
        const float sp = xx > 20.f ? xx : log1pf(__expf(xx));
        float G = -__expf(a.in[8][h]) * sp;
#pragma unroll
        for (int o = 1; o < 64; o <<= 1) { const float t = __shfl_up(G, o); if (lane >= o) G += t; }
        const float Gl = __shfl(G, 63);
        SC[tid] = G; SC[64 + tid] = be; SC[128 + tid] = __expf(G); SC[192 + tid] = __expf(Gl - G);
        if (tid == 63) DGL[ci] = __expf(G);
    }
    {
        const int c = tid & 127, rg = tid >> 7;
        const bool first = (n == 0 && rg == 0);
        const float* cw = a.in[7];
#pragma unroll
        for (int mat = 0; mat < 3; ++mat) {
            const int ch = mat * 512 + h * 128 + c;
            const float w0 = cw[ch], w1 = cw[1536 + ch], w2 = cw[3072 + ch], w3 = cw[4608 + ch];
            const bf16* src = P + (size_t)(t0 + rg * 16) * PW + ch;
            float x0 = 0.f, x1 = 0.f, x2 = 0.f;
            if (!first) { x0 = bf2f(*(src - 3 * PW)); x1 = bf2f(*(src - 2 * PW)); x2 = bf2f(*(src - PW)); }
#pragma unroll
            for (int r = 0; r < 16; ++r) {
                const float x3 = bf2f(src[(size_t)r * PW]);
                const float y = silu(w0 * x0 + w1 * x1 + w2 * x2 + w3 * x3);
                const int row = rg * 16 + r;
                if (mat == 0) QF[row * 128 + c] = y; else if (mat == 1) RHS[row * 256 + 128 + c] = y; else RHS[row * 256 + c] = y;
                x0 = x1; x1 = x2; x2 = x3;
            }
        }
    }
    __syncthreads();
    {
        const int r = tid >> 3, p = tid & 7;
        const float be = SC[64 + r], eg = SC[128 + r];
        float qv[16], kv[16]; float sq = 0.f, sk = 0.f;
#pragma unroll
        for (int j = 0; j < 16; ++j) { qv[j] = QF[r * 128 + p * 16 + j]; kv[j] = RHS[r * 256 + 128 + p * 16 + j]; sq += qv[j] * qv[j]; sk += kv[j] * kv[j]; }
        sq += __shfl_xor(sq, 1); sq += __shfl_xor(sq, 2); sq += __shfl_xor(sq, 4);
        sk += __shfl_xor(sk, 1); sk += __shfl_xor(sk, 2); sk += __shfl_xor(sk, 4);
        const float rq = (1.0f / sqrtf(sq + RMS_EPS)) * 0.08838834764831845f, rk = 1.0f / sqrtf(sk + RMS_EPS);
#pragma unroll
        for (int j = 0; j < 16; ++j) { qv[j] *= rq; kv[j] *= rk; RHS[r * 256 + 128 + p * 16 + j] = be * eg * kv[j]; RHS[r * 256 + p * 16 + j] *= be; }
        LAS unsigned* kn = (LAS unsigned*)(KNp + r * 272 + p * 32); LAS unsigned* qn = (LAS unsigned*)(QNp + r * 272 + p * 32);
#pragma unroll
        for (int j = 0; j < 8; ++j) { kn[j] = pk2(kv[2 * j], kv[2 * j + 1]); qn[j] = pk2(qv[2 * j], qv[2 * j + 1]); }
        const int gi = p >> 1, hi = p & 1;
#pragma unroll
        for (int q4 = 0; q4 < 4; ++q4) { u32x2 w; w.x = pk2(qv[4 * q4] * eg, qv[4 * q4 + 1] * eg); w.y = pk2(qv[4 * q4 + 2] * eg, qv[4 * q4 + 3] * eg);
            *(u32x2*)(DQ + r * 128 + gi * 32 + 8 * q4 + 4 * hi) = w; }
    }
    __syncthreads();
    {
        const int rb = wid & 3; const bool isqk = wid >= 4; const int r = lane & 15, q = lane >> 4;
        const LAS unsigned char* Ab = isqk ? QNp : KNp;
        f32x4 acc[4];
#pragma unroll
        for (int cb = 0; cb < 4; ++cb) acc[cb] = (f32x4){0.f, 0.f, 0.f, 0.f};
#pragma unroll
        for (int s = 0; s < 4; ++s) {
            const bf16x8 av = *(const LAS bf16x8*)(Ab + (16 * rb + r) * 272 + s * 64 + q * 16);
#pragma unroll
            for (int cb = 0; cb < 4; ++cb) { const bf16x8 bv = *(const LAS bf16x8*)(KNp + (16 * cb + r) * 272 + s * 64 + q * 16); acc[cb] = MFMA16(av, bv, acc[cb]); }
        }
#pragma unroll
        for (int cb = 0; cb < 4; ++cb)
#pragma unroll
            for (int i = 0; i < 4; ++i) {
                const int ii = 16 * rb + 4 * q + i, jj = 16 * cb + r;
                const float Gi = SC[ii], Gj = SC[jj];
                if (isqk) { const float v = (jj <= ii) ? acc[cb][i] * __expf(Gi - Gj) : 0.f; DQK[ii * 64 + kperm(jj)] = f2bf(v); }
                else { const float v = (jj < ii) ? SC[64 + ii] * acc[cb][i] * __expf(Gi - Gj) : 0.f; AM[ii * 64 + jj] = v; }
            }
    }
    __syncthreads();
    if (tid < 256) {
        const int c = tid; float x[64];
#pragma unroll
        for (int i = 0; i < 64; ++i) {
            float acc = RHS[i * 256 + c];
#pragma unroll
            for (int jb = 0; jb < (i + 3) / 4; ++jb) {
                const f32x4 av = *(const LAS f32x4*)(AM + i * 64 + 4 * jb);
#pragma unroll
                for (int e = 0; e < 4; ++e) if (4 * jb + e < i) acc -= av[e] * x[4 * jb + e];
            }
            x[i] = acc;
        }
        if (c < 128) {
#pragma unroll
            for (int k8 = 0; k8 < 8; ++k8) { u32x4 w; w.x = pk2(x[8 * k8], x[8 * k8 + 1]); w.y = pk2(x[8 * k8 + 2], x[8 * k8 + 3]); w.z = pk2(x[8 * k8 + 4], x[8 * k8 + 5]); w.w = pk2(x[8 * k8 + 6], x[8 * k8 + 7]);
                *(u32x4*)(DU + c * 64 + 8 * k8) = w; }
        } else {
            const int pc = kperm(c - 128);
#pragma unroll
            for (int i = 0; i < 64; ++i) DW[i * 128 + pc] = f2bf(x[i]);
        }
    } else if (tid < 384) {
        const int c = tid - 256;
        float v[64];
#pragma unroll
        for (int i = 0; i < 64; ++i) v[kperm(i)] = bf2f(*(const LAS unsigned short*)(KNp + i * 272 + c * 2)) * SC[192 + i];
#pragma unroll
        for (int k8 = 0; k8 < 8; ++k8) { u32x4 w; w.x = pk2(v[8 * k8], v[8 * k8 + 1]); w.y = pk2(v[8 * k8 + 2], v[8 * k8 + 3]); w.z = pk2(v[8 * k8 + 4], v[8 * k8 + 5]); w.w = pk2(v[8 * k8 + 6], v[8 * k8 + 7]);
            *(u32x4*)(DK + c * 64 + 8 * k8) = w; }
    }
    __syncthreads();
}

constexpr int GK_QT = 0, GK_KT = 9216, GK_PS = 18432, GK_LR = 20480;
__device__ __forceinline__ void gla_prep_item(const Args& a, LAS unsigned char* lds_in, int item, int tid_in) {
    const int tid = opaque_v(tid_in); LAS unsigned char* lds = opaque_v(lds_in);
    const int n = item & 127, bh = item >> 7, h = bh & 3, b = bh >> 2;
    const int t0 = b * SEQ + n * 64, ci = item;
    const int lane = tid & 63, wid = tid >> 6;
    unsigned char* ws = a.ws;
    const bf16* P = (const bf16*)(ws + WS_HP);
    const float* SMALL = (const float*)(ws + WS_SMALL);
    unsigned char* os = (unsigned char*)a.out;
    bf16* GQ = (bf16*)(os + OS_GQ) + (size_t)ci * 4096; bf16* GA = (bf16*)(os + OS_GA) + (size_t)ci * 4096; bf16* GK = (bf16*)(os + OS_GK) + (size_t)ci * 4096;
    bf16* GV = (bf16*)(os + OS_GV) + (size_t)ci * 8192; float* GE = (float*)(ws + WS_GE) + (size_t)ci * 64;
    LAS float* PS = (LAS float*)(lds + GK_PS); LAS float* LR = (LAS float*)(lds + GK_LR);
    if (tid < 256) *(LAS f32x4*)(LR + tid * 4) = *(const f32x4*)(SMALL + (size_t)(t0 + (tid >> 2)) * 32 + 8 + (tid & 3) * 4);
    {
        const int dv = tid & 127, tg = tid >> 7; const bf16* src = P + (size_t)(t0 + tg * 16) * PW + 2560 + h * 128 + dv;
        unsigned w[8];
#pragma unroll
        for (int j = 0; j < 8; ++j) w[j] = (unsigned)src[(size_t)(2 * j) * PW] | ((unsigned)src[(size_t)(2 * j + 1) * PW] << 16);
        *(u32x4*)(GV + dv * 64 + tg * 16) = (u32x4){w[0], w[1], w[2], w[3]}; *(u32x4*)(GV + dv * 64 + tg * 16 + 8) = (u32x4){w[4], w[5], w[6], w[7]};
    }
    __syncthreads();
    const int k = tid & 63, rg = tid >> 6;
    float lg[8];
    {
        float wg[16];
#pragma unroll
        for (int j = 0; j < 16; ++j) wg[j] = a.in[11][j * 256 + h * 64 + k];
        const float bg = a.in[12][h * 64 + k];
        float run = 0.f;
#pragma unroll
        for (int i = 0; i < 8; ++i) {
            const int r = rg * 8 + i; float x = bg;
#pragma unroll
            for (int j = 0; j < 16; ++j) x += LR[r * 16 + j] * wg[j];
            const float ls = fminf(x, 0.f) - log1pf(__expf(-fabsf(x)));
            run += ls * (1.0f / 16.0f); lg[i] = run;
        }
        PS[rg * 64 + k] = run;
    }
    __syncthreads();
    {
        float off = 0.f, tot = 0.f;
#pragma unroll
        for (int g2 = 0; g2 < 8; ++g2) { const float v = PS[g2 * 64 + k]; if (g2 < rg) off += v; tot += v; }
        float kd[8];
#pragma unroll
        for (int i = 0; i < 8; ++i) {
            const int r = rg * 8 + i; const float bc = lg[i] + off;
            const float qraw = bf2f(P[(size_t)(t0 + r) * PW + 2048 + h * 64 + k]), kraw = bf2f(P[(size_t)(t0 + r) * PW + 2304 + h * 64 + k]);
            const float qt = qraw * 0.125f * __expf(bc), kt = kraw * __expf(-bc);
            kd[i] = kraw * __expf(tot - bc);
            const unsigned short qb = f2bf(qt);
            *(LAS unsigned short*)(lds + GK_QT + r * 144 + k * 2) = qb; *(LAS unsigned short*)(lds + GK_KT + r * 144 + k * 2) = f2bf(kt);
            GQ[r * 64 + kperm(k)] = qb;
        }
        u32x4 w; w.x = pk2(kd[0], kd[1]); w.y = pk2(kd[2], kd[3]); w.z = pk2(kd[4], kd[5]); w.w = pk2(kd[6], kd[7]);
        *(u32x4*)(GK + k * 64 + rg * 8) = w;
        if (rg == 0) GE[k] = __expf(tot);
    }
    __syncthreads();
    if (wid < 4) {
        const int rb = wid, r = lane & 15, q = lane >> 4;
        f32x4 acc[4];
#pragma unroll
        for (int cb = 0; cb < 4; ++cb) acc[cb] = (f32x4){0.f, 0.f, 0.f, 0.f};
#pragma unroll
        for (int s = 0; s < 2; ++s) {
            const bf16x8 av = *(const LAS bf16x8*)(lds + GK_QT + (16 * rb + r) * 144 + s * 64 + q * 16);
#pragma unroll
            for (int cb = 0; cb < 4; ++cb) { const bf16x8 bv = *(const LAS bf16x8*)(lds + GK_KT + (16 * cb + r) * 144 + s * 64 + q * 16); acc[cb] = MFMA16(av, bv, acc[cb]); }
        }
#pragma unroll
        for (int cb = 0; cb < 4; ++cb)
#pragma unroll
            for (int i = 0; i < 4; ++i) { const int ii = 16 * rb + 4 * q + i, jj = 16 * cb + r; GA[ii * 64 + jj] = f2bf(jj <= ii ? acc[cb][i] : 0.f); }
    }
    __syncthreads();
}

constexpr int SB_W = 0, SB_Q = 17408, SB_K = 34816, SB_QK = 53248, SB_BYTES = 62464;
constexpr int GB_Q = 0, GB_A = 9216, GB_K = 18432, GB_BYTES = 27648;

__device__ __forceinline__ void gdn_scan(const Args& a, LAS unsigned char* lds, int bh, int part, int tid) {
    const int lane = tid & 63, wid = tid >> 6, c = lane & 15, q = lane >> 4, h = bh & 3, b = bh >> 2;
    unsigned char* ws = a.ws; unsigned char* os = (unsigned char*)a.out;
    const u32x4* DW = (const u32x4*)(ws + WS_DW) + (size_t)bh * 128 * 1024; const u32x4* DQ = (const u32x4*)(ws + WS_DQ) + (size_t)bh * 128 * 1024;
    const u32x4* DK = (const u32x4*)(ws + WS_DK) + (size_t)bh * 128 * 1024; const u32x4* DQK = (const u32x4*)(os + OS_DQK) + (size_t)bh * 128 * 512;
    const bf16* DU = (const bf16*)(os + OS_DU) + (size_t)bh * 128 * 8192; const float* DGL = (const float*)(ws + WS_DGL) + bh * 128;
    bf16* MIX = (bf16*)(ws + WS_MIX);
    const bool cw = wid < NCWAVE; const int dv = part * CW + 16 * wid + c;
    const int p0 = tid, p1 = tid + 512;
    const int oW0 = (p0 >> 4) * 272 + (p0 & 15) * 16, oW1 = (p1 >> 4) * 272 + (p1 & 15) * 16;
    const int oK0 = (p0 >> 3) * 144 + (p0 & 7) * 16, oK1 = (p1 >> 3) * 144 + (p1 & 7) * 16;
    u32x4 st[7];
#define GDN_LOAD(n) do { const size_t o8 = (size_t)(n) * 1024, o4 = (size_t)(n) * 512; st[0] = DW[o8 + p0]; st[1] = DW[o8 + p1]; st[2] = DQ[o8 + p0]; st[3] = DQ[o8 + p1]; st[4] = DK[o8 + p0]; st[5] = DK[o8 + p1]; st[6] = DQK[o4 + p0]; } while (0)
#define GDN_STORE(buf) do { LAS unsigned char* B_ = lds + (buf) * SB_BYTES; *(LAS u32x4*)(B_ + SB_W + oW0) = st[0]; *(LAS u32x4*)(B_ + SB_W + oW1) = st[1]; *(LAS u32x4*)(B_ + SB_Q + oW0) = st[2]; *(LAS u32x4*)(B_ + SB_Q + oW1) = st[3]; \
        *(LAS u32x4*)(B_ + SB_K + oK0) = st[4]; *(LAS u32x4*)(B_ + SB_K + oK1) = st[5]; *(LAS u32x4*)(B_ + SB_QK + oK0) = st[6]; } while (0)
    f32x4 S[8]; bf16x8 Sb[4];
#pragma unroll
    for (int i = 0; i < 8; ++i) S[i] = (f32x4){0.f, 0.f, 0.f, 0.f};
#pragma unroll
    for (int i = 0; i < 4; ++i) Sb[i] = (bf16x8){0, 0, 0, 0, 0, 0, 0, 0};
    u32x2 un[4];
    if (cw) {
#pragma unroll
        for (int rb = 0; rb < 4; ++rb) un[rb] = *(const u32x2*)(DU + dv * 64 + 16 * rb + 4 * q);
    }
    GDN_LOAD(0); GDN_STORE(0);
    __syncthreads();
    for (int n = 0; n < NCHK; ++n) {
        const int nn = n + 1 < NCHK ? n + 1 : n;
        GDN_LOAD(nn);
        if (cw) {
            const LAS unsigned char* B = lds + (n & 1) * SB_BYTES;
            const float gl = DGL[n];
            u32x2 uc[4];
#pragma unroll
            for (int rb = 0; rb < 4; ++rb) { uc[rb] = un[rb]; un[rb] = *(const u32x2*)(DU + (size_t)nn * 8192 + dv * 64 + 16 * rb + 4 * q); }
            f32x4 aO[4], aW[4];
#pragma unroll
            for (int rb = 0; rb < 4; ++rb) { aO[rb] = (f32x4){0.f, 0.f, 0.f, 0.f}; aW[rb] = (f32x4){0.f, 0.f, 0.f, 0.f}; }
#pragma unroll
            for (int s = 0; s < 4; ++s)
#pragma unroll
                for (int rb = 0; rb < 4; ++rb) {
                    const bf16x8 wv = *(const LAS bf16x8*)(B + SB_W + (16 * rb + c) * 272 + s * 64 + q * 16);
                    aW[rb] = MFMA16(wv, Sb[s], aW[rb]);
                    const bf16x8 qv = *(const LAS bf16x8*)(B + SB_Q + (16 * rb + c) * 272 + s * 64 + q * 16);
                    aO[rb] = MFMA16(qv, Sb[s], aO[rb]);
                }
            f32x4 vn[4];
#pragma unroll
            for (int rb = 0; rb < 4; ++rb) vn[rb] = (f32x4){bflo(uc[rb].x), bfhi(uc[rb].x), bflo(uc[rb].y), bfhi(uc[rb].y)} - aW[rb];
            bf16x8 Vb[2]; Vb[0] = pack8(vn[0], vn[1]); Vb[1] = pack8(vn[2], vn[3]);
#pragma unroll
            for (int s = 0; s < 2; ++s)
#pragma unroll
                for (int rb = 0; rb < 4; ++rb) {
                    const bf16x8 kv = *(const LAS bf16x8*)(B + SB_QK + (16 * rb + c) * 144 + s * 64 + q * 16);
                    aO[rb] = MFMA16(kv, Vb[s], aO[rb]);
                }
#pragma unroll
            for (int rb = 0; rb < 8; ++rb) {
                S[rb] = S[rb] * gl;
#pragma unroll
                for (int s = 0; s < 2; ++s) {
                    const bf16x8 kv = *(const LAS bf16x8*)(B + SB_K + (16 * rb + c) * 144 + s * 64 + q * 16);
                    S[rb] = MFMA16(kv, Vb[s], S[rb]);
                }
            }
#pragma unroll
            for (int s = 0; s < 4; ++s) Sb[s] = pack8(S[2 * s], S[2 * s + 1]);
            bf16* op = MIX + (size_t)(b * SEQ + n * 64 + 4 * q) * D + h * 128 + dv;
#pragma unroll
            for (int rb = 0; rb < 4; ++rb)
#pragma unroll
                for (int i = 0; i < 4; ++i) op[(size_t)(16 * rb + i) * D] = f2bf(aO[rb][i]);
        }
        GDN_STORE((n + 1) & 1);
        __syncthreads();
    }
#undef GDN_LOAD
#undef GDN_STORE
}

__device__ __forceinline__ void gla_scan(const Args& a, LAS unsigned char* lds, int bh, int part, int tid) {
    const int lane = tid & 63, wid = tid >> 6, c = lane & 15, q = lane >> 4, h = bh & 3, b = bh >> 2;
    unsigned char* ws = a.ws; unsigned char* os = (unsigned char*)a.out;
    const u32x4* GQ = (const u32x4*)(os + OS_GQ) + (size_t)bh * 128 * 512; const u32x4* GA = (const u32x4*)(os + OS_GA) + (size_t)bh * 128 * 512; const u32x4* GK = (const u32x4*)(os + OS_GK) + (size_t)bh * 128 * 512;
    const bf16* GV = (const bf16*)(os + OS_GV) + (size_t)bh * 128 * 8192; const float* GE = (const float*)(ws + WS_GE) + (size_t)bh * 128 * 64;
    bf16* MIX = (bf16*)(ws + WS_MIX);
    const bool cw = wid < NCWAVE; const int dv = part * CW + 16 * wid + c;
    const int oK0 = (tid >> 3) * 144 + (tid & 7) * 16;
    u32x4 st[3];
#define GLA_LOAD(n) do { const size_t o4 = (size_t)(n) * 512; st[0] = GQ[o4 + tid]; st[1] = GA[o4 + tid]; st[2] = GK[o4 + tid]; } while (0)
#define GLA_STORE(buf) do { LAS unsigned char* B_ = lds + (buf) * GB_BYTES; *(LAS u32x4*)(B_ + GB_Q + oK0) = st[0]; *(LAS u32x4*)(B_ + GB_A + oK0) = st[1]; *(LAS u32x4*)(B_ + GB_K + oK0) = st[2]; } while (0)
    f32x4 S[4]; bf16x8 Sb[2];
#pragma unroll
    for (int i = 0; i < 4; ++i) S[i] = (f32x4){0.f, 0.f, 0.f, 0.f};
#pragma unroll
    for (int i = 0; i < 2; ++i) Sb[i] = (bf16x8){0, 0, 0, 0, 0, 0, 0, 0};
    bf16x8 vnx[2]; f32x4 enx[4];
    if (cw) {
#pragma unroll
        for (int s = 0; s < 2; ++s) vnx[s] = *(const bf16x8*)(GV + dv * 64 + 32 * s + 8 * q);
#pragma unroll
        for (int rb = 0; rb < 4; ++rb) enx[rb] = *(const f32x4*)(GE + 16 * rb + 4 * q);
    }
    GLA_LOAD(0); GLA_STORE(0);
    __syncthreads();
    for (int n = 0; n < NCHK; ++n) {
        const int nn = n + 1 < NCHK ? n + 1 : n;
        GLA_LOAD(nn);
        if (cw) {
            const LAS unsigned char* B = lds + (n & 1) * GB_BYTES;
            bf16x8 Vb[2]; f32x4 eb[4];
#pragma unroll
            for (int s = 0; s < 2; ++s) { Vb[s] = vnx[s]; vnx[s] = *(const bf16x8*)(GV + (size_t)nn * 8192 + dv * 64 + 32 * s + 8 * q); }
#pragma unroll
            for (int rb = 0; rb < 4; ++rb) { eb[rb] = enx[rb]; enx[rb] = *(const f32x4*)(GE + (size_t)nn * 64 + 16 * rb + 4 * q); }
            f32x4 aO[4];
#pragma unroll
            for (int rb = 0; rb < 4; ++rb) aO[rb] = (f32x4){0.f, 0.f, 0.f, 0.f};
#pragma unroll
            for (int s = 0; s < 2; ++s)
#pragma unroll
                for (int rb = 0; rb < 4; ++rb) {
                    const bf16x8 qv = *(const LAS bf16x8*)(B + GB_Q + (16 * rb + c) * 144 + s * 64 + q * 16);
                    aO[rb] = MFMA16(qv, Sb[s], aO[rb]);
                    const bf16x8 av = *(const LAS bf16x8*)(B + GB_A + (16 * rb + c) * 144 + s * 64 + q * 16);
                    aO[rb] = MFMA16(av, Vb[s], aO[rb]);
                }
#pragma unroll
            for (int rb = 0; rb < 4; ++rb) {
                S[rb] = S[rb] * eb[rb];
#pragma unroll
                for (int s = 0; s < 2; ++s) {
                    const bf16x8 kv = *(const LAS bf16x8*)(B + GB_K + (16 * rb + c) * 144 + s * 64 + q * 16);
                    S[rb] = MFMA16(kv, Vb[s], S[rb]);
                }
            }
#pragma unroll
            for (int s = 0; s < 2; ++s) Sb[s] = pack8(S[2 * s], S[2 * s + 1]);
            bf16* op = MIX + (size_t)(b * SEQ + n * 64 + 4 * q) * D + 512 + h * 128 + dv;
#pragma unroll
            for (int rb = 0; rb < 4; ++rb)
#pragma unroll
                for (int i = 0; i < 4; ++i) op[(size_t)(16 * rb + i) * D] = f2bf(aO[rb][i]);
        }
        GLA_STORE((n + 1) & 1);
        __syncthreads();
    }
#undef GLA_LOAD
#undef GLA_STORE
}

__global__ void __launch_bounds__(512, 2) fwd_kernel(Args a) {
    extern __shared__ __attribute__((aligned(16))) unsigned char lds_raw[];
    LAS unsigned char* lds = (LAS unsigned char*)lds_raw;
    const int tid = threadIdx.x, lane = tid & 63, wave = __builtin_amdgcn_readfirstlane(tid >> 6);
    const int G = gridDim.x, bx = blockIdx.x;
    const int vcu = (G % 8 == 0) ? (bx % 8) * (G / 8) + bx / 8 : bx;
    const int gw = vcu * 8 + wave, NGW = G * 8;
    unsigned char* ws = a.ws;
    const int lo = a.ph_lo, hi = a.ph_hi;
#define IN(k) (lo <= (k) && (k) < hi)
#define SEAM(k) do { if (IN(k) && IN((k) + 1)) { if (a.coop) cg::this_grid().sync(); } } while (0)
    bf16* XB = (bf16*)(ws + WS_XB); bf16* HB = (bf16*)(ws + WS_HP); bf16* MIX = (bf16*)(ws + WS_MIX);
    float* SMALL = (float*)(ws + WS_SMALL);

    if (IN(0)) { prologue(a, lds, gw, NGW, wave, lane); } SEAM(0);
    if (IN(1)) {
        pg8::Gemm g{XB, (const bf16*)(ws + WS_WGU1), M, NGU, D}; pg8::StaticOrder S; S.init(M, NGU, G, bx);
        pg8::EpiSwiglu E{HB, FF};
        pg8::gemm_phase<pg8::EpiSwiglu, pg8::StaticOrder, true, true>(lds, g, S, E);
    } SEAM(1);
    if (IN(2)) {
        pg8::Gemm g{HB, (const bf16*)(ws + WS_WD1), M, D, FF}; pg8::StaticOrder S; S.init(M, D, G, bx);
        pg8::EpiRes<false> E{a.in[0], a.out, ALPHA, 0.5f};
        pg8::gemm_phase<pg8::EpiRes<false>, pg8::StaticOrder, true, true>(lds, g, S, E);
    } SEAM(2);
    if (IN(3)) { ln_phase(a.out, nullptr, XB, a.in[4], a.in[5], gw, NGW, lane); } SEAM(3);
    if (IN(4)) {
        pg8::Gemm g{XB, (const bf16*)(ws + WS_WIN), M, NPROJ, D}; pg8::StaticOrder S; S.init(M, NPROJ, G, bx);
        pg8::EpiProj E{HB, SMALL};
        pg8::gemm_phase<pg8::EpiProj, pg8::StaticOrder, true, true>(lds, g, S, E);
    } SEAM(4);
    if (IN(5)) {
        for (int it = bx; it < 2 * NCH; it += G) { if (it < NCH) gdn_prep_item(a, lds, it, tid); else gla_prep_item(a, lds, it - NCH, tid); }
    } SEAM(5);
    if (IN(6)) {
        const int xcd = bx & 7, slot = bx >> 3;
        if (slot < 4 * NPART) {
            const int sl = slot / NPART, part = slot % NPART, bh = xcd * 2 + (sl >> 1);
            if ((sl & 1) == 0) gdn_scan(a, lds, bh, part, tid); else gla_scan(a, lds, bh, part, tid);
        }
    } SEAM(6);
    if (IN(7)) { gnorm_phase(MIX, HB, a.in[10], a.in[13], gw, NGW, lane); } SEAM(7);
    if (IN(8)) {
        pg8::Gemm g{MIX, (const bf16*)(ws + WS_WOUT), M, D, D}; pg8::StaticOrder S; S.init(M, D, G, bx);
        pg8::EpiRes<true> E{XB, a.out, ALPHA, 1.0f};
        pg8::gemm_phase<pg8::EpiRes<true>, pg8::StaticOrder, true, true>(lds, g, S, E);
    } SEAM(8);
    if (IN(9)) { ln_phase(a.out, a.out, XB, a.in[15], a.in[16], gw, NGW, lane); } SEAM(9);
    if (IN(10)) {
        pg8::Gemm g{XB, (const bf16*)(ws + WS_WGU2), M, NGU, D}; pg8::StaticOrder S; S.init(M, NGU, G, bx);
        pg8::EpiSwiglu E{HB, FF};
        pg8::gemm_phase<pg8::EpiSwiglu, pg8::StaticOrder, true, true>(lds, g, S, E);
    } SEAM(10);
    if (IN(11)) {
        pg8::Gemm g{HB, (const bf16*)(ws + WS_WD2), M, D, FF}; pg8::StaticOrder S; S.init(M, D, G, bx);
        pg8::EpiRes<false> E{a.out, a.out, ALPHA, 0.5f};
        pg8::gemm_phase<pg8::EpiRes<false>, pg8::StaticOrder, true, true>(lds, g, S, E);
    } SEAM(11);
    if (IN(12)) { ln_phase(a.out, a.out, nullptr, a.in[20], a.in[21], gw, NGW, lane); }
#undef IN
#undef SEAM
}

constexpr int NPHASE = 13;
#ifndef MK_MULTI
#define MK_MULTI 0
#endif
extern "C" void kernel_launch(void* const* d_in, const int* in_sizes, int n_in, void* d_out, int out_size, void* d_ws, size_t ws_size, hipStream_t stream) {
    static int grid = 0;
    if (grid == 0) {
        if (n_in != 22 || out_size != M * D || ws_size < WS_END) { fprintf(stderr, "kernel_launch: unexpected shapes (n_in %d out %d ws %zu)\n", n_in, out_size, ws_size); grid = -1; return; }
        int dev = 0, cus = 0, per_cu = 0;
        hipGetDevice(&dev); hipDeviceGetAttribute(&cus, hipDeviceAttributeMultiprocessorCount, dev);
        if (hipFuncSetAttribute((const void*)fwd_kernel, hipFuncAttributeMaxDynamicSharedMemorySize, LDS_BYTES) != hipSuccess) { fprintf(stderr, "kernel_launch: hipFuncSetAttribute failed\n"); grid = -1; return; }
        hipOccupancyMaxActiveBlocksPerMultiprocessor(&per_cu, (const void*)fwd_kernel, 512, LDS_BYTES);
        (void)hipGetLastError();
        if (per_cu < 1) per_cu = 1;
        grid = cus * 1;
        fprintf(stderr, "kernel_launch: cus %d per_cu %d grid %d\n", cus, per_cu, grid);
    }
    if (grid < 0) return;
    Args a{};
    for (int i = 0; i < 22; ++i) a.in[i] = (const float*)d_in[i];
    a.out = (float*)d_out; a.ws = (unsigned char*)d_ws;
#if MK_MULTI
    for (int p = 0; p < NPHASE; ++p) { a.ph_lo = p; a.ph_hi = p + 1; a.coop = 0; hipLaunchKernelGGL(fwd_kernel, dim3(grid), dim3(512), LDS_BYTES, stream, a); }
#else
    a.ph_lo = 0; a.ph_hi = NPHASE; a.coop = 1;
    void* args[] = {&a};
    hipError_t e = hipLaunchCooperativeKernel((const void*)fwd_kernel, dim3(grid), dim3(512), args, LDS_BYTES, stream);
    if (e != hipSuccess) fprintf(stderr, "cooperative launch failed: %s (grid %d)\n", hipGetErrorString(e), grid);
#endif
}
```

```cpp
#include <hip/hip_runtime.h>
#include <hip/hip_cooperative_groups.h>
#include <cstdio>
#include <cstdint>
namespace cg = cooperative_groups;
#define LAS __attribute__((address_space(3)))
namespace pg8 {
#define PG8_LAS __attribute__((address_space(3)))
typedef unsigned short bf16_t;
typedef short bf16x8 __attribute__((ext_vector_type(8)));
typedef float f32x4 __attribute__((ext_vector_type(4)));
typedef unsigned u32x4 __attribute__((ext_vector_type(4)));
constexpr int BM = 256, BK = 64, HALF = 128, HTB = HALF * BK * 2  , STAGE_BYTES = 8 * HTB, NXCD = 8, WGM = 8;

__host__ __device__ __forceinline__ int lds_byte(int r, int c) { const int st = (r >> 4) * 2 + (c >> 5), rr = r & 15, cc = c & 31, ob = rr * 64 + cc * 2; return st * 1024 + (ob ^ (((ob >> 9) & 1) << 5)); }
__host__ __device__ __forceinline__ void stage_rc(int b, int& R, int& C) { const int st = b / 1024, sb = b % 1024, swz = sb ^ (((sb >> 9) & 1) << 5); R = (st >> 1) * 16 + swz / 64; C = (st & 1) * 32 + (swz % 64) / 2; }
__host__ __device__ __forceinline__ int perm32(int rho) { const int n = rho >> 4, i = rho & 15; return 8 * (i >> 2) + 4 * n + (i & 3); }

struct Unit { int pm, pn; };
struct Gemm { const bf16_t* A; const bf16_t* Bt; int M, N, K; };

struct StaticOrder {
    int nM, nN, nwg, G, c;
    __host__ __device__ void init(int M, int N, int G_, int c_) { nM = M / BM; nN = N / BM; nwg = nM * nN; G = G_; c = c_; }
    __host__ __device__ bool next(int i, Unit& u) const {
        const long L = (long)i * G + c; if (L >= nwg) return false;
        int wgid = (int)L; { const int q = nwg / NXCD, r = nwg % NXCD, xcd = wgid % NXCD, off = wgid / NXCD; wgid = (xcd < r ? xcd * (q + 1) : r * (q + 1) + (xcd - r) * q) + off; }
        const int nig = WGM * nN, gid = wgid / nig, fm = gid * WGM, gsz = (nM - fm) < WGM ? (nM - fm) : WGM;
        u.pm = fm + ((wgid % nig) % gsz); u.pn = (wgid % nig) / gsz; return true;
    }
    __device__ __forceinline__ void a_ready(const Unit&) const {}
    __device__ __forceinline__ void done(const Unit&) const {}
};

__device__ __forceinline__ unsigned cvt_pk_bf16(float lo, float hi) { unsigned r; asm volatile("v_cvt_pk_bf16_f32 %0, %1, %2" : "=v"(r) : "v"(lo), "v"(hi)); return r; }
typedef float f32x2 __attribute__((ext_vector_type(2)));
template <class Epi, class Sched, bool ALIGN_EPI = false, bool SP2 = false>
__device__ __forceinline__ void gemm_phase(PG8_LAS unsigned char* lds, const Gemm g, const Sched& S, const Epi& E) {
    const int tid = threadIdx.x, wid = __builtin_amdgcn_readfirstlane(tid >> 6), lane = tid & 63, wr = wid >> 2, wc = wid & 3, fr = lane & 15, fq = lane >> 4;
    const int K = g.K, nt = K / BK;
    unsigned voffA[2], voffB[2];
#pragma unroll
    for (int i = 0; i < 2; ++i) { int R, C; stage_rc(tid * 16 + i * 8192, R, C); const int Rb = Epi::PERM ? ((R & ~31) + perm32(R & 31)) : R;
        voffA[i] = (unsigned)(R * K + C) * 2u; voffB[i] = (unsigned)(Rb * K + C) * 2u; }
    const size_t kstep = (size_t)(BK * 2);
    const size_t hstep = (size_t)HALF * K * 2;
    const size_t tstep = 2 * hstep;
    const unsigned ldsw = (unsigned)wid * 1024u;
    const int aoff = lds_byte(wr * 64 + fr, fq * 8), boff = lds_byte(wc * 32 + fr, fq * 8);
#define PG8_SA(b, h) (((b) * 2 + (h)) * HTB)
#define PG8_SB(b, h) ((4 + (b) * 2 + (h)) * HTB)
#define PG8_STAGE(bufoff, gbase, voff) do { _Pragma("unroll") for (int _i = 0; _i < 2; ++_i) \
        __builtin_amdgcn_global_load_lds((const unsigned*)((const char*)(gbase) + (voff)[_i]), (PG8_LAS unsigned*)(lds + (bufoff) + ldsw + _i * 8192), 16, 0, 0); } while (0)
#define PG8_LDA(dst, b, h) do { _Pragma("unroll") for (int m = 0; m < 4; ++m) _Pragma("unroll") for (int k = 0; k < 2; ++k) dst[m][k] = *(const PG8_LAS bf16x8*)(lds + PG8_SA(b, h) + aoff + m * 2048 + k * 1024); } while (0)
#define PG8_LDB(dst, b, h) do { _Pragma("unroll") for (int n = 0; n < 2; ++n) _Pragma("unroll") for (int k = 0; k < 2; ++k) dst[n][k] = *(const PG8_LAS bf16x8*)(lds + PG8_SB(b, h) + boff + n * 2048 + k * 1024); } while (0)
#define PG8_MMA(ai, bj, At, Bt) do { __builtin_amdgcn_s_setprio(1); _Pragma("unroll") for (int m = 0; m < 4; ++m) _Pragma("unroll") for (int n = 0; n < 2; ++n) _Pragma("unroll") for (int k = 0; k < 2; ++k) \
        acc[ai][bj][m][n] = __builtin_amdgcn_mfma_f32_16x16x32_bf16(Bt[n][k], At[m][k], acc[ai][bj][m][n], 0, 0, 0); __builtin_amdgcn_s_setprio(0); } while (0)
#define PG8_WAIT_V(n) asm volatile("s_waitcnt vmcnt(" #n ")" ::: "memory")
#define PG8_WAIT_L(n) asm volatile("s_waitcnt lgkmcnt(" #n ")" ::: "memory")
#define PG8_BAR __builtin_amdgcn_s_barrier()
#define PG8_SCHED __builtin_amdgcn_sched_barrier(0)
    Unit cur, nxt; int ui = 0;
    if (!S.next(0, cur)) return;
    f32x4 acc[2][2][4][2];
#pragma unroll
    for (int a = 0; a < 2; ++a)
#pragma unroll
        for (int b = 0; b < 2; ++b)
#pragma unroll
            for (int m = 0; m < 4; ++m)
#pragma unroll
                for (int n = 0; n < 2; ++n) acc[a][b][m][n] = (f32x4){0.f, 0.f, 0.f, 0.f};
    bf16x8 At[4][2], B0[2][2], B1[2][2];
    const char* cA = (const char*)g.A + (size_t)cur.pm * tstep; const char* cB = (const char*)g.Bt + (size_t)cur.pn * tstep;
    S.a_ready(cur);
    if constexpr (SP2) {
        PG8_STAGE(PG8_SB(0, 0), cB, voffB); PG8_STAGE(PG8_SB(0, 1), cB + hstep, voffB); PG8_STAGE(PG8_SA(0, 0), cA, voffA); PG8_STAGE(PG8_SA(0, 1), cA + hstep, voffA);
        if (wr == 1) PG8_BAR;
        PG8_WAIT_V(2); PG8_BAR;
        PG8_STAGE(PG8_SB(1, 0), cB + kstep, voffB); PG8_STAGE(PG8_SA(1, 0), cA + kstep, voffA); PG8_STAGE(PG8_SB(1, 1), cB + hstep + kstep, voffB);
        PG8_WAIT_V(6); PG8_BAR;
    } else {
        PG8_STAGE(PG8_SB(0, 0), cB, voffB); PG8_STAGE(PG8_SA(0, 0), cA, voffA); PG8_STAGE(PG8_SB(0, 1), cB + hstep, voffB); PG8_STAGE(PG8_SA(0, 1), cA + hstep, voffA);
        if (wr == 1) PG8_BAR;
        PG8_WAIT_V(4); PG8_BAR;
        PG8_STAGE(PG8_SB(1, 0), cB + kstep, voffB); PG8_STAGE(PG8_SA(1, 0), cA + kstep, voffA); PG8_STAGE(PG8_SB(1, 1), cB + hstep + kstep, voffB);
        PG8_WAIT_V(6); PG8_BAR;
    }
    for (;;) {
        const bool has_next = S.next(ui + 1, nxt);
        const char* nA = has_next ? (const char*)g.A + (size_t)nxt.pm * tstep : cA; const char* nB = has_next ? (const char*)g.Bt + (size_t)nxt.pn * tstep : cB;
        for (int t = 0; t < nt; t += 2) {
            const bool last = (t == nt - 2);
            const char* a1 = cA + (size_t)(t + 1) * kstep;
            const char* a2 = last ? nA : cA + (size_t)(t + 2) * kstep; const char* b2 = last ? nB : cB + (size_t)(t + 2) * kstep;
            const char* a3 = a2 + kstep; const char* b3 = b2 + kstep;
            if (last && has_next) S.a_ready(nxt);
            if constexpr (SP2) {
            PG8_LDB(B0, 0, 0); PG8_LDB(B1, 0, 1); PG8_SCHED; PG8_LDA(At, 0, 0); PG8_STAGE(PG8_SA(1, 1), a1 + hstep, voffA);
            PG8_WAIT_V(8); PG8_WAIT_L(0); PG8_BAR; PG8_MMA(0, 0, At, B0); PG8_MMA(0, 1, At, B1); PG8_BAR; PG8_SCHED;
            PG8_LDA(At, 0, 1); PG8_STAGE(PG8_SB(0, 0), b2, voffB); PG8_STAGE(PG8_SB(0, 1), b2 + hstep, voffB); PG8_STAGE(PG8_SA(0, 0), a2, voffA);
            PG8_WAIT_V(8); PG8_WAIT_L(0); PG8_BAR; PG8_MMA(1, 0, At, B0); PG8_MMA(1, 1, At, B1); PG8_BAR; PG8_SCHED;
            PG8_LDB(B0, 1, 0); PG8_LDB(B1, 1, 1); PG8_SCHED; PG8_LDA(At, 1, 0); PG8_STAGE(PG8_SA(0, 1), a2 + hstep, voffA);
            PG8_WAIT_V(8); PG8_WAIT_L(0); PG8_BAR; PG8_MMA(0, 0, At, B0); PG8_MMA(0, 1, At, B1); PG8_BAR; PG8_SCHED;
            PG8_LDA(At, 1, 1); PG8_STAGE(PG8_SB(1, 0), b3, voffB); PG8_STAGE(PG8_SB(1, 1), b3 + hstep, voffB); PG8_STAGE(PG8_SA(1, 0), a3, voffA);
            PG8_WAIT_V(8); PG8_WAIT_L(0); PG8_BAR; PG8_MMA(1, 0, At, B0); PG8_MMA(1, 1, At, B1); PG8_BAR; PG8_SCHED;
            } else {
            PG8_LDB(B0, 0, 0); PG8_SCHED; PG8_LDA(At, 0, 0); PG8_STAGE(PG8_SA(1, 1), a1 + hstep, voffA);
            PG8_WAIT_L(8); PG8_BAR; PG8_WAIT_L(0); PG8_MMA(0, 0, At, B0); PG8_BAR; PG8_SCHED;
            PG8_LDB(B1, 0, 1); PG8_STAGE(PG8_SB(0, 0), b2, voffB);
            PG8_BAR; PG8_WAIT_L(0); PG8_MMA(0, 1, At, B1); PG8_BAR;
            PG8_LDA(At, 0, 1); PG8_STAGE(PG8_SA(0, 0), a2, voffA);
            PG8_BAR; PG8_WAIT_L(0); PG8_MMA(1, 0, At, B0); PG8_BAR; PG8_SCHED;
            PG8_STAGE(PG8_SB(0, 1), b2 + hstep, voffB);
            PG8_WAIT_V(6); PG8_BAR; PG8_MMA(1, 1, At, B1); PG8_BAR;
            PG8_LDB(B0, 1, 0); PG8_SCHED; PG8_LDA(At, 1, 0); PG8_STAGE(PG8_SA(0, 1), a2 + hstep, voffA);
            PG8_WAIT_L(8); PG8_BAR; PG8_WAIT_L(0); PG8_MMA(0, 0, At, B0); PG8_BAR; PG8_SCHED;
            PG8_LDB(B1, 1, 1); PG8_STAGE(PG8_SB(1, 0), b3, voffB);
            PG8_BAR; PG8_WAIT_L(0); PG8_MMA(0, 1, At, B1); PG8_BAR;
            PG8_LDA(At, 1, 1); PG8_STAGE(PG8_SA(1, 0), a3, voffA);
            PG8_BAR; PG8_WAIT_L(0); PG8_MMA(1, 0, At, B0); PG8_BAR; PG8_SCHED;
            PG8_STAGE(PG8_SB(1, 1), b3 + hstep, voffB);
            PG8_WAIT_V(6); PG8_BAR; PG8_MMA(1, 1, At, B1); PG8_BAR;
            }
        }
        if constexpr (ALIGN_EPI) { if (wr == 0) PG8_BAR; }
        if constexpr (!Epi::AFTER_DRAIN) { E(acc, cur, wr, wc, fr, fq); S.done(cur); }
        if (!has_next) break;
#pragma unroll
        for (int a = 0; a < 2; ++a)
#pragma unroll
            for (int b = 0; b < 2; ++b)
#pragma unroll
                for (int m = 0; m < 4; ++m)
#pragma unroll
                    for (int n = 0; n < 2; ++n) acc[a][b][m][n] = (f32x4){0.f, 0.f, 0.f, 0.f};
        cur = nxt; cA = nA; cB = nB; ++ui;
        if constexpr (ALIGN_EPI) { if (wr == 1) PG8_BAR; }
    }
    PG8_WAIT_V(0);
    if constexpr (!ALIGN_EPI) { if (wr == 0) PG8_BAR; }
    PG8_BAR;
    if constexpr (Epi::AFTER_DRAIN) { E.fused(acc, cur, wr, wc, fr, fq, lds, wid, lane); S.done(cur); }
#undef PG8_SA
#undef PG8_SB
#undef PG8_STAGE
#undef PG8_LDA
#undef PG8_LDB
#undef PG8_MMA
#undef PG8_WAIT_V
#undef PG8_WAIT_L
#undef PG8_BAR
#undef PG8_SCHED
}
}

namespace pg8 {
__device__ __forceinline__ float silu_f(float x) { return x * __builtin_amdgcn_rcpf(1.0f + __expf(-x)); }
__device__ __forceinline__ float bflo_f(unsigned u) { return __uint_as_float(u << 16); }
__device__ __forceinline__ float bfhi_f(unsigned u) { return __uint_as_float(u & 0xffff0000u); }

struct EpiSwiglu {
    static constexpr bool PERM = true, AFTER_DRAIN = false;
    bf16_t* O; int ldc;
    __device__ __forceinline__ void operator()(const f32x4 (&acc)[2][2][4][2], const Unit& u, int wr, int wc, int fr, int fq) const {
        const int row0 = u.pm * BM + wr * 64 + fr, col0 = u.pn * HALF + wc * 32 + 8 * fq;
#pragma unroll
        for (int ai = 0; ai < 2; ++ai)
#pragma unroll
            for (int m = 0; m < 4; ++m) {
                bf16_t* rowp = O + (size_t)(row0 + ai * HALF + m * 16) * ldc + col0;
                const f32x4 g0 = acc[ai][0][m][0], g1 = acc[ai][0][m][1], u0 = acc[ai][1][m][0], u1 = acc[ai][1][m][1];
                u32x4 w;
                w.x = cvt_pk_bf16(silu_f(g0[0]) * u0[0], silu_f(g0[1]) * u0[1]);
                w.y = cvt_pk_bf16(silu_f(g0[2]) * u0[2], silu_f(g0[3]) * u0[3]);
                w.z = cvt_pk_bf16(silu_f(g1[0]) * u1[0], silu_f(g1[1]) * u1[1]);
                w.w = cvt_pk_bf16(silu_f(g1[2]) * u1[2], silu_f(g1[3]) * u1[3]);
                *(u32x4*)rowp = w;
            }
    }
};

template <bool RES_BF16> struct EpiRes {
    static constexpr bool PERM = true, AFTER_DRAIN = false;
    const void* res; float* out; float alpha, scale;
    __device__ __forceinline__ void operator()(const f32x4 (&acc)[2][2][4][2], const Unit& u, int wr, int wc, int fr, int fq) const {
#pragma unroll
        for (int ai = 0; ai < 2; ++ai)
#pragma unroll
            for (int m = 0; m < 4; ++m) {
                const int row = u.pm * BM + wr * 64 + fr + ai * HALF + m * 16;
#pragma unroll
                for (int bj = 0; bj < 2; ++bj) {
                    const int col = u.pn * BM + bj * HALF + wc * 32 + 8 * fq; const size_t off = (size_t)row * 1024 + col;
                    f32x4 r0, r1;
                    if (RES_BF16) { const u32x4 rw = *(const u32x4*)((const bf16_t*)res + off);
                        r0 = (f32x4){bflo_f(rw.x), bfhi_f(rw.x), bflo_f(rw.y), bfhi_f(rw.y)}; r1 = (f32x4){bflo_f(rw.z), bfhi_f(rw.z), bflo_f(rw.w), bfhi_f(rw.w)}; }
                    else { r0 = *(const f32x4*)((const float*)res + off); r1 = *(const f32x4*)((const float*)res + off + 4); }
                    const f32x4 o0 = r0 * alpha + acc[ai][bj][m][0] * scale, o1 = r1 * alpha + acc[ai][bj][m][1] * scale;
                    *(f32x4*)(out + off) = o0; *(f32x4*)(out + off + 4) = o1;
                }
            }
    }
};

struct EpiProj {
    static constexpr bool PERM = true, AFTER_DRAIN = false;
    bf16_t* P; float* SM;
    __device__ __forceinline__ void operator()(const f32x4 (&acc)[2][2][4][2], const Unit& u, int wr, int wc, int fr, int fq) const {
        const int row0 = u.pm * BM + wr * 64 + fr;
        if (u.pn < 14) {
            const int col0 = u.pn * BM + wc * 32 + 8 * fq;
#pragma unroll
            for (int ai = 0; ai < 2; ++ai)
#pragma unroll
                for (int m = 0; m < 4; ++m) { bf16_t* rowp = P + (size_t)(row0 + ai * HALF + m * 16) * 3584 + col0;
#pragma unroll
                    for (int bj = 0; bj < 2; ++bj) { const f32x4 v0 = acc[ai][bj][m][0], v1 = acc[ai][bj][m][1];
                        u32x4 w; w.x = cvt_pk_bf16(v0[0], v0[1]); w.y = cvt_pk_bf16(v0[2], v0[3]); w.z = cvt_pk_bf16(v1[0], v1[1]); w.w = cvt_pk_bf16(v1[2], v1[3]);
                        *(u32x4*)(rowp + bj * HALF) = w; } }
        } else if (wc == 0) {
#pragma unroll
            for (int ai = 0; ai < 2; ++ai)
#pragma unroll
                for (int m = 0; m < 4; ++m) { float* rowp = SM + (size_t)(row0 + ai * HALF + m * 16) * 32 + 8 * fq;
                    *(f32x4*)rowp = acc[ai][0][m][0]; *(f32x4*)(rowp + 4) = acc[ai][0][m][1]; }
        }
    }
};
}
#define XB_TMO      128
#define XB_XCNT(j)  (256  + 64 * (j))
#define XB_XSUB(j)  (1280 + 64 * (j))
#define XB_XGEN(j)  (2304 + 64 * (j))
#define XB_TOP      3328
#define XB_TOPGEN   3392
#define XCD_BAR_WORDS 3456
#define XB_SPIN_CAP (1u << 18)

__device__ __forceinline__ unsigned xb_ld(unsigned* p)              { return __hip_atomic_load(p, __ATOMIC_RELAXED, __HIP_MEMORY_SCOPE_AGENT); }
__device__ __forceinline__ unsigned xb_add(unsigned* p, unsigned v) { return __hip_atomic_fetch_add(p, v, __ATOMIC_RELAXED, __HIP_MEMORY_SCOPE_AGENT); }
__device__ __forceinline__ unsigned xb_xcc_id() { return (unsigned)__builtin_amdgcn_s_getreg((3 << 11) | 20) & 0xFu; }
#define XB_SPIN(cond, bar) do { unsigned _sp = 0; while (cond) { __builtin_amdgcn_s_sleep(1); \
    if ((++_sp & 255u) == 0u) { if (xb_ld(&(bar)[XB_TMO])) break; if (_sp > XB_SPIN_CAP) { atomicAdd(&(bar)[XB_TMO], 1u); break; } } } } while (0)

struct XcdBarrier {
    unsigned* bar; unsigned x;
    volatile LAS unsigned* st;
};

__device__ __forceinline__ XcdBarrier xcd_barrier_post(unsigned* bar, volatile LAS unsigned* st) {
    XcdBarrier b; b.bar = bar; b.x = xb_xcc_id(); b.st = st;
    if (threadIdx.x == 0) (void)xb_add(&bar[XB_XCNT(b.x)], 1u);
    return b;
}
__device__ __forceinline__ void xcd_barrier_complete(unsigned* bar, unsigned x, unsigned& nloc, unsigned& nx) {
    const unsigned G = gridDim.x * gridDim.y * gridDim.z;
    unsigned sum, cnt, mine, sp = 0u;
    for (;;) {
        sum = 0u; cnt = 0u; mine = 0u;
#pragma unroll
        for (unsigned j = 0; j < 16; ++j) { const unsigned c = xb_ld(&bar[XB_XCNT(j)]); sum += c; cnt += (c > 0u) ? 1u : 0u; mine = (j == x) ? c : mine; }
        if (sum == G) break;
        __builtin_amdgcn_s_sleep(1);
        if ((++sp & 255u) == 0u) { if (xb_ld(&bar[XB_TMO])) break; if (sp > XB_SPIN_CAP) { atomicAdd(&bar[XB_TMO], 1u); break; } }
    }
    nloc = mine > 0u ? mine : 1u; nx = cnt > 0u ? cnt : 1u;
}

__device__ __forceinline__ void xcd_barrier(const XcdBarrier& b) {
    asm volatile("s_waitcnt vmcnt(0)" ::: "memory");
    __syncthreads();
    if (threadIdx.x == 0) {
        unsigned* bar = b.bar;
        __builtin_amdgcn_s_waitcnt(0);
        unsigned nloc = b.st[0], nx = b.st[1];
        if (nloc == 0u) { xcd_barrier_complete(bar, b.x, nloc, nx); b.st[0] = nloc; b.st[1] = nx; }
        const unsigned old = xb_add(&bar[XB_XSUB(b.x)], 1u);
        const unsigned gen = old / nloc;
        if (old + 1u == (gen + 1u) * nloc) {
            __builtin_amdgcn_fence(__ATOMIC_RELEASE, "agent");
            asm volatile("s_waitcnt vmcnt(0)" ::: "memory");
            const unsigned og = xb_add(&bar[XB_TOP], 1u);
            const unsigned tg = og / nx;
            if (og + 1u == (tg + 1u) * nx) xb_add(&bar[XB_TOPGEN], 1u);
            else XB_SPIN(xb_ld(&bar[XB_TOPGEN]) == tg, bar);
            __builtin_amdgcn_fence(__ATOMIC_ACQUIRE, "agent");
            xb_add(&bar[XB_XGEN(b.x)], 1u);
            asm volatile("s_waitcnt vmcnt(0)" ::: "memory");
        } else {
            XB_SPIN(xb_ld(&bar[XB_XGEN(b.x)]) == gen, bar);
            __builtin_amdgcn_fence(__ATOMIC_ACQUIRE, "agent");
            asm volatile("s_waitcnt vmcnt(0)" ::: "memory");
        }
    }
    __syncthreads();
}

typedef unsigned short bf16;
typedef unsigned u32x4 __attribute__((ext_vector_type(4)));
typedef unsigned u32x2 __attribute__((ext_vector_type(2)));
typedef float f32x4 __attribute__((ext_vector_type(4)));
typedef short bf16x8 __attribute__((ext_vector_type(8)));
typedef float f32x2_t __attribute__((ext_vector_type(2)));
typedef __bf16 bf16x2_t __attribute__((ext_vector_type(2)));

constexpr int M = 32768, D = 1024, FF = 2816, NGU = 2 * FF, NPROJ = 3840, PW = 3584, SEQ = 8192, NCHK = 128, NCH = 2048;
constexpr int WIN_N = 3608;
constexpr float ALPHA = 1.189207115002721f;
constexpr float LN_EPS = 1e-5f, RMS_EPS = 1e-6f;
constexpr size_t MiB = 1u << 20;
constexpr size_t WS_WGU1 = 1 * MiB, WS_WD1 = 12 * MiB, WS_WIN = 18 * MiB, WS_WOUT = 26 * MiB, WS_WGU2 = 28 * MiB, WS_WD2 = 39 * MiB, WS_SMALL = 45 * MiB;
constexpr size_t WS_HP = 49 * MiB;
constexpr size_t WS_XB = 273 * MiB;
constexpr size_t WS_MIX = 337 * MiB;
constexpr size_t WS_DW = 401 * MiB, WS_DQ = 433 * MiB, WS_DK = 465 * MiB, WS_GE = 497 * MiB, WS_DGL = 498 * MiB, WS_END = 512 * MiB;
constexpr size_t OS_DU = 0, OS_GQ = 32 * MiB, OS_GA = 48 * MiB, OS_GK = 64 * MiB, OS_GV = 80 * MiB, OS_DQK = 112 * MiB;
constexpr int LDS_BYTES = 147456;
constexpr int NPART = 4, CW = 128 / NPART, NCWAVE = CW / 16;

__device__ __forceinline__ unsigned pk2(float lo, float hi) { f32x2_t v = {lo, hi}; bf16x2_t b = __builtin_convertvector(v, bf16x2_t); return __builtin_bit_cast(unsigned, b); }
__device__ __forceinline__ unsigned short f2bf(float f) { return (unsigned short)(pk2(f, 0.f) & 0xffffu); }
__device__ __forceinline__ float bf2f(unsigned short h) { return __uint_as_float((unsigned)h << 16); }
__device__ __forceinline__ float bflo(unsigned u) { return __uint_as_float(u << 16); }
__device__ __forceinline__ float bfhi(unsigned u) { return __uint_as_float(u & 0xffff0000u); }
__device__ __forceinline__ float silu(float x) { return x / (1.0f + __expf(-x)); }
__device__ __forceinline__ int kperm(int a) { return (a & ~31) | (((a >> 2) & 3) << 3) | (((a >> 4) & 1) << 2) | (a & 3); }
__device__ __forceinline__ float wave_sum(float v) {
#pragma unroll
    for (int o = 1; o < 64; o <<= 1) v += __shfl_xor(v, o);
    return v;
}
template <class T> __device__ __forceinline__ T opaque_v(T p) { asm volatile("" : "+v"(p)); return p; }
#define MFMA16(a, b, c) __builtin_amdgcn_mfma_f32_16x16x32_bf16((a), (b), (c), 0, 0, 0)
__device__ __forceinline__ bf16x8 pack8(const f32x4& lo, const f32x4& hi) {
    u32x4 p; p.x = pk2(lo[0], lo[1]); p.y = pk2(lo[2], lo[3]); p.z = pk2(hi[0], hi[1]); p.w = pk2(hi[2], hi[3]); return __builtin_bit_cast(bf16x8, p);
}

#ifndef XREP_PHASE
#define XREP_PHASE -1
#define XREP_N 1
#define XREP_SYNC 0
#endif
struct Args { const float* in[22]; float* out; unsigned char* ws; int ph_lo, ph_hi, coop, pad; };

struct ColGU { const float* g; const float* u; __device__ __forceinline__ const float* operator()(int d) const { const int t = d >> 8, w = d & 255;
    const uintptr_t gp = (uintptr_t)g, up = (uintptr_t)u; const uintptr_t base = gp + (uintptr_t)((w >> 7) & 1) * (up - gp); return (const float*)base + t * 128 + (w & 127); } };
struct ColPlain { const float* w; __device__ __forceinline__ const float* operator()(int d) const { return w + d; } };
struct ColWin { const float* w; __device__ __forceinline__ const float* operator()(int d) const {
    if (d < 2048) return w + d; if (d < 3584) return w + d + 8; if (d < 3592) return w + d - 1536; if (d < 3608) return w + d; return nullptr; } };

template <class ColPtr>
__device__ __forceinline__ void transpose_item(const ColPtr& cp, int nsrc, int K, bf16* WT, LAS float* scr, int kb, int nb, int lane) {
    const int k0 = 64 * kb, n0 = 32 * nb;
    const float* colp = cp(n0 + (lane & 31));
#pragma unroll 8
    for (int i = 0; i < 32; ++i) { const int kk = 2 * i + (lane >> 5); scr[kk * 33 + (lane & 31)] = colp ? colp[(size_t)(k0 + kk) * nsrc] : 0.f; }
    asm volatile("s_waitcnt lgkmcnt(0)" ::: "memory");
    const int c = lane & 7;
#pragma unroll
    for (int j = 0; j < 4; ++j) { const int n = (lane >> 3) + 8 * j; const LAS float* s = scr + (8 * c) * 33 + n;
        u32x4 o; o.x = pk2(s[0 * 33], s[1 * 33]); o.y = pk2(s[2 * 33], s[3 * 33]); o.z = pk2(s[4 * 33], s[5 * 33]); o.w = pk2(s[6 * 33], s[7 * 33]);
        *(u32x4*)(WT + (size_t)(n0 + n) * K + k0 + 8 * c) = o; }
    asm volatile("s_waitcnt lgkmcnt(0)" ::: "memory");
}

__device__ __forceinline__ void prologue(const Args& a, LAS unsigned char* lds, int gw, int NGW, int wave, int lane) {
    unsigned char* ws = a.ws;
    LAS float* scr = (LAS float*)(lds + wave * 16384);
    constexpr int I_GU = 16 * (NGU / 32), I_D = (FF / 64) * (D / 32), I_IN = 16 * (NPROJ / 32), I_O = 16 * (D / 32);
    constexpr int NITEMS = 2 * I_GU + 2 * I_D + I_IN + I_O;
    for (int it = gw; it < NITEMS; it += NGW) {
        int r = it;
        if (r < I_GU) { ColGU c{a.in[1], a.in[2]}; transpose_item(c, FF, D, (bf16*)(ws + WS_WGU1), scr, r / (NGU / 32), r % (NGU / 32), lane); continue; } r -= I_GU;
        if (r < I_GU) { ColGU c{a.in[17], a.in[18]}; transpose_item(c, FF, D, (bf16*)(ws + WS_WGU2), scr, r / (NGU / 32), r % (NGU / 32), lane); continue; } r -= I_GU;
        if (r < I_D) { ColPlain c{a.in[3]}; transpose_item(c, D, FF, (bf16*)(ws + WS_WD1), scr, r / (D / 32), r % (D / 32), lane); continue; } r -= I_D;
        if (r < I_D) { ColPlain c{a.in[19]}; transpose_item(c, D, FF, (bf16*)(ws + WS_WD2), scr, r / (D / 32), r % (D / 32), lane); continue; } r -= I_D;
        if (r < I_IN) { ColWin c{a.in[6]}; transpose_item(c, WIN_N, D, (bf16*)(ws + WS_WIN), scr, r / (NPROJ / 32), r % (NPROJ / 32), lane); continue; } r -= I_IN;
        { ColPlain c{a.in[14]}; transpose_item(c, D, D, (bf16*)(ws + WS_WOUT), scr, r / (D / 32), r % (D / 32), lane); }
    }
    const float* x = a.in[0]; bf16* xb = (bf16*)(ws + WS_XB);
    const size_t nthr = (size_t)NGW * 64, t0 = (size_t)gw * 64 + lane;
    for (size_t i = t0; i < (size_t)M * D / 8; i += nthr) {
        const f32x4 v0 = *(const f32x4*)(x + i * 8), v1 = *(const f32x4*)(x + i * 8 + 4);
        u32x4 o; o.x = pk2(v0[0], v0[1]); o.y = pk2(v0[2], v0[3]); o.z = pk2(v1[0], v1[1]); o.w = pk2(v1[2], v1[3]);
        *(u32x4*)(xb + i * 8) = o;
    }
}

__device__ __forceinline__ void ln_phase(const float* Y, float* Xf, bf16* Xb, const float* g, const float* b, int gw, int NGW, int lane) {
    f32x4 gv[4], bv[4];
#pragma unroll
    for (int j = 0; j < 4; ++j) { gv[j] = *(const f32x4*)(g + 4 * lane + 256 * j); bv[j] = *(const f32x4*)(b + 4 * lane + 256 * j); }
    for (int m = gw; m < M; m += NGW) {
        const f32x4* yr = (const f32x4*)(Y + (size_t)m * D) + lane;
        f32x4 v[4]; float s = 0.f;
#pragma unroll
        for (int j = 0; j < 4; ++j) { v[j] = yr[64 * j]; s += (v[j][0] + v[j][1]) + (v[j][2] + v[j][3]); }
        const float mean = wave_sum(s) * (1.f / D); float s2 = 0.f;
#pragma unroll
        for (int j = 0; j < 4; ++j) { v[j] = v[j] - mean; s2 += (v[j][0] * v[j][0] + v[j][1] * v[j][1]) + (v[j][2] * v[j][2] + v[j][3] * v[j][3]); }
        const float rstd = 1.0f / sqrtf(wave_sum(s2) * (1.f / D) + LN_EPS);
#pragma unroll
        for (int j = 0; j < 4; ++j) {
            const f32x4 o = v[j] * rstd * gv[j] + bv[j];
            if (Xf) *((f32x4*)(Xf + (size_t)m * D) + lane + 64 * j) = o;
            if (Xb) { u32x2 w; w.x = pk2(o[0], o[1]); w.y = pk2(o[2], o[3]); *((u32x2*)(Xb + (size_t)m * D) + lane + 64 * j) = w; }
        }
    }
}

__device__ __forceinline__ void gnorm_phase(bf16* MIX, const bf16* P, const float* wa, const float* wb, int gw, int NGW, int lane) {
    const int hd = lane >> 3, cc = (lane & 7) * 16;
    const float* wn = (hd < 4 ? wa : wb) + cc;
    float wv[16];
#pragma unroll
    for (int j = 0; j < 16; ++j) wv[j] = wn[j];
    const int gcol = (hd < 4 ? 1536 : 3072) + (hd & 3) * 128 + cc;
    for (int m = gw; m < M; m += NGW) {
        bf16* op = MIX + (size_t)m * D + lane * 16;
        const u32x4 o0 = *(const u32x4*)op, o1 = *(const u32x4*)(op + 8);
        const u32x4 g0 = *(const u32x4*)(P + (size_t)m * PW + gcol), g1 = *(const u32x4*)(P + (size_t)m * PW + gcol + 8);
        float o[16], g[16];
#pragma unroll
        for (int j = 0; j < 4; ++j) { o[2 * j] = bflo(o0[j]); o[2 * j + 1] = bfhi(o0[j]); o[8 + 2 * j] = bflo(o1[j]); o[9 + 2 * j] = bfhi(o1[j]);
                                      g[2 * j] = bflo(g0[j]); g[2 * j + 1] = bfhi(g0[j]); g[8 + 2 * j] = bflo(g1[j]); g[9 + 2 * j] = bfhi(g1[j]); }
        float ss = 0.f;
#pragma unroll
        for (int j = 0; j < 16; ++j) ss += o[j] * o[j];
        ss += __shfl_xor(ss, 1); ss += __shfl_xor(ss, 2); ss += __shfl_xor(ss, 4);
        const float rs = 1.0f / sqrtf(ss * (1.f / 128.f) + RMS_EPS);
        u32x4 r0, r1;
#pragma unroll
        for (int j = 0; j < 4; ++j) {
            r0[j] = pk2(o[2 * j] * rs * wv[2 * j] * silu(g[2 * j]), o[2 * j + 1] * rs * wv[2 * j + 1] * silu(g[2 * j + 1]));
            r1[j] = pk2(o[8 + 2 * j] * rs * wv[8 + 2 * j] * silu(g[8 + 2 * j]), o[9 + 2 * j] * rs * wv[9 + 2 * j] * silu(g[9 + 2 * j]));
        }
        *(u32x4*)op = r0; *(u32x4*)(op + 8) = r1;
    }
}

constexpr int PK_KN = 0, PK_QN = 17408, PK_RHS = 34816, PK_QF = 100352, PK_SC = 133120;
__device__ __forceinline__ void gdn_prep_item(const Args& a, LAS unsigned char* lds_in, int item, int tid_in) {
    const int tid = opaque_v(tid_in); LAS unsigned char* lds = opaque_v(lds_in);
    const int n = item & 127, bh = item >> 7, h = bh & 3, b = bh >> 2;
    const int t0 = b * SEQ + n * 64, ci = item;
    const int lane = tid & 63, wid = tid >> 6;
    unsigned char* ws = a.ws;
    const bf16* P = (const bf16*)(ws + WS_HP);
    const float* SMALL = (const float*)(ws + WS_SMALL);
    LAS float* RHS = opaque_v((LAS float*)(lds + PK_RHS)); LAS float* QF = opaque_v((LAS float*)(lds + PK_QF)); LAS float* AM = QF; LAS float* SC = opaque_v((LAS float*)(lds + PK_SC));
    LAS unsigned char* KNp = opaque_v(lds + PK_KN); LAS unsigned char* QNp = opaque_v(lds + PK_QN);
    bf16* DW = (bf16*)(ws + WS_DW) + (size_t)ci * 8192; bf16* DQ = (bf16*)(ws + WS_DQ) + (size_t)ci * 8192; bf16* DK = (bf16*)(ws + WS_DK) + (size_t)ci * 8192;
    bf16* DQK = (bf16*)((unsigned char*)a.out + OS_DQK) + (size_t)ci * 4096; bf16* DU = (bf16*)((unsigned char*)a.out + OS_DU) + (size_t)ci * 8192;
    float* DGL = (float*)(ws + WS_DGL);
    if (tid < 64) {
        const float* sm = SMALL + (size_t)(t0 + tid) * 32;
        const float be = 1.0f / (1.0f + __expf(-sm[h]));
        const float xx = sm[4 + h] + a.in[9][h];
        const float sp = xx > 20.f ? xx : log1pf(__expf(xx));
        float G = -__expf(a.in[8][h]) * sp;
#pragma unroll
        for (int o = 1; o < 64; o <<= 1) { const float t = __shfl_up(G, o); if (lane >= o) G += t; }
        const float Gl = __shfl(G, 63);
        SC[tid] = G; SC[64 + tid] = be; SC[128 + tid] = __expf(G); SC[192 + tid] = __expf(Gl - G);
        if (tid == 63) DGL[ci] = __expf(G);
    }
    {
        const int c = tid & 127, rg = tid >> 7;
        const bool first = (n == 0 && rg == 0);
        const float* cw = a.in[7];
#pragma unroll
        for (int mat = 0; mat < 3; ++mat) {
            const int ch = mat * 512 + h * 128 + c;
            const float w0 = cw[ch], w1 = cw[1536 + ch], w2 = cw[3072 + ch], w3 = cw[4608 + ch];
            const bf16* src = P + (size_t)(t0 + rg * 16) * PW + ch;
            float x0 = 0.f, x1 = 0.f, x2 = 0.f;
            if (!first) { x0 = bf2f(*(src - 3 * PW)); x1 = bf2f(*(src - 2 * PW)); x2 = bf2f(*(src - PW)); }
#pragma unroll
            for (int r = 0; r < 16; ++r) {
                const float x3 = bf2f(src[(size_t)r * PW]);
                const float y = silu(w0 * x0 + w1 * x1 + w2 * x2 + w3 * x3);
                const int row = rg * 16 + r;
                if (mat == 0) QF[row * 128 + c] = y; else if (mat == 1) RHS[row * 256 + 128 + c] = y; else RHS[row * 256 + c] = y;
                x0 = x1; x1 = x2; x2 = x3;
            }
        }
    }
    __syncthreads();
    {
        const int r = tid >> 3, p = tid & 7;
        const float be = SC[64 + r], eg = SC[128 + r];
        float qv[16], kv[16]; float sq = 0.f, sk = 0.f;
#pragma unroll
        for (int j = 0; j < 16; ++j) { qv[j] = QF[r * 128 + p * 16 + j]; kv[j] = RHS[r * 256 + 128 + p * 16 + j]; sq += qv[j] * qv[j]; sk += kv[j] * kv[j]; }
        sq += __shfl_xor(sq, 1); sq += __shfl_xor(sq, 2); sq += __shfl_xor(sq, 4);
        sk += __shfl_xor(sk, 1); sk += __shfl_xor(sk, 2); sk += __shfl_xor(sk, 4);
        const float rq = (1.0f / sqrtf(sq + RMS_EPS)) * 0.08838834764831845f, rk = 1.0f / sqrtf(sk + RMS_EPS);
#pragma unroll
        for (int j = 0; j < 16; ++j) { qv[j] *= rq; kv[j] *= rk; RHS[r * 256 + 128 + p * 16 + j] = be * eg * kv[j]; RHS[r * 256 + p * 16 + j] *= be; }
        LAS unsigned* kn = (LAS unsigned*)(KNp + r * 272 + p * 32); LAS unsigned* qn = (LAS unsigned*)(QNp + r * 272 + p * 32);
#pragma unroll
        for (int j = 0; j < 8; ++j) { kn[j] = pk2(kv[2 * j], kv[2 * j + 1]); qn[j] = pk2(qv[2 * j], qv[2 * j + 1]); }
        const int gi = p >> 1, hi = p & 1;
#pragma unroll
        for (int q4 = 0; q4 < 4; ++q4) { u32x2 w; w.x = pk2(qv[4 * q4] * eg, qv[4 * q4 + 1] * eg); w.y = pk2(qv[4 * q4 + 2] * eg, qv[4 * q4 + 3] * eg);
            *(u32x2*)(DQ + r * 128 + gi * 32 + 8 * q4 + 4 * hi) = w; }
    }
    __syncthreads();
    {
        const int rb = wid & 3; const bool isqk = wid >= 4; const int r = lane & 15, q = lane >> 4;
        const LAS unsigned char* Ab = isqk ? QNp : KNp;
        f32x4 acc[4];
#pragma unroll
        for (int cb = 0; cb < 4; ++cb) acc[cb] = (f32x4){0.f, 0.f, 0.f, 0.f};
#pragma unroll
        for (int s = 0; s < 4; ++s) {
            const bf16x8 av = *(const LAS bf16x8*)(Ab + (16 * rb + r) * 272 + s * 64 + q * 16);
#pragma unroll
            for (int cb = 0; cb < 4; ++cb) { const bf16x8 bv = *(const LAS bf16x8*)(KNp + (16 * cb + r) * 272 + s * 64 + q * 16); acc[cb] = MFMA16(av, bv, acc[cb]); }
        }
#pragma unroll
        for (int cb = 0; cb < 4; ++cb)
#pragma unroll
            for (int i = 0; i < 4; ++i) {
                const int ii = 16 * rb + 4 * q + i, jj = 16 * cb + r;
                const float Gi = SC[ii], Gj = SC[jj];
                if (isqk) { const float v = (jj <= ii) ? acc[cb][i] * __expf(Gi - Gj) : 0.f; DQK[ii * 64 + kperm(jj)] = f2bf(v); }
                else { const float v = (jj < ii) ? SC[64 + ii] * acc[cb][i] * __expf(Gi - Gj) : 0.f; AM[ii * 64 + jj] = v; }
            }
    }
    __syncthreads();
    if (tid < 256) {
        const int c = tid; float x[64]; f32x4 ar[2][16]; float rn[2];
        rn[0] = RHS[c];
#pragma unroll
        for (int i = 0; i < 64; ++i) {
            if (i + 1 < 64) {
                rn[(i + 1) & 1] = RHS[(i + 1) * 256 + c];
#pragma unroll
                for (int jb = 0; jb < (i + 4) / 4; ++jb) ar[(i + 1) & 1][jb] = *(const LAS f32x4*)(AM + (i + 1) * 64 + 4 * jb);
            }
            __builtin_amdgcn_sched_barrier(0);
            float acc = rn[i & 1];
#pragma unroll
            for (int jb = 0; jb < (i + 3) / 4; ++jb) {
#pragma unroll
                for (int e = 0; e < 4; ++e) if (4 * jb + e < i) acc -= ar[i & 1][jb][e] * x[4 * jb + e];
            }
            x[i] = acc;
            __builtin_amdgcn_sched_barrier(0);
        }
        if (c < 128) {
#pragma unroll
            for (int k8 = 0; k8 < 8; ++k8) { u32x4 w; w.x = pk2(x[8 * k8], x[8 * k8 + 1]); w.y = pk2(x[8 * k8 + 2], x[8 * k8 + 3]); w.z = pk2(x[8 * k8 + 4], x[8 * k8 + 5]); w.w = pk2(x[8 * k8 + 6], x[8 * k8 + 7]);
                *(u32x4*)(DU + c * 64 + 8 * k8) = w; }
        } else {
            const int pc = kperm(c - 128);
#pragma unroll
            for (int i = 0; i < 64; ++i) DW[i * 128 + pc] = f2bf(x[i]);
        }
    } else if (tid < 384) {
        const int c = tid - 256;
        float v[64];
#pragma unroll
        for (int i = 0; i < 64; ++i) v[kperm(i)] = bf2f(*(const LAS unsigned short*)(KNp + i * 272 + c * 2)) * SC[192 + i];
#pragma unroll
        for (int k8 = 0; k8 < 8; ++k8) { u32x4 w; w.x = pk2(v[8 * k8], v[8 * k8 + 1]); w.y = pk2(v[8 * k8 + 2], v[8 * k8 + 3]); w.z = pk2(v[8 * k8 + 4], v[8 * k8 + 5]); w.w = pk2(v[8 * k8 + 6], v[8 * k8 + 7]);
            *(u32x4*)(DK + c * 64 + 8 * k8) = w; }
    }
    __syncthreads();
}

constexpr int GK_QT = 0, GK_KT = 9216, GK_PS = 18432, GK_LR = 20480;
__device__ __forceinline__ void gla_prep_item(const Args& a, LAS unsigned char* lds_in, int item, int tid_in) {
    const int tid = opaque_v(tid_in); LAS unsigned char* lds = opaque_v(lds_in);
    const int n = item & 127, bh = item >> 7, h = bh & 3, b = bh >> 2;
    const int t0 = b * SEQ + n * 64, ci = item;
    const int lane = tid & 63, wid = tid >> 6;
    unsigned char* ws = a.ws;
    const bf16* P = (const bf16*)(ws + WS_HP);
    const float* SMALL = (const float*)(ws + WS_SMALL);
    unsigned char* os = (unsigned char*)a.out;
    bf16* GQ = (bf16*)(os + OS_GQ) + (size_t)ci * 4096; bf16* GA = (bf16*)(os + OS_GA) + (size_t)ci * 4096; bf16* GK = (bf16*)(os + OS_GK) + (size_t)ci * 4096;
    bf16* GV = (bf16*)(os + OS_GV) + (size_t)ci * 8192; float* GE = (float*)(ws + WS_GE) + (size_t)ci * 64;
    LAS float* PS = (LAS float*)(lds + GK_PS); LAS float* LR = (LAS float*)(lds + GK_LR);
    if (tid < 256) *(LAS f32x4*)(LR + tid * 4) = *(const f32x4*)(SMALL + (size_t)(t0 + (tid >> 2)) * 32 + 8 + (tid & 3) * 4);
    {
        const int dv = tid & 127, tg = tid >> 7; const bf16* src = P + (size_t)(t0 + tg * 16) * PW + 2560 + h * 128 + dv;
        unsigned w[8];
#pragma unroll
        for (int j = 0; j < 8; ++j) w[j] = (unsigned)src[(size_t)(2 * j) * PW] | ((unsigned)src[(size_t)(2 * j + 1) * PW] << 16);
        *(u32x4*)(GV + dv * 64 + tg * 16) = (u32x4){w[0], w[1], w[2], w[3]}; *(u32x4*)(GV + dv * 64 + tg * 16 + 8) = (u32x4){w[4], w[5], w[6], w[7]};
    }
    __syncthreads();
    const int k = tid & 63, rg = tid >> 6;
    float lg[8];
    {
        float wg[16];
#pragma unroll
        for (int j = 0; j < 16; ++j) wg[j] = a.in[11][j * 256 + h * 64 + k];
        const float bg = a.in[12][h * 64 + k];
        float run = 0.f;
#pragma unroll
        for (int i = 0; i < 8; ++i) {
            const int r = rg * 8 + i; float x = bg;
#pragma unroll
            for (int j = 0; j < 16; ++j) x += LR[r * 16 + j] * wg[j];
            const float ls = fminf(x, 0.f) - log1pf(__expf(-fabsf(x)));
            run += ls * (1.0f / 16.0f); lg[i] = run;
        }
        PS[rg * 64 + k] = run;
    }
    __syncthreads();
    {
        float off = 0.f, tot = 0.f;
#pragma unroll
        for (int g2 = 0; g2 < 8; ++g2) { const float v = PS[g2 * 64 + k]; if (g2 < rg) off += v; tot += v; }
        float kd[8];
#pragma unroll
        for (int i = 0; i < 8; ++i) {
            const int r = rg * 8 + i; const float bc = lg[i] + off;
            const float qraw = bf2f(P[(size_t)(t0 + r) * PW + 2048 + h * 64 + k]), kraw = bf2f(P[(size_t)(t0 + r) * PW + 2304 + h * 64 + k]);
            const float qt = qraw * 0.125f * __expf(bc), kt = kraw * __expf(-bc);
            kd[i] = kraw * __expf(tot - bc);
            const unsigned short qb = f2bf(qt);
            *(LAS unsigned short*)(lds + GK_QT + r * 144 + k * 2) = qb; *(LAS unsigned short*)(lds + GK_KT + r * 144 + k * 2) = f2bf(kt);
            GQ[r * 64 + kperm(k)] = qb;
        }
        u32x4 w; w.x = pk2(kd[0], kd[1]); w.y = pk2(kd[2], kd[3]); w.z = pk2(kd[4], kd[5]); w.w = pk2(kd[6], kd[7]);
        *(u32x4*)(GK + k * 64 + rg * 8) = w;
        if (rg == 0) GE[k] = __expf(tot);
    }
    __syncthreads();
    if (wid < 4) {
        const int rb = wid, r = lane & 15, q = lane >> 4;
        f32x4 acc[4];
#pragma unroll
        for (int cb = 0; cb < 4; ++cb) acc[cb] = (f32x4){0.f, 0.f, 0.f, 0.f};
#pragma unroll
        for (int s = 0; s < 2; ++s) {
            const bf16x8 av = *(const LAS bf16x8*)(lds + GK_QT + (16 * rb + r) * 144 + s * 64 + q * 16);
#pragma unroll
            for (int cb = 0; cb < 4; ++cb) { const bf16x8 bv = *(const LAS bf16x8*)(lds + GK_KT + (16 * cb + r) * 144 + s * 64 + q * 16); acc[cb] = MFMA16(av, bv, acc[cb]); }
        }
#pragma unroll
        for (int cb = 0; cb < 4; ++cb)
#pragma unroll
            for (int i = 0; i < 4; ++i) { const int ii = 16 * rb + 4 * q + i, jj = 16 * cb + r; GA[ii * 64 + jj] = f2bf(jj <= ii ? acc[cb][i] : 0.f); }
    }
    __syncthreads();
}

constexpr int SB_W = 0, SB_Q = 17408, SB_K = 34816, SB_QK = 53248, SB_BYTES = 62464;
constexpr int GB_Q = 0, GB_A = 9216, GB_K = 18432, GB_BYTES = 27648;

#define WG_BAR() do { asm volatile("s_waitcnt lgkmcnt(0)" ::: "memory"); __builtin_amdgcn_s_barrier(); asm volatile("" ::: "memory"); } while (0)
constexpr int NLOAD = 512 - 64 * NCWAVE;
constexpr int GDN_KP = (3584 + NLOAD - 1) / NLOAD;
constexpr int GLA_KP = (1536 + NLOAD - 1) / NLOAD;

__device__ __forceinline__ void gdn_scan(const Args& a, LAS unsigned char* lds_in, int bh, int part, int tid_in) {
    const int tid = opaque_v(tid_in); LAS unsigned char* lds = opaque_v(lds_in);
    const int lane = tid & 63, wid = tid >> 6, c = lane & 15, q = lane >> 4, h = bh & 3, b = bh >> 2;
    unsigned char* ws = a.ws; unsigned char* os = (unsigned char*)a.out;
    if (wid >= NCWAVE) {
        const int lt = tid - 64 * NCWAVE;
        const u32x4* src[GDN_KP]; int cst[GDN_KP]; int dst[GDN_KP]; bool ok[GDN_KP];
#pragma unroll
        for (int k = 0; k < GDN_KP; ++k) {
            const int p = lt + k * NLOAD; ok[k] = p < 3584; const int pc = ok[k] ? p : 0; const int arr = pc >> 10, pp = pc & 1023;
            const unsigned char* base = arr == 0 ? ws + WS_DW : arr == 1 ? ws + WS_DQ : arr == 2 ? ws + WS_DK : os + OS_DQK;
            cst[k] = arr < 3 ? 1024 : 512;
            src[k] = (const u32x4*)base + (size_t)bh * 128 * cst[k] + pp;
            dst[k] = arr < 2 ? (arr == 0 ? SB_W : SB_Q) + (pp >> 4) * 272 + (pp & 15) * 16 : (arr == 2 ? SB_K : SB_QK) + (pp >> 3) * 144 + (pp & 7) * 16;
        }
        u32x4 sa[GDN_KP], sb[GDN_KP];
#define L_LOAD(set, n) do { const int n_ = (n) < NCHK ? (n) : NCHK - 1; _Pragma("unroll") for (int k = 0; k < GDN_KP; ++k) set[k] = src[k][(size_t)n_ * cst[k]]; } while (0)
#define L_STORE(set, buf) do { LAS unsigned char* B_ = lds + (buf) * SB_BYTES; _Pragma("unroll") for (int k = 0; k < GDN_KP; ++k) if (ok[k]) *(LAS u32x4*)(B_ + dst[k]) = set[k]; } while (0)
        L_LOAD(sa, 0); L_STORE(sa, 0); L_LOAD(sa, 1); L_LOAD(sb, 2);
        WG_BAR();
        for (int n = 0; n < NCHK; n += 2) {
            L_STORE(sa, 1); L_LOAD(sa, n + 3); WG_BAR();
            L_STORE(sb, 0); L_LOAD(sb, n + 4); WG_BAR();
        }
#undef L_LOAD
#undef L_STORE
        return;
    }
    const bf16* DU = (const bf16*)(os + OS_DU) + (size_t)bh * 128 * 8192; const float* DGL = (const float*)(ws + WS_DGL) + bh * 128;
    bf16* MIX = (bf16*)(ws + WS_MIX);
    const int dv = part * CW + 16 * wid + c;
    f32x4 S[8]; bf16x8 Sb[4];
#pragma unroll
    for (int i = 0; i < 8; ++i) S[i] = (f32x4){0.f, 0.f, 0.f, 0.f};
#pragma unroll
    for (int i = 0; i < 4; ++i) Sb[i] = (bf16x8){0, 0, 0, 0, 0, 0, 0, 0};
    u32x2 un[4];
#pragma unroll
    for (int rb = 0; rb < 4; ++rb) un[rb] = *(const u32x2*)(DU + dv * 64 + 16 * rb + 4 * q);
    WG_BAR();
    for (int n = 0; n < NCHK; ++n) {
        const int nn = n + 1 < NCHK ? n + 1 : n;
        const LAS unsigned char* B = lds + (n & 1) * SB_BYTES;
        const float gl = DGL[n];
        u32x2 uc[4];
#pragma unroll
        for (int rb = 0; rb < 4; ++rb) { uc[rb] = un[rb]; un[rb] = *(const u32x2*)(DU + (size_t)nn * 8192 + dv * 64 + 16 * rb + 4 * q); }
        f32x4 aO[4], aW[4];
#pragma unroll
        for (int rb = 0; rb < 4; ++rb) { aO[rb] = (f32x4){0.f, 0.f, 0.f, 0.f}; aW[rb] = (f32x4){0.f, 0.f, 0.f, 0.f}; }
#pragma unroll
        for (int s = 0; s < 4; ++s)
#pragma unroll
            for (int rb = 0; rb < 4; ++rb) {
                const bf16x8 wv = *(const LAS bf16x8*)(B + SB_W + (16 * rb + c) * 272 + s * 64 + q * 16);
                aW[rb] = MFMA16(wv, Sb[s], aW[rb]);
            }
#pragma unroll
        for (int s = 0; s < 4; ++s)
#pragma unroll
            for (int rb = 0; rb < 4; ++rb) {
                const bf16x8 qv = *(const LAS bf16x8*)(B + SB_Q + (16 * rb + c) * 272 + s * 64 + q * 16);
                aO[rb] = MFMA16(qv, Sb[s], aO[rb]);
            }
        f32x4 vn[4];
#pragma unroll
        for (int rb = 0; rb < 4; ++rb) vn[rb] = (f32x4){bflo(uc[rb].x), bfhi(uc[rb].x), bflo(uc[rb].y), bfhi(uc[rb].y)} - aW[rb];
        bf16x8 Vb[2]; Vb[0] = pack8(vn[0], vn[1]); Vb[1] = pack8(vn[2], vn[3]);
#pragma unroll
        for (int rb = 0; rb < 8; ++rb) {
            S[rb] = S[rb] * gl;
#pragma unroll
            for (int s = 0; s < 2; ++s) {
                const bf16x8 kv = *(const LAS bf16x8*)(B + SB_K + (16 * rb + c) * 144 + s * 64 + q * 16);
                S[rb] = MFMA16(kv, Vb[s], S[rb]);
            }
        }
#pragma unroll
        for (int s = 0; s < 2; ++s)
#pragma unroll
            for (int rb = 0; rb < 4; ++rb) {
                const bf16x8 kv = *(const LAS bf16x8*)(B + SB_QK + (16 * rb + c) * 144 + s * 64 + q * 16);
                aO[rb] = MFMA16(kv, Vb[s], aO[rb]);
            }
#pragma unroll
        for (int s = 0; s < 4; ++s) Sb[s] = pack8(S[2 * s], S[2 * s + 1]);
        bf16* op = MIX + (size_t)(b * SEQ + n * 64 + 4 * q) * D + h * 128 + dv;
#pragma unroll
        for (int rb = 0; rb < 4; ++rb)
#pragma unroll
            for (int i = 0; i < 4; ++i) op[(size_t)(16 * rb + i) * D] = f2bf(aO[rb][i]);
        WG_BAR();
    }
}

__device__ __forceinline__ void gla_scan(const Args& a, LAS unsigned char* lds_in, int bh, int part, int tid_in) {
    const int tid = opaque_v(tid_in); LAS unsigned char* lds = opaque_v(lds_in);
    const int lane = tid & 63, wid = tid >> 6, c = lane & 15, q = lane >> 4, h = bh & 3, b = bh >> 2;
    unsigned char* ws = a.ws; unsigned char* os = (unsigned char*)a.out;
    if (wid >= NCWAVE) {
        const int lt = tid - 64 * NCWAVE;
        const u32x4* src[GLA_KP]; int dst[GLA_KP]; bool ok[GLA_KP];
#pragma unroll
        for (int k = 0; k < GLA_KP; ++k) {
            const int p = lt + k * NLOAD; ok[k] = p < 1536; const int pc = ok[k] ? p : 0; const int arr = pc >> 9, pp = pc & 511;
            const unsigned char* base = arr == 0 ? os + OS_GQ : arr == 1 ? os + OS_GA : os + OS_GK;
            src[k] = (const u32x4*)base + (size_t)bh * 128 * 512 + pp;
            dst[k] = (arr == 0 ? GB_Q : arr == 1 ? GB_A : GB_K) + (pp >> 3) * 144 + (pp & 7) * 16;
        }
        u32x4 sa[GLA_KP], sb[GLA_KP];
#define L_LOAD(set, n) do { const int n_ = (n) < NCHK ? (n) : NCHK - 1; _Pragma("unroll") for (int k = 0; k < GLA_KP; ++k) set[k] = src[k][(size_t)n_ * 512]; } while (0)
#define L_STORE(set, buf) do { LAS unsigned char* B_ = lds + (buf) * GB_BYTES; _Pragma("unroll") for (int k = 0; k < GLA_KP; ++k) if (ok[k]) *(LAS u32x4*)(B_ + dst[k]) = set[k]; } while (0)
        L_LOAD(sa, 0); L_STORE(sa, 0); L_LOAD(sa, 1); L_LOAD(sb, 2);
        WG_BAR();
        for (int n = 0; n < NCHK; n += 2) {
            L_STORE(sa, 1); L_LOAD(sa, n + 3); WG_BAR();
            L_STORE(sb, 0); L_LOAD(sb, n + 4); WG_BAR();
        }
#undef L_LOAD
#undef L_STORE
        return;
    }
    const bf16* GV = (const bf16*)(os + OS_GV) + (size_t)bh * 128 * 8192; const float* GE = (const float*)(ws + WS_GE) + (size_t)bh * 128 * 64;
    bf16* MIX = (bf16*)(ws + WS_MIX);
    const int dv = part * CW + 16 * wid + c;
    f32x4 S[4]; bf16x8 Sb[2];
#pragma unroll
    for (int i = 0; i < 4; ++i) S[i] = (f32x4){0.f, 0.f, 0.f, 0.f};
#pragma unroll
    for (int i = 0; i < 2; ++i) Sb[i] = (bf16x8){0, 0, 0, 0, 0, 0, 0, 0};
    bf16x8 vnx[2]; f32x4 enx[4];
#pragma unroll
    for (int s = 0; s < 2; ++s) vnx[s] = *(const bf16x8*)(GV + dv * 64 + 32 * s + 8 * q);
#pragma unroll
    for (int rb = 0; rb < 4; ++rb) enx[rb] = *(const f32x4*)(GE + 16 * rb + 4 * q);
    WG_BAR();
    for (int n = 0; n < NCHK; ++n) {
        const int nn = n + 1 < NCHK ? n + 1 : n;
        const LAS unsigned char* B = lds + (n & 1) * GB_BYTES;
        bf16x8 Vb[2]; f32x4 eb[4];
#pragma unroll
        for (int s = 0; s < 2; ++s) { Vb[s] = vnx[s]; vnx[s] = *(const bf16x8*)(GV + (size_t)nn * 8192 + dv * 64 + 32 * s + 8 * q); }
#pragma unroll
        for (int rb = 0; rb < 4; ++rb) { eb[rb] = enx[rb]; enx[rb] = *(const f32x4*)(GE + (size_t)nn * 64 + 16 * rb + 4 * q); }
        f32x4 aO[4];
#pragma unroll
        for (int rb = 0; rb < 4; ++rb) aO[rb] = (f32x4){0.f, 0.f, 0.f, 0.f};
#pragma unroll
        for (int s = 0; s < 2; ++s)
#pragma unroll
            for (int rb = 0; rb < 4; ++rb) {
                const bf16x8 qv = *(const LAS bf16x8*)(B + GB_Q + (16 * rb + c) * 144 + s * 64 + q * 16);
                aO[rb] = MFMA16(qv, Sb[s], aO[rb]);
                const bf16x8 av = *(const LAS bf16x8*)(B + GB_A + (16 * rb + c) * 144 + s * 64 + q * 16);
                aO[rb] = MFMA16(av, Vb[s], aO[rb]);
            }
#pragma unroll
        for (int rb = 0; rb < 4; ++rb) {
            S[rb] = S[rb] * eb[rb];
#pragma unroll
            for (int s = 0; s < 2; ++s) {
                const bf16x8 kv = *(const LAS bf16x8*)(B + GB_K + (16 * rb + c) * 144 + s * 64 + q * 16);
                S[rb] = MFMA16(kv, Vb[s], S[rb]);
            }
        }
#pragma unroll
        for (int s = 0; s < 2; ++s) Sb[s] = pack8(S[2 * s], S[2 * s + 1]);
        bf16* op = MIX + (size_t)(b * SEQ + n * 64 + 4 * q) * D + 512 + h * 128 + dv;
#pragma unroll
        for (int rb = 0; rb < 4; ++rb)
#pragma unroll
            for (int i = 0; i < 4; ++i) op[(size_t)(16 * rb + i) * D] = f2bf(aO[rb][i]);
        WG_BAR();
    }
}

__global__ void __launch_bounds__(512, 2) fwd_kernel(Args a) {
    extern __shared__ __attribute__((aligned(16))) unsigned char lds_raw[];
    LAS unsigned char* lds = (LAS unsigned char*)lds_raw;
    const int tid = threadIdx.x, lane = tid & 63, wave = __builtin_amdgcn_readfirstlane(tid >> 6);
    const int G = gridDim.x, bx = blockIdx.x;
    const int vcu = (G % 8 == 0) ? (bx % 8) * (G / 8) + bx / 8 : bx;
    const int gw = vcu * 8 + wave, NGW = G * 8;
    unsigned char* ws = a.ws;
    const int lo = a.ph_lo, hi = a.ph_hi;
    volatile LAS unsigned* bst = (volatile LAS unsigned*)(lds + LDS_BYTES - 64);
    if (tid < 2) bst[tid] = 0u;
    __syncthreads();
    XcdBarrier bar; bar.bar = (unsigned*)ws; bar.x = 0; bar.st = bst;
    if (a.coop == 1) bar = xcd_barrier_post((unsigned*)ws, bst);
#define IN(k) (lo <= (k) && (k) < hi)
#define REPEAT(k) _Pragma("unroll 1") for (int rep_ = 0; rep_ < ((k) == XREP_PHASE ? a.pad : 1); ++rep_)
#define SEAM(k) do { if (IN(k) && IN((k) + 1)) { if (a.coop == 1) xcd_barrier(bar); else if (a.coop == 2) cg::this_grid().sync(); } } while (0)
    bf16* XB = (bf16*)(ws + WS_XB); bf16* HB = (bf16*)(ws + WS_HP); bf16* MIX = (bf16*)(ws + WS_MIX);
    float* SMALL = (float*)(ws + WS_SMALL);

    if (IN(0)) REPEAT(0) { prologue(a, lds, gw, NGW, wave, lane); } SEAM(0);
    if (IN(1)) REPEAT(1) {
        pg8::Gemm g{XB, (const bf16*)(ws + WS_WGU1), M, NGU, D}; pg8::StaticOrder S; S.init(M, NGU, G, bx);
        pg8::EpiSwiglu E{HB, FF};
        pg8::gemm_phase<pg8::EpiSwiglu, pg8::StaticOrder, true, true>(lds, g, S, E);
    } SEAM(1);
    if (IN(2)) REPEAT(2) {
        pg8::Gemm g{HB, (const bf16*)(ws + WS_WD1), M, D, FF}; pg8::StaticOrder S; S.init(M, D, G, bx);
        pg8::EpiRes<false> E{a.in[0], a.out, ALPHA, 0.5f};
        pg8::gemm_phase<pg8::EpiRes<false>, pg8::StaticOrder, true, true>(lds, g, S, E);
    } SEAM(2);
    if (IN(3)) REPEAT(3) { ln_phase(a.out, nullptr, XB, a.in[4], a.in[5], gw, NGW, lane); } SEAM(3);
    if (IN(4)) REPEAT(4) {
        pg8::Gemm g{XB, (const bf16*)(ws + WS_WIN), M, NPROJ, D}; pg8::StaticOrder S; S.init(M, NPROJ, G, bx);
        pg8::EpiProj E{HB, SMALL};
        pg8::gemm_phase<pg8::EpiProj, pg8::StaticOrder, true, true>(lds, g, S, E);
    } SEAM(4);
    if (IN(5)) REPEAT(5) {
        for (int it = bx; it < 2 * NCH; it += G) { if (it < NCH) gdn_prep_item(a, lds, it, tid); else gla_prep_item(a, lds, it - NCH, tid); }
    } SEAM(5);
    if (IN(6)) REPEAT(6) {
        const int xcd = bx & 7, slot = bx >> 3;
        if (slot < 4 * NPART) {
            const int sl = slot / NPART, part = slot % NPART, bh = xcd * 2 + (sl >> 1);
            if ((sl & 1) == 0) gdn_scan(a, lds, bh, part, tid); else gla_scan(a, lds, bh, part, tid);
        }
    } SEAM(6);
    if (IN(7)) { gnorm_phase(MIX, HB, a.in[10], a.in[13], gw, NGW, lane); } SEAM(7);
    if (IN(8)) REPEAT(8) {
        pg8::Gemm g{MIX, (const bf16*)(ws + WS_WOUT), M, D, D}; pg8::StaticOrder S; S.init(M, D, G, bx);
        pg8::EpiRes<true> E{XB, a.out, ALPHA, 1.0f};
        pg8::gemm_phase<pg8::EpiRes<true>, pg8::StaticOrder, true, true>(lds, g, S, E);
    } SEAM(8);
    if (IN(9)) { ln_phase(a.out, a.out, XB, a.in[15], a.in[16], gw, NGW, lane); } SEAM(9);
    if (IN(10)) {
        pg8::Gemm g{XB, (const bf16*)(ws + WS_WGU2), M, NGU, D}; pg8::StaticOrder S; S.init(M, NGU, G, bx);
        pg8::EpiSwiglu E{HB, FF};
        pg8::gemm_phase<pg8::EpiSwiglu, pg8::StaticOrder, true, true>(lds, g, S, E);
    } SEAM(10);
    if (IN(11)) {
        pg8::Gemm g{HB, (const bf16*)(ws + WS_WD2), M, D, FF}; pg8::StaticOrder S; S.init(M, D, G, bx);
        pg8::EpiRes<false> E{a.out, a.out, ALPHA, 0.5f};
        pg8::gemm_phase<pg8::EpiRes<false>, pg8::StaticOrder, true, true>(lds, g, S, E);
    } SEAM(11);
    if (IN(12)) { ln_phase(a.out, a.out, nullptr, a.in[20], a.in[21], gw, NGW, lane); }
    if (a.coop == 1) for (int i_ = 0; i_ < XREP_SYNC; ++i_) xcd_barrier(bar);
#undef IN
#undef SEAM
}

constexpr int NPHASE = 13;
#ifndef MK_MULTI
#define MK_MULTI 0
#endif
extern "C" void kernel_launch(void* const* d_in, const int* in_sizes, int n_in, void* d_out, int out_size, void* d_ws, size_t ws_size, hipStream_t stream) {
    static int grid = 0;
    if (grid == 0) {
        if (n_in != 22 || out_size != M * D || ws_size < WS_END) { fprintf(stderr, "kernel_launch: unexpected shapes (n_in %d out %d ws %zu)\n", n_in, out_size, ws_size); grid = -1; return; }
        int dev = 0, cus = 0, per_cu = 0;
        hipGetDevice(&dev); hipDeviceGetAttribute(&cus, hipDeviceAttributeMultiprocessorCount, dev);
        if (hipFuncSetAttribute((const void*)fwd_kernel, hipFuncAttributeMaxDynamicSharedMemorySize, LDS_BYTES) != hipSuccess) { fprintf(stderr, "kernel_launch: hipFuncSetAttribute failed\n"); grid = -1; return; }
        hipOccupancyMaxActiveBlocksPerMultiprocessor(&per_cu, (const void*)fwd_kernel, 512, LDS_BYTES);
        (void)hipGetLastError();
        if (per_cu < 1) per_cu = 1;
        grid = cus * 1;
        fprintf(stderr, "kernel_launch: cus %d per_cu %d grid %d\n", cus, per_cu, grid);
    }
    if (grid < 0) return;
    Args a{};
    for (int i = 0; i < 22; ++i) a.in[i] = (const float*)d_in[i];
    a.out = (float*)d_out; a.ws = (unsigned char*)d_ws; a.pad = XREP_N;
#if MK_MULTI
    for (int p = 0; p < NPHASE; ++p) { a.ph_lo = p; a.ph_hi = p + 1; a.coop = 0; hipLaunchKernelGGL(fwd_kernel, dim3(grid), dim3(512), LDS_BYTES, stream, a); }
#else
    if (hipMemsetAsync(d_ws, 0, 65536, stream) != hipSuccess) { fprintf(stderr, "kernel_launch: memset failed\n"); return; }
    a.ph_lo = 0; a.ph_hi = NPHASE; a.coop = 1;
    void* args[] = {&a};
    hipError_t e = hipLaunchCooperativeKernel((const void*)fwd_kernel, dim3(grid), dim3(512), args, LDS_BYTES, stream);
    if (e != hipSuccess) fprintf(stderr, "cooperative launch failed: %s (grid %d)\n", hipGetErrorString(e), grid);
#endif
}
```

```cpp
#include <hip/hip_runtime.h>
#include <hip/hip_cooperative_groups.h>
#include <cstdio>
#include <cstdint>
namespace cg = cooperative_groups;
#define LAS __attribute__((address_space(3)))
namespace pg8 {
#define PG8_LAS __attribute__((address_space(3)))
typedef unsigned short bf16_t;
typedef short bf16x8 __attribute__((ext_vector_type(8)));
typedef float f32x4 __attribute__((ext_vector_type(4)));
typedef unsigned u32x4 __attribute__((ext_vector_type(4)));
constexpr int BM = 256, BK = 64, HALF = 128, HTB = HALF * BK * 2  , STAGE_BYTES = 8 * HTB, NXCD = 8, WGM = 8;

__host__ __device__ __forceinline__ int lds_byte(int r, int c) { const int st = (r >> 4) * 2 + (c >> 5), rr = r & 15, cc = c & 31, ob = rr * 64 + cc * 2; return st * 1024 + (ob ^ (((ob >> 9) & 1) << 5)); }
__host__ __device__ __forceinline__ void stage_rc(int b, int& R, int& C) { const int st = b / 1024, sb = b % 1024, swz = sb ^ (((sb >> 9) & 1) << 5); R = (st >> 1) * 16 + swz / 64; C = (st & 1) * 32 + (swz % 64) / 2; }
__host__ __device__ __forceinline__ int perm32(int rho) { const int n = rho >> 4, i = rho & 15; return 8 * (i >> 2) + 4 * n + (i & 3); }

struct Unit { int pm, pn; };
struct Gemm { const bf16_t* A; const bf16_t* Bt; int M, N, K; };

struct StaticOrder {
    int nM, nN, nwg, G, c;
    __host__ __device__ void init(int M, int N, int G_, int c_) { nM = M / BM; nN = N / BM; nwg = nM * nN; G = G_; c = c_; }
    __host__ __device__ bool next(int i, Unit& u) const {
        const long L = (long)i * G + c; if (L >= nwg) return false;
        int wgid = (int)L; { const int q = nwg / NXCD, r = nwg % NXCD, xcd = wgid % NXCD, off = wgid / NXCD; wgid = (xcd < r ? xcd * (q + 1) : r * (q + 1) + (xcd - r) * q) + off; }
        const int nig = WGM * nN, gid = wgid / nig, fm = gid * WGM, gsz = (nM - fm) < WGM ? (nM - fm) : WGM;
        u.pm = fm + ((wgid % nig) % gsz); u.pn = (wgid % nig) / gsz; return true;
    }
    __device__ __forceinline__ void a_ready(const Unit&) const {}
    __device__ __forceinline__ void done(const Unit&) const {}
};

__device__ __forceinline__ unsigned cvt_pk_bf16(float lo, float hi) { unsigned r; asm volatile("v_cvt_pk_bf16_f32 %0, %1, %2" : "=v"(r) : "v"(lo), "v"(hi)); return r; }
typedef float f32x2 __attribute__((ext_vector_type(2)));
template <class Epi, class Sched, bool ALIGN_EPI = false, bool SP2 = false>
__device__ __forceinline__ void gemm_phase(PG8_LAS unsigned char* lds, const Gemm g, const Sched& S, const Epi& E) {
    const int tid = threadIdx.x, wid = __builtin_amdgcn_readfirstlane(tid >> 6), lane = tid & 63, wr = wid >> 2, wc = wid & 3, fr = lane & 15, fq = lane >> 4;
    const int K = g.K, nt = K / BK;
    unsigned voffA[2], voffB[2];
#pragma unroll
    for (int i = 0; i < 2; ++i) { int R, C; stage_rc(tid * 16 + i * 8192, R, C); const int Rb = Epi::PERM ? ((R & ~31) + perm32(R & 31)) : R;
        voffA[i] = (unsigned)(R * K + C) * 2u; voffB[i] = (unsigned)(Rb * K + C) * 2u; }
    const size_t kstep = (size_t)(BK * 2);
    const size_t hstep = (size_t)HALF * K * 2;
    const size_t tstep = 2 * hstep;
    const unsigned ldsw = (unsigned)wid * 1024u;
    const int aoff = lds_byte(wr * 64 + fr, fq * 8), boff = lds_byte(wc * 32 + fr, fq * 8);
#define PG8_SA(b, h) (((b) * 2 + (h)) * HTB)
#define PG8_SB(b, h) ((4 + (b) * 2 + (h)) * HTB)
#define PG8_STAGE(bufoff, gbase, voff) do { _Pragma("unroll") for (int _i = 0; _i < 2; ++_i) \
        __builtin_amdgcn_global_load_lds((const unsigned*)((const char*)(gbase) + (voff)[_i]), (PG8_LAS unsigned*)(lds + (bufoff) + ldsw + _i * 8192), 16, 0, 0); } while (0)
#define PG8_LDA(dst, b, h) do { _Pragma("unroll") for (int m = 0; m < 4; ++m) _Pragma("unroll") for (int k = 0; k < 2; ++k) dst[m][k] = *(const PG8_LAS bf16x8*)(lds + PG8_SA(b, h) + aoff + m * 2048 + k * 1024); } while (0)
#define PG8_LDB(dst, b, h) do { _Pragma("unroll") for (int n = 0; n < 2; ++n) _Pragma("unroll") for (int k = 0; k < 2; ++k) dst[n][k] = *(const PG8_LAS bf16x8*)(lds + PG8_SB(b, h) + boff + n * 2048 + k * 1024); } while (0)
#define PG8_MMA(ai, bj, At, Bt) do { __builtin_amdgcn_s_setprio(1); _Pragma("unroll") for (int m = 0; m < 4; ++m) _Pragma("unroll") for (int n = 0; n < 2; ++n) _Pragma("unroll") for (int k = 0; k < 2; ++k) \
        acc[ai][bj][m][n] = __builtin_amdgcn_mfma_f32_16x16x32_bf16(Bt[n][k], At[m][k], acc[ai][bj][m][n], 0, 0, 0); __builtin_amdgcn_s_setprio(0); } while (0)
#define PG8_WAIT_V(n) asm volatile("s_waitcnt vmcnt(" #n ")" ::: "memory")
#define PG8_WAIT_L(n) asm volatile("s_waitcnt lgkmcnt(" #n ")" ::: "memory")
#define PG8_BAR __builtin_amdgcn_s_barrier()
#define PG8_SCHED __builtin_amdgcn_sched_barrier(0)
    Unit cur, nxt; int ui = 0;
    if (!S.next(0, cur)) return;
    f32x4 acc[2][2][4][2];
#pragma unroll
    for (int a = 0; a < 2; ++a)
#pragma unroll
        for (int b = 0; b < 2; ++b)
#pragma unroll
            for (int m = 0; m < 4; ++m)
#pragma unroll
                for (int n = 0; n < 2; ++n) acc[a][b][m][n] = (f32x4){0.f, 0.f, 0.f, 0.f};
    bf16x8 At[4][2], B0[2][2], B1[2][2];
    const char* cA = (const char*)g.A + (size_t)cur.pm * tstep; const char* cB = (const char*)g.Bt + (size_t)cur.pn * tstep;
    S.a_ready(cur);
    if constexpr (SP2) {
        PG8_STAGE(PG8_SB(0, 0), cB, voffB); PG8_STAGE(PG8_SB(0, 1), cB + hstep, voffB); PG8_STAGE(PG8_SA(0, 0), cA, voffA); PG8_STAGE(PG8_SA(0, 1), cA + hstep, voffA);
        if (wr == 1) PG8_BAR;
        PG8_WAIT_V(2); PG8_BAR;
        PG8_STAGE(PG8_SB(1, 0), cB + kstep, voffB); PG8_STAGE(PG8_SA(1, 0), cA + kstep, voffA); PG8_STAGE(PG8_SB(1, 1), cB + hstep + kstep, voffB);
        PG8_WAIT_V(6); PG8_BAR;
    } else {
        PG8_STAGE(PG8_SB(0, 0), cB, voffB); PG8_STAGE(PG8_SA(0, 0), cA, voffA); PG8_STAGE(PG8_SB(0, 1), cB + hstep, voffB); PG8_STAGE(PG8_SA(0, 1), cA + hstep, voffA);
        if (wr == 1) PG8_BAR;
        PG8_WAIT_V(4); PG8_BAR;
        PG8_STAGE(PG8_SB(1, 0), cB + kstep, voffB); PG8_STAGE(PG8_SA(1, 0), cA + kstep, voffA); PG8_STAGE(PG8_SB(1, 1), cB + hstep + kstep, voffB);
        PG8_WAIT_V(6); PG8_BAR;
    }
    for (;;) {
        const bool has_next = S.next(ui + 1, nxt);
        const char* nA = has_next ? (const char*)g.A + (size_t)nxt.pm * tstep : cA; const char* nB = has_next ? (const char*)g.Bt + (size_t)nxt.pn * tstep : cB;
        for (int t = 0; t < nt; t += 2) {
            const bool last = (t == nt - 2);
            const char* a1 = cA + (size_t)(t + 1) * kstep;
            const char* a2 = last ? nA : cA + (size_t)(t + 2) * kstep; const char* b2 = last ? nB : cB + (size_t)(t + 2) * kstep;
            const char* a3 = a2 + kstep; const char* b3 = b2 + kstep;
            if (last && has_next) S.a_ready(nxt);
            if constexpr (SP2) {
            PG8_LDB(B0, 0, 0); PG8_LDB(B1, 0, 1); PG8_SCHED; PG8_LDA(At, 0, 0); PG8_STAGE(PG8_SA(1, 1), a1 + hstep, voffA);
            PG8_WAIT_V(8); PG8_WAIT_L(0); PG8_BAR; PG8_MMA(0, 0, At, B0); PG8_MMA(0, 1, At, B1); PG8_BAR; PG8_SCHED;
            PG8_LDA(At, 0, 1); PG8_STAGE(PG8_SB(0, 0), b2, voffB); PG8_STAGE(PG8_SB(0, 1), b2 + hstep, voffB); PG8_STAGE(PG8_SA(0, 0), a2, voffA);
            PG8_WAIT_V(8); PG8_WAIT_L(0); PG8_BAR; PG8_MMA(1, 0, At, B0); PG8_MMA(1, 1, At, B1); PG8_BAR; PG8_SCHED;
            PG8_LDB(B0, 1, 0); PG8_LDB(B1, 1, 1); PG8_SCHED; PG8_LDA(At, 1, 0); PG8_STAGE(PG8_SA(0, 1), a2 + hstep, voffA);
            PG8_WAIT_V(8); PG8_WAIT_L(0); PG8_BAR; PG8_MMA(0, 0, At, B0); PG8_MMA(0, 1, At, B1); PG8_BAR; PG8_SCHED;
            PG8_LDA(At, 1, 1); PG8_STAGE(PG8_SB(1, 0), b3, voffB); PG8_STAGE(PG8_SB(1, 1), b3 + hstep, voffB); PG8_STAGE(PG8_SA(1, 0), a3, voffA);
            PG8_WAIT_V(8); PG8_WAIT_L(0); PG8_BAR; PG8_MMA(1, 0, At, B0); PG8_MMA(1, 1, At, B1); PG8_BAR; PG8_SCHED;
            } else {
            PG8_LDB(B0, 0, 0); PG8_SCHED; PG8_LDA(At, 0, 0); PG8_STAGE(PG8_SA(1, 1), a1 + hstep, voffA);
            PG8_WAIT_L(8); PG8_BAR; PG8_WAIT_L(0); PG8_MMA(0, 0, At, B0); PG8_BAR; PG8_SCHED;
            PG8_LDB(B1, 0, 1); PG8_STAGE(PG8_SB(0, 0), b2, voffB);
            PG8_BAR; PG8_WAIT_L(0); PG8_MMA(0, 1, At, B1); PG8_BAR;
            PG8_LDA(At, 0, 1); PG8_STAGE(PG8_SA(0, 0), a2, voffA);
            PG8_BAR; PG8_WAIT_L(0); PG8_MMA(1, 0, At, B0); PG8_BAR; PG8_SCHED;
            PG8_STAGE(PG8_SB(0, 1), b2 + hstep, voffB);
            PG8_WAIT_V(6); PG8_BAR; PG8_MMA(1, 1, At, B1); PG8_BAR;
            PG8_LDB(B0, 1, 0); PG8_SCHED; PG8_LDA(At, 1, 0); PG8_STAGE(PG8_SA(0, 1), a2 + hstep, voffA);
            PG8_WAIT_L(8); PG8_BAR; PG8_WAIT_L(0); PG8_MMA(0, 0, At, B0); PG8_BAR; PG8_SCHED;
            PG8_LDB(B1, 1, 1); PG8_STAGE(PG8_SB(1, 0), b3, voffB);
            PG8_BAR; PG8_WAIT_L(0); PG8_MMA(0, 1, At, B1); PG8_BAR;
            PG8_LDA(At, 1, 1); PG8_STAGE(PG8_SA(1, 0), a3, voffA);
            PG8_BAR; PG8_WAIT_L(0); PG8_MMA(1, 0, At, B0); PG8_BAR; PG8_SCHED;
            PG8_STAGE(PG8_SB(1, 1), b3 + hstep, voffB);
            PG8_WAIT_V(6); PG8_BAR; PG8_MMA(1, 1, At, B1); PG8_BAR;
            }
        }
        if constexpr (ALIGN_EPI) { if (wr == 0) PG8_BAR; }
        if constexpr (!Epi::AFTER_DRAIN) { E(acc, cur, wr, wc, fr, fq); S.done(cur); }
        if (!has_next) break;
#pragma unroll
        for (int a = 0; a < 2; ++a)
#pragma unroll
            for (int b = 0; b < 2; ++b)
#pragma unroll
                for (int m = 0; m < 4; ++m)
#pragma unroll
                    for (int n = 0; n < 2; ++n) acc[a][b][m][n] = (f32x4){0.f, 0.f, 0.f, 0.f};
        cur = nxt; cA = nA; cB = nB; ++ui;
        if constexpr (ALIGN_EPI) { if (wr == 1) PG8_BAR; }
    }
    PG8_WAIT_V(0);
    if constexpr (!ALIGN_EPI) { if (wr == 0) PG8_BAR; }
    PG8_BAR;
    if constexpr (Epi::AFTER_DRAIN) { E.fused(acc, cur, wr, wc, fr, fq, lds, wid, lane); S.done(cur); }
#undef PG8_SA
#undef PG8_SB
#undef PG8_STAGE
#undef PG8_LDA
#undef PG8_LDB
#undef PG8_MMA
#undef PG8_WAIT_V
#undef PG8_WAIT_L
#undef PG8_BAR
#undef PG8_SCHED
}
}

namespace pg8 {
__device__ __forceinline__ float silu_f(float x) { return x * __builtin_amdgcn_rcpf(1.0f + __expf(-x)); }
__device__ __forceinline__ float bflo_f(unsigned u) { return __uint_as_float(u << 16); }
__device__ __forceinline__ float bfhi_f(unsigned u) { return __uint_as_float(u & 0xffff0000u); }

struct EpiSwiglu {
    static constexpr bool PERM = true, AFTER_DRAIN = false;
    bf16_t* O; int ldc;
    __device__ __forceinline__ void operator()(const f32x4 (&acc)[2][2][4][2], const Unit& u, int wr, int wc, int fr, int fq) const {
        const int row0 = u.pm * BM + wr * 64 + fr, col0 = u.pn * HALF + wc * 32 + 8 * fq;
#pragma unroll
        for (int ai = 0; ai < 2; ++ai)
#pragma unroll
            for (int m = 0; m < 4; ++m) {
                bf16_t* rowp = O + (size_t)(row0 + ai * HALF + m * 16) * ldc + col0;
                const f32x4 g0 = acc[ai][0][m][0], g1 = acc[ai][0][m][1], u0 = acc[ai][1][m][0], u1 = acc[ai][1][m][1];
                u32x4 w;
                w.x = cvt_pk_bf16(silu_f(g0[0]) * u0[0], silu_f(g0[1]) * u0[1]);
                w.y = cvt_pk_bf16(silu_f(g0[2]) * u0[2], silu_f(g0[3]) * u0[3]);
                w.z = cvt_pk_bf16(silu_f(g1[0]) * u1[0], silu_f(g1[1]) * u1[1]);
                w.w = cvt_pk_bf16(silu_f(g1[2]) * u1[2], silu_f(g1[3]) * u1[3]);
                *(u32x4*)rowp = w;
            }
    }
};

template <bool RES_BF16> struct EpiRes {
    static constexpr bool PERM = true, AFTER_DRAIN = false;
    const void* res; bf16_t* out; float alpha, scale;
    __device__ __forceinline__ void operator()(const f32x4 (&acc)[2][2][4][2], const Unit& u, int wr, int wc, int fr, int fq) const {
#pragma unroll
        for (int ai = 0; ai < 2; ++ai)
#pragma unroll
            for (int m = 0; m < 4; ++m) {
                const int row = u.pm * BM + wr * 64 + fr + ai * HALF + m * 16;
#pragma unroll
                for (int bj = 0; bj < 2; ++bj) {
                    const int col = u.pn * BM + bj * HALF + wc * 32 + 8 * fq; const size_t off = (size_t)row * 1024 + col;
                    f32x4 r0, r1;
                    if (RES_BF16) { const u32x4 rw = *(const u32x4*)((const bf16_t*)res + off);
                        r0 = (f32x4){bflo_f(rw.x), bfhi_f(rw.x), bflo_f(rw.y), bfhi_f(rw.y)}; r1 = (f32x4){bflo_f(rw.z), bfhi_f(rw.z), bflo_f(rw.w), bfhi_f(rw.w)}; }
                    else { r0 = *(const f32x4*)((const float*)res + off); r1 = *(const f32x4*)((const float*)res + off + 4); }
                    const f32x4 o0 = r0 * alpha + acc[ai][bj][m][0] * scale, o1 = r1 * alpha + acc[ai][bj][m][1] * scale;
                    u32x4 w; w.x = cvt_pk_bf16(o0[0], o0[1]); w.y = cvt_pk_bf16(o0[2], o0[3]); w.z = cvt_pk_bf16(o1[0], o1[1]); w.w = cvt_pk_bf16(o1[2], o1[3]);
                    *(u32x4*)(out + off) = w;
                }
            }
    }
};

struct EpiProj {
    static constexpr bool PERM = true, AFTER_DRAIN = false;
    bf16_t* P; float* SM;
    __device__ __forceinline__ void operator()(const f32x4 (&acc)[2][2][4][2], const Unit& u, int wr, int wc, int fr, int fq) const {
        const int row0 = u.pm * BM + wr * 64 + fr;
        if (u.pn < 14) {
            const int col0 = u.pn * BM + wc * 32 + 8 * fq;
#pragma unroll
            for (int ai = 0; ai < 2; ++ai)
#pragma unroll
                for (int m = 0; m < 4; ++m) { bf16_t* rowp = P + (size_t)(row0 + ai * HALF + m * 16) * 3584 + col0;
#pragma unroll
                    for (int bj = 0; bj < 2; ++bj) { const f32x4 v0 = acc[ai][bj][m][0], v1 = acc[ai][bj][m][1];
                        u32x4 w; w.x = cvt_pk_bf16(v0[0], v0[1]); w.y = cvt_pk_bf16(v0[2], v0[3]); w.z = cvt_pk_bf16(v1[0], v1[1]); w.w = cvt_pk_bf16(v1[2], v1[3]);
                        *(u32x4*)(rowp + bj * HALF) = w; } }
        } else if (wc == 0) {
#pragma unroll
            for (int ai = 0; ai < 2; ++ai)
#pragma unroll
                for (int m = 0; m < 4; ++m) { float* rowp = SM + (size_t)(row0 + ai * HALF + m * 16) * 32 + 8 * fq;
                    *(f32x4*)rowp = acc[ai][0][m][0]; *(f32x4*)(rowp + 4) = acc[ai][0][m][1]; }
        }
    }
};
}
#define XB_TMO      128
#define XB_XCNT(j)  (256  + 64 * (j))
#define XB_XSUB(j)  (1280 + 64 * (j))
#define XB_XGEN(j)  (2304 + 64 * (j))
#define XB_TOP      3328
#define XB_TOPGEN   3392
#define XCD_BAR_WORDS 3456
#define XB_SPIN_CAP (1u << 18)

__device__ __forceinline__ unsigned xb_ld(unsigned* p)              { return __hip_atomic_load(p, __ATOMIC_RELAXED, __HIP_MEMORY_SCOPE_AGENT); }
__device__ __forceinline__ unsigned xb_add(unsigned* p, unsigned v) { return __hip_atomic_fetch_add(p, v, __ATOMIC_RELAXED, __HIP_MEMORY_SCOPE_AGENT); }
__device__ __forceinline__ unsigned xb_xcc_id() { return (unsigned)__builtin_amdgcn_s_getreg((3 << 11) | 20) & 0xFu; }
#define XB_SPIN(cond, bar) do { unsigned _sp = 0; while (cond) { __builtin_amdgcn_s_sleep(1); \
    if ((++_sp & 255u) == 0u) { if (xb_ld(&(bar)[XB_TMO])) break; if (_sp > XB_SPIN_CAP) { atomicAdd(&(bar)[XB_TMO], 1u); break; } } } } while (0)

struct XcdBarrier {
    unsigned* bar; unsigned x;
    volatile LAS unsigned* st;
};

__device__ __forceinline__ XcdBarrier xcd_barrier_post(unsigned* bar, volatile LAS unsigned* st) {
    XcdBarrier b; b.bar = bar; b.x = xb_xcc_id(); b.st = st;
    if (threadIdx.x == 0) (void)xb_add(&bar[XB_XCNT(b.x)], 1u);
    return b;
}
__device__ __forceinline__ void xcd_barrier_complete(unsigned* bar, unsigned x, unsigned& nloc, unsigned& nx) {
    const unsigned G = gridDim.x * gridDim.y * gridDim.z;
    unsigned sum, cnt, mine, sp = 0u;
    for (;;) {
        sum = 0u; cnt = 0u; mine = 0u;
#pragma unroll
        for (unsigned j = 0; j < 16; ++j) { const unsigned c = xb_ld(&bar[XB_XCNT(j)]); sum += c; cnt += (c > 0u) ? 1u : 0u; mine = (j == x) ? c : mine; }
        if (sum == G) break;
        __builtin_amdgcn_s_sleep(1);
        if ((++sp & 255u) == 0u) { if (xb_ld(&bar[XB_TMO])) break; if (sp > XB_SPIN_CAP) { atomicAdd(&bar[XB_TMO], 1u); break; } }
    }
    nloc = mine > 0u ? mine : 1u; nx = cnt > 0u ? cnt : 1u;
}

__device__ __forceinline__ void xcd_barrier(const XcdBarrier& b) {
    asm volatile("s_waitcnt vmcnt(0)" ::: "memory");
    __syncthreads();
    if (threadIdx.x == 0) {
        unsigned* bar = b.bar;
        __builtin_amdgcn_s_waitcnt(0);
        unsigned nloc = b.st[0], nx = b.st[1];
        if (nloc == 0u) { xcd_barrier_complete(bar, b.x, nloc, nx); b.st[0] = nloc; b.st[1] = nx; }
        const unsigned old = xb_add(&bar[XB_XSUB(b.x)], 1u);
        const unsigned gen = old / nloc;
        if (old + 1u == (gen + 1u) * nloc) {
            __builtin_amdgcn_fence(__ATOMIC_RELEASE, "agent");
            asm volatile("s_waitcnt vmcnt(0)" ::: "memory");
            const unsigned og = xb_add(&bar[XB_TOP], 1u);
            const unsigned tg = og / nx;
            if (og + 1u == (tg + 1u) * nx) xb_add(&bar[XB_TOPGEN], 1u);
            else XB_SPIN(xb_ld(&bar[XB_TOPGEN]) == tg, bar);
            __builtin_amdgcn_fence(__ATOMIC_ACQUIRE, "agent");
            xb_add(&bar[XB_XGEN(b.x)], 1u);
            asm volatile("s_waitcnt vmcnt(0)" ::: "memory");
        } else {
            XB_SPIN(xb_ld(&bar[XB_XGEN(b.x)]) == gen, bar);
            __builtin_amdgcn_fence(__ATOMIC_ACQUIRE, "agent");
            asm volatile("s_waitcnt vmcnt(0)" ::: "memory");
        }
    }
    __syncthreads();
}

typedef unsigned short bf16;
typedef unsigned u32x4 __attribute__((ext_vector_type(4)));
typedef unsigned u32x2 __attribute__((ext_vector_type(2)));
typedef float f32x4 __attribute__((ext_vector_type(4)));
typedef short bf16x8 __attribute__((ext_vector_type(8)));
typedef float f32x2_t __attribute__((ext_vector_type(2)));
typedef __bf16 bf16x2_t __attribute__((ext_vector_type(2)));

constexpr int M = 32768, D = 1024, FF = 2816, NGU = 2 * FF, NPROJ = 3840, PW = 3584, SEQ = 8192, NCHK = 128, NCH = 2048;
constexpr int WIN_N = 3608;
constexpr float ALPHA = 1.189207115002721f;
constexpr float LN_EPS = 1e-5f, RMS_EPS = 1e-6f;
constexpr size_t MiB = 1u << 20;
constexpr size_t WS_WGU1 = 1 * MiB, WS_WD1 = 12 * MiB, WS_WIN = 18 * MiB, WS_WOUT = 26 * MiB, WS_WGU2 = 28 * MiB, WS_WD2 = 39 * MiB, WS_SMALL = 45 * MiB;
constexpr size_t WS_HP = 49 * MiB;
constexpr size_t WS_XB = 273 * MiB;
constexpr size_t WS_MIX = 337 * MiB;
constexpr size_t WS_DW = 401 * MiB, WS_DQ = 433 * MiB, WS_DK = 465 * MiB, WS_GE = 497 * MiB, WS_DGL = 498 * MiB, WS_END = 512 * MiB;
constexpr size_t OS_DU = 0, OS_GQ = 32 * MiB, OS_GA = 48 * MiB, OS_GK = 64 * MiB, OS_GV = 80 * MiB, OS_DQK = 112 * MiB;
constexpr int LDS_BYTES = 147456;
constexpr int NPART = 4, CW = 128 / NPART, NCWAVE = CW / 16;

__device__ __forceinline__ unsigned pk2(float lo, float hi) { f32x2_t v = {lo, hi}; bf16x2_t b = __builtin_convertvector(v, bf16x2_t); return __builtin_bit_cast(unsigned, b); }
__device__ __forceinline__ unsigned short f2bf(float f) { return (unsigned short)(pk2(f, 0.f) & 0xffffu); }
__device__ __forceinline__ float bf2f(unsigned short h) { return __uint_as_float((unsigned)h << 16); }
__device__ __forceinline__ float bflo(unsigned u) { return __uint_as_float(u << 16); }
__device__ __forceinline__ float bfhi(unsigned u) { return __uint_as_float(u & 0xffff0000u); }
__device__ __forceinline__ float silu(float x) { return x / (1.0f + __expf(-x)); }
__device__ __forceinline__ int kperm(int a) { return (a & ~31) | (((a >> 2) & 3) << 3) | (((a >> 4) & 1) << 2) | (a & 3); }
__device__ __forceinline__ float wave_sum(float v) {
#pragma unroll
    for (int o = 1; o < 64; o <<= 1) v += __shfl_xor(v, o);
    return v;
}
template <class T> __device__ __forceinline__ T opaque_v(T p) { asm volatile("" : "+v"(p)); return p; }
#define WG_BAR() do { asm volatile("s_waitcnt lgkmcnt(0)" ::: "memory"); __builtin_amdgcn_s_barrier(); asm volatile("" ::: "memory"); } while (0)
#define MFMA16(a, b, c) __builtin_amdgcn_mfma_f32_16x16x32_bf16((a), (b), (c), 0, 0, 0)
__device__ __forceinline__ bf16x8 pack8(const f32x4& lo, const f32x4& hi) {
    u32x4 p; p.x = pk2(lo[0], lo[1]); p.y = pk2(lo[2], lo[3]); p.z = pk2(hi[0], hi[1]); p.w = pk2(hi[2], hi[3]); return __builtin_bit_cast(bf16x8, p);
}

#ifndef XREP_PHASE
#define XREP_PHASE -1
#define XREP_N 1
#define XREP_SYNC 0
#endif
struct Args { const float* in[22]; float* out; unsigned char* ws; int ph_lo, ph_hi, coop, pad; };

struct ColGU { const float* g; const float* u; __device__ __forceinline__ const float* operator()(int d) const { const int t = d >> 8, w = d & 255;
    const uintptr_t gp = (uintptr_t)g, up = (uintptr_t)u; const uintptr_t base = gp + (uintptr_t)((w >> 7) & 1) * (up - gp); return (const float*)base + t * 128 + (w & 127); } };
struct ColPlain { const float* w; __device__ __forceinline__ const float* operator()(int d) const { return w + d; } };
struct ColWin { const float* w; __device__ __forceinline__ const float* operator()(int d) const {
    if (d < 2048) return w + d; if (d < 3584) return w + d + 8; if (d < 3592) return w + d - 1536; if (d < 3608) return w + d; return nullptr; } };

template <class ColPtr>
__device__ __forceinline__ void transpose_item(const ColPtr& cp, int nsrc, int K, bf16* WT, LAS float* scr, int kb, int nb, int lane) {
    const int k0 = 64 * kb, n0 = 32 * nb;
    const float* colp = cp(n0 + (lane & 31));
#pragma unroll 8
    for (int i = 0; i < 32; ++i) { const int kk = 2 * i + (lane >> 5); scr[kk * 33 + (lane & 31)] = colp ? colp[(size_t)(k0 + kk) * nsrc] : 0.f; }
    asm volatile("s_waitcnt lgkmcnt(0)" ::: "memory");
    const int c = lane & 7;
#pragma unroll
    for (int j = 0; j < 4; ++j) { const int n = (lane >> 3) + 8 * j; const LAS float* s = scr + (8 * c) * 33 + n;
        u32x4 o; o.x = pk2(s[0 * 33], s[1 * 33]); o.y = pk2(s[2 * 33], s[3 * 33]); o.z = pk2(s[4 * 33], s[5 * 33]); o.w = pk2(s[6 * 33], s[7 * 33]);
        *(u32x4*)(WT + (size_t)(n0 + n) * K + k0 + 8 * c) = o; }
    asm volatile("s_waitcnt lgkmcnt(0)" ::: "memory");
}

__device__ __forceinline__ void prologue(const Args& a, LAS unsigned char* lds, int gw, int NGW, int wave, int lane) {
    unsigned char* ws = a.ws;
    LAS float* scr = (LAS float*)(lds + wave * 16384);
    constexpr int I_GU = 16 * (NGU / 32), I_D = (FF / 64) * (D / 32), I_IN = 16 * (NPROJ / 32), I_O = 16 * (D / 32);
    constexpr int NITEMS = 2 * I_GU + 2 * I_D + I_IN + I_O;
    for (int it = gw; it < NITEMS; it += NGW) {
        int r = it;
        if (r < I_GU) { ColGU c{a.in[1], a.in[2]}; transpose_item(c, FF, D, (bf16*)(ws + WS_WGU1), scr, r / (NGU / 32), r % (NGU / 32), lane); continue; } r -= I_GU;
        if (r < I_GU) { ColGU c{a.in[17], a.in[18]}; transpose_item(c, FF, D, (bf16*)(ws + WS_WGU2), scr, r / (NGU / 32), r % (NGU / 32), lane); continue; } r -= I_GU;
        if (r < I_D) { ColPlain c{a.in[3]}; transpose_item(c, D, FF, (bf16*)(ws + WS_WD1), scr, r / (D / 32), r % (D / 32), lane); continue; } r -= I_D;
        if (r < I_D) { ColPlain c{a.in[19]}; transpose_item(c, D, FF, (bf16*)(ws + WS_WD2), scr, r / (D / 32), r % (D / 32), lane); continue; } r -= I_D;
        if (r < I_IN) { ColWin c{a.in[6]}; transpose_item(c, WIN_N, D, (bf16*)(ws + WS_WIN), scr, r / (NPROJ / 32), r % (NPROJ / 32), lane); continue; } r -= I_IN;
        { ColPlain c{a.in[14]}; transpose_item(c, D, D, (bf16*)(ws + WS_WOUT), scr, r / (D / 32), r % (D / 32), lane); }
    }
    const float* x = a.in[0]; bf16* xb = (bf16*)(ws + WS_XB);
    const size_t nthr = (size_t)NGW * 64, t0 = (size_t)gw * 64 + lane;
    for (size_t i = t0; i < (size_t)M * D / 8; i += nthr) {
        const f32x4 v0 = *(const f32x4*)(x + i * 8), v1 = *(const f32x4*)(x + i * 8 + 4);
        u32x4 o; o.x = pk2(v0[0], v0[1]); o.y = pk2(v0[2], v0[3]); o.z = pk2(v1[0], v1[1]); o.w = pk2(v1[2], v1[3]);
        *(u32x4*)(xb + i * 8) = o;
    }
}

__device__ __forceinline__ void ln_phase(const bf16* Y, float* Xf, bf16* Xb, const float* g, const float* b, int gw, int NGW, int lane) {
    float gv[16], bv[16];
#pragma unroll
    for (int j = 0; j < 2; ++j)
#pragma unroll
        for (int e = 0; e < 8; ++e) { gv[8 * j + e] = g[512 * j + 8 * lane + e]; bv[8 * j + e] = b[512 * j + 8 * lane + e]; }
#pragma unroll 2
    for (int m = gw; m < M; m += NGW) {
        const u32x4* yr = (const u32x4*)(Y + (size_t)m * D) + lane;
        const u32x4 y0 = yr[0], y1 = yr[64];
        float v[16]; float s = 0.f;
#pragma unroll
        for (int e = 0; e < 4; ++e) { v[2 * e] = bflo(y0[e]); v[2 * e + 1] = bfhi(y0[e]); v[8 + 2 * e] = bflo(y1[e]); v[9 + 2 * e] = bfhi(y1[e]); }
#pragma unroll
        for (int e = 0; e < 16; ++e) s += v[e];
        const float mean = wave_sum(s) * (1.f / D); float s2 = 0.f;
#pragma unroll
        for (int e = 0; e < 16; ++e) { v[e] -= mean; s2 += v[e] * v[e]; }
        const float rstd = 1.0f / sqrtf(wave_sum(s2) * (1.f / D) + LN_EPS);
#pragma unroll
        for (int e = 0; e < 16; ++e) v[e] = v[e] * rstd * gv[e] + bv[e];
        if (Xf) {
            f32x4* o = (f32x4*)(Xf + (size_t)m * D + 8 * lane);
            o[0] = (f32x4){v[0], v[1], v[2], v[3]}; o[1] = (f32x4){v[4], v[5], v[6], v[7]};
            o[128] = (f32x4){v[8], v[9], v[10], v[11]}; o[129] = (f32x4){v[12], v[13], v[14], v[15]};
        }
        if (Xb) {
            u32x4* o = (u32x4*)(Xb + (size_t)m * D) + lane;
            o[0] = (u32x4){pk2(v[0], v[1]), pk2(v[2], v[3]), pk2(v[4], v[5]), pk2(v[6], v[7])};
            o[64] = (u32x4){pk2(v[8], v[9]), pk2(v[10], v[11]), pk2(v[12], v[13]), pk2(v[14], v[15])};
        }
    }
}

__device__ __forceinline__ void gnorm_phase(bf16* MIX, const bf16* P, const float* wa, const float* wb, int gw, int NGW, int lane) {
    const int hd = lane >> 3, cc = (lane & 7) * 16;
    const float* wn = (hd < 4 ? wa : wb) + cc;
    float wv[16];
#pragma unroll
    for (int j = 0; j < 16; ++j) wv[j] = wn[j];
    const int gcol = (hd < 4 ? 1536 : 3072) + (hd & 3) * 128 + cc;
    for (int m = gw; m < M; m += NGW) {
        bf16* op = MIX + (size_t)m * D + lane * 16;
        const u32x4 o0 = *(const u32x4*)op, o1 = *(const u32x4*)(op + 8);
        const u32x4 g0 = *(const u32x4*)(P + (size_t)m * PW + gcol), g1 = *(const u32x4*)(P + (size_t)m * PW + gcol + 8);
        float o[16], g[16];
#pragma unroll
        for (int j = 0; j < 4; ++j) { o[2 * j] = bflo(o0[j]); o[2 * j + 1] = bfhi(o0[j]); o[8 + 2 * j] = bflo(o1[j]); o[9 + 2 * j] = bfhi(o1[j]);
                                      g[2 * j] = bflo(g0[j]); g[2 * j + 1] = bfhi(g0[j]); g[8 + 2 * j] = bflo(g1[j]); g[9 + 2 * j] = bfhi(g1[j]); }
        float ss = 0.f;
#pragma unroll
        for (int j = 0; j < 16; ++j) ss += o[j] * o[j];
        ss += __shfl_xor(ss, 1); ss += __shfl_xor(ss, 2); ss += __shfl_xor(ss, 4);
        const float rs = 1.0f / sqrtf(ss * (1.f / 128.f) + RMS_EPS);
        u32x4 r0, r1;
#pragma unroll
        for (int j = 0; j < 4; ++j) {
            r0[j] = pk2(o[2 * j] * rs * wv[2 * j] * silu(g[2 * j]), o[2 * j + 1] * rs * wv[2 * j + 1] * silu(g[2 * j + 1]));
            r1[j] = pk2(o[8 + 2 * j] * rs * wv[8 + 2 * j] * silu(g[8 + 2 * j]), o[9 + 2 * j] * rs * wv[9 + 2 * j] * silu(g[9 + 2 * j]));
        }
        *(u32x4*)op = r0; *(u32x4*)(op + 8) = r1;
    }
}

constexpr int PK_KN = 0, PK_QN = 17408, PK_RHS = 34816, PK_QF = 100352, PK_SC = 133120;
struct GdnPf { unsigned x[3][11]; f32x2_t w[3][4]; float s0, s1, dtb, alog; };
__device__ __forceinline__ void gdn_pf_load(GdnPf& f, const Args& a, int item, int tid) {
    const int n = item & 127, bh = item >> 7, h = bh & 3, b = bh >> 2, t0 = b * SEQ + n * 64;
    const int c2 = tid & 63, rg = tid >> 6;
    const bf16* P = (const bf16*)(a.ws + WS_HP);
    const float* cw = a.in[7];
#pragma unroll
    for (int mat = 0; mat < 3; ++mat) {
        const int ch = mat * 512 + h * 128 + 2 * c2;
#pragma unroll
        for (int i = 0; i < 11; ++i) { const int row = rg * 8 - 3 + i; const bool ok = !(n == 0 && row < 0);
            f.x[mat][i] = ok ? *(const unsigned*)(P + (size_t)(t0 + row) * PW + ch) : 0u; }
#pragma unroll
        for (int j = 0; j < 4; ++j) f.w[mat][j] = *(const f32x2_t*)(cw + j * 1536 + ch);
    }
    const float* sm = (const float*)(a.ws + WS_SMALL) + (size_t)(t0 + (tid & 63)) * 32;
    f.s0 = sm[h]; f.s1 = sm[4 + h]; f.dtb = a.in[9][h]; f.alog = a.in[8][h];
}
__device__ __forceinline__ void gdn_prep_item(const Args& a, LAS unsigned char* lds_in, int item, int tid_in, const GdnPf& f) {
    const int tid = opaque_v(tid_in); LAS unsigned char* lds = opaque_v(lds_in);
    const int bh = item >> 7, h = bh & 3;
    const int ci = item;
    const int lane = tid & 63, wid = tid >> 6;
    unsigned char* ws = a.ws;
    LAS float* RHS = opaque_v((LAS float*)(lds + PK_RHS)); LAS float* QF = opaque_v((LAS float*)(lds + PK_QF)); LAS float* AM = QF; LAS float* SC = opaque_v((LAS float*)(lds + PK_SC));
    LAS unsigned char* KNp = opaque_v(lds + PK_KN); LAS unsigned char* QNp = opaque_v(lds + PK_QN);
    bf16* DW = (bf16*)(ws + WS_DW) + (size_t)ci * 8192; bf16* DQ = (bf16*)(ws + WS_DQ) + (size_t)ci * 8192; bf16* DK = (bf16*)(ws + WS_DK) + (size_t)ci * 8192;
    bf16* DQK = (bf16*)((unsigned char*)a.out + OS_DQK) + (size_t)ci * 4096; bf16* DU = (bf16*)((unsigned char*)a.out + OS_DU) + (size_t)ci * 8192;
    float* DGL = (float*)(ws + WS_DGL);
    if (tid < 64) {
        const float be = 1.0f / (1.0f + __expf(-f.s0));
        const float xx = f.s1 + f.dtb;
        const float sp = xx > 20.f ? xx : log1pf(__expf(xx));
        float G = -__expf(f.alog) * sp;
#pragma unroll
        for (int o = 1; o < 64; o <<= 1) { const float t = __shfl_up(G, o); if (lane >= o) G += t; }
        const float Gl = __shfl(G, 63);
        SC[tid] = G; SC[64 + tid] = be; SC[128 + tid] = __expf(G); SC[192 + tid] = __expf(Gl - G);
        if (tid == 63) DGL[ci] = __expf(G);
    }
    {
        const int c2 = tid & 63, rg = tid >> 6;
#pragma unroll
        for (int mat = 0; mat < 3; ++mat) {
            float xa[11], xb[11];
#pragma unroll
            for (int i = 0; i < 11; ++i) { xa[i] = bflo(f.x[mat][i]); xb[i] = bfhi(f.x[mat][i]); }
            LAS float* dstp = (mat == 0 ? QF + rg * 8 * 128 : RHS + rg * 8 * 256 + (mat == 1 ? 128 : 0)) + 2 * c2; const int dstr = mat == 0 ? 128 : 256;
#pragma unroll
            for (int r = 0; r < 8; ++r) {
                const float ya = f.w[mat][0].x * xa[r] + f.w[mat][1].x * xa[r + 1] + f.w[mat][2].x * xa[r + 2] + f.w[mat][3].x * xa[r + 3];
                const float yb = f.w[mat][0].y * xb[r] + f.w[mat][1].y * xb[r + 1] + f.w[mat][2].y * xb[r + 2] + f.w[mat][3].y * xb[r + 3];
                *(LAS f32x2_t*)(dstp + r * dstr) = (f32x2_t){silu(ya), silu(yb)};
            }
        }
    }
    WG_BAR();
    {
        const int r = tid >> 3, p = tid & 7;
        const float be = SC[64 + r], eg = SC[128 + r];
        float qv[16], kv[16]; float sq = 0.f, sk = 0.f;
#pragma unroll
        for (int j = 0; j < 16; ++j) { qv[j] = QF[r * 128 + p * 16 + j]; kv[j] = RHS[r * 256 + 128 + p * 16 + j]; sq += qv[j] * qv[j]; sk += kv[j] * kv[j]; }
        sq += __shfl_xor(sq, 1); sq += __shfl_xor(sq, 2); sq += __shfl_xor(sq, 4);
        sk += __shfl_xor(sk, 1); sk += __shfl_xor(sk, 2); sk += __shfl_xor(sk, 4);
        const float rq = (1.0f / sqrtf(sq + RMS_EPS)) * 0.08838834764831845f, rk = 1.0f / sqrtf(sk + RMS_EPS);
#pragma unroll
        for (int j = 0; j < 16; ++j) { qv[j] *= rq; kv[j] *= rk; RHS[r * 256 + 128 + p * 16 + j] = be * eg * kv[j]; RHS[r * 256 + p * 16 + j] *= be; }
        LAS unsigned* kn = (LAS unsigned*)(KNp + r * 272 + p * 32); LAS unsigned* qn = (LAS unsigned*)(QNp + r * 272 + p * 32);
#pragma unroll
        for (int j = 0; j < 8; ++j) { kn[j] = pk2(kv[2 * j], kv[2 * j + 1]); qn[j] = pk2(qv[2 * j], qv[2 * j + 1]); }
        const int gi = p >> 1, hi = p & 1;
#pragma unroll
        for (int q4 = 0; q4 < 4; ++q4) { u32x2 w; w.x = pk2(qv[4 * q4] * eg, qv[4 * q4 + 1] * eg); w.y = pk2(qv[4 * q4 + 2] * eg, qv[4 * q4 + 3] * eg);
            *(u32x2*)(DQ + r * 128 + gi * 32 + 8 * q4 + 4 * hi) = w; }
    }
    WG_BAR();
    {
        const int cb = wid & 3; const bool isqk = wid >= 4; const int r = lane & 15, q = lane >> 4;
        const LAS unsigned char* Ab = isqk ? QNp : KNp;
        bf16x8 bv[4];
#pragma unroll
        for (int s = 0; s < 4; ++s) bv[s] = *(const LAS bf16x8*)(KNp + (16 * cb + r) * 272 + s * 64 + q * 16);
        const int jj = 16 * cb + r; const float Gj = SC[jj];
#pragma unroll 1
        for (int rb = 0; rb < 4; ++rb) {
            f32x4 acc = (f32x4){0.f, 0.f, 0.f, 0.f};
            if (rb >= cb) {
#pragma unroll
                for (int s = 0; s < 4; ++s) { const bf16x8 av = *(const LAS bf16x8*)(Ab + (16 * rb + r) * 272 + s * 64 + q * 16); acc = MFMA16(av, bv[s], acc); }
            }
#pragma unroll
            for (int i = 0; i < 4; ++i) {
                const int ii = 16 * rb + 4 * q + i; const float d = __expf(fminf(SC[ii] - Gj, 0.f));
                if (isqk) { DQK[ii * 64 + kperm(jj)] = f2bf((jj <= ii) ? acc[i] * d : 0.f); }
                else if (rb >= cb) { AM[ii * 64 + jj] = (jj < ii) ? SC[64 + ii] * acc[i] * d : 0.f; }
            }
        }
    }
    WG_BAR();
    if (tid < 256) {
        const int c = tid; LAS float* rc = RHS + c; const int pc = kperm(c & 127);
#pragma unroll 1
        for (int J = 0; J < 4; ++J) {
            float x[16];
            LAS float* rj = rc + J * 16 * 256; const LAS float* aj = AM + (J * 16) * 64 + J * 16;
#pragma unroll
            for (int r = 0; r < 16; ++r) x[r] = rj[r * 256];
#pragma unroll
            for (int hf = 0; hf < 2; ++hf) {
                f32x4 ad[8][4];
#pragma unroll
                for (int r8 = 0; r8 < 8; ++r8)
#pragma unroll
                    for (int jb = 0; jb < (8 * hf + r8 + 3) / 4; ++jb) ad[r8][jb] = *(const LAS f32x4*)(aj + (8 * hf + r8) * 64 + 4 * jb);
#pragma unroll
                for (int r8 = 0; r8 < 8; ++r8) {
                    const int r = 8 * hf + r8; float acc = x[r];
#pragma unroll
                    for (int jb = 0; jb < (r + 3) / 4; ++jb)
#pragma unroll
                        for (int e = 0; e < 4; ++e) if (4 * jb + e < r) acc -= ad[r8][jb][e] * x[4 * jb + e];
                    x[r] = acc;
                }
            }
            if (c < 128) {
#pragma unroll
                for (int k8 = 0; k8 < 2; ++k8) { u32x4 w; w.x = pk2(x[8 * k8], x[8 * k8 + 1]); w.y = pk2(x[8 * k8 + 2], x[8 * k8 + 3]); w.z = pk2(x[8 * k8 + 4], x[8 * k8 + 5]); w.w = pk2(x[8 * k8 + 6], x[8 * k8 + 7]);
                    *(u32x4*)(DU + c * 64 + 16 * J + 8 * k8) = w; }
            } else {
#pragma unroll
                for (int r = 0; r < 16; ++r) DW[(16 * J + r) * 128 + pc] = f2bf(x[r]);
            }
#pragma unroll 2
            for (int i = 16 * (J + 1); i < 64; ++i) {
                const LAS float* ai = AM + i * 64 + J * 16;
                const f32x4 a0 = *(const LAS f32x4*)ai, a1 = *(const LAS f32x4*)(ai + 4), a2 = *(const LAS f32x4*)(ai + 8), a3 = *(const LAS f32x4*)(ai + 12);
                float v = rc[i * 256];
                v -= a0[0] * x[0]; v -= a0[1] * x[1]; v -= a0[2] * x[2]; v -= a0[3] * x[3];
                v -= a1[0] * x[4]; v -= a1[1] * x[5]; v -= a1[2] * x[6]; v -= a1[3] * x[7];
                v -= a2[0] * x[8]; v -= a2[1] * x[9]; v -= a2[2] * x[10]; v -= a2[3] * x[11];
                v -= a3[0] * x[12]; v -= a3[1] * x[13]; v -= a3[2] * x[14]; v -= a3[3] * x[15];
                rc[i * 256] = v;
            }
        }
    } else if (tid < 384) {
        const int c = tid - 256;
#pragma unroll 1
        for (int k8 = 0; k8 < 8; ++k8) {
            float v[8];
#pragma unroll
            for (int e = 0; e < 8; ++e) v[e] = bf2f(*(const LAS unsigned short*)(KNp + (8 * k8 + e) * 272 + c * 2)) * SC[192 + 8 * k8 + e];
            const int m = k8 & 3, pos0 = 32 * (k8 >> 2) + 16 * (m & 1) + 4 * (m >> 1);
            u32x2 w0, w1; w0.x = pk2(v[0], v[1]); w0.y = pk2(v[2], v[3]); w1.x = pk2(v[4], v[5]); w1.y = pk2(v[6], v[7]);
            *(u32x2*)(DK + c * 64 + pos0) = w0; *(u32x2*)(DK + c * 64 + pos0 + 8) = w1;
        }
    }
    WG_BAR();
}

constexpr int GK_QT = 0, GK_KT = 9216, GK_PS = 18432, GK_LR = 20480;
struct GlaPf { f32x4 lr; unsigned v[8]; unsigned short q[8], k[8]; float wg[16]; float bg; };
__device__ __forceinline__ void gla_pf_load(GlaPf& f, const Args& a, int item, int tid) {
    const int n = item & 127, bh = item >> 7, h = bh & 3, b = bh >> 2, t0 = b * SEQ + n * 64;
    const bf16* P = (const bf16*)(a.ws + WS_HP);
    const float* SMALL = (const float*)(a.ws + WS_SMALL);
    f.lr = *(const f32x4*)(SMALL + (size_t)(t0 + ((tid & 255) >> 2)) * 32 + 8 + (tid & 3) * 4);
    const int dvp = tid & 63, tg = tid >> 6;
#pragma unroll
    for (int j = 0; j < 8; ++j) f.v[j] = *(const unsigned*)(P + (size_t)(t0 + tg * 8 + j) * PW + 2560 + h * 128 + 2 * dvp);
    const int k = tid & 63, rg = tid >> 6;
#pragma unroll
    for (int i = 0; i < 8; ++i) { f.q[i] = P[(size_t)(t0 + rg * 8 + i) * PW + 2048 + h * 64 + k]; f.k[i] = P[(size_t)(t0 + rg * 8 + i) * PW + 2304 + h * 64 + k]; }
#pragma unroll
    for (int j = 0; j < 16; ++j) f.wg[j] = a.in[11][j * 256 + h * 64 + k];
    f.bg = a.in[12][h * 64 + k];
}
__device__ __forceinline__ void gla_prep_item(const Args& a, LAS unsigned char* lds_in, int item, int tid_in, const GlaPf& f) {
    const int tid = opaque_v(tid_in); LAS unsigned char* lds = opaque_v(lds_in);
    const int ci = item;
    const int lane = tid & 63, wid = tid >> 6;
    unsigned char* ws = a.ws;
    unsigned char* os = (unsigned char*)a.out;
    bf16* GQ = (bf16*)(os + OS_GQ) + (size_t)ci * 4096; bf16* GA = (bf16*)(os + OS_GA) + (size_t)ci * 4096; bf16* GK = (bf16*)(os + OS_GK) + (size_t)ci * 4096;
    bf16* GV = (bf16*)(os + OS_GV) + (size_t)ci * 8192; float* GE = (float*)(ws + WS_GE) + (size_t)ci * 64;
    LAS float* PS = (LAS float*)(lds + GK_PS); LAS float* LR = (LAS float*)(lds + GK_LR);
    if (tid < 256) *(LAS f32x4*)(LR + tid * 4) = f.lr;
    {
        const int dvp = tid & 63, tg = tid >> 6;
        u32x4 w0, w1;
#pragma unroll
        for (int m = 0; m < 4; ++m) { w0[m] = (f.v[2 * m] & 0xffffu) | (f.v[2 * m + 1] << 16); w1[m] = (f.v[2 * m] >> 16) | (f.v[2 * m + 1] & 0xffff0000u); }
        *(u32x4*)(GV + (2 * dvp) * 64 + tg * 8) = w0; *(u32x4*)(GV + (2 * dvp + 1) * 64 + tg * 8) = w1;
    }
    WG_BAR();
    const int k = tid & 63, rg = tid >> 6;
    float lg[8];
    {
        float run = 0.f;
#pragma unroll
        for (int i = 0; i < 8; ++i) {
            const int r = rg * 8 + i; float x = f.bg;
#pragma unroll
            for (int j = 0; j < 16; ++j) x += LR[r * 16 + j] * f.wg[j];
            const float ls = fminf(x, 0.f) - log1pf(__expf(-fabsf(x)));
            run += ls * (1.0f / 16.0f); lg[i] = run;
        }
        PS[rg * 64 + k] = run;
    }
    WG_BAR();
    {
        float off = 0.f, tot = 0.f;
#pragma unroll
        for (int g2 = 0; g2 < 8; ++g2) { const float v = PS[g2 * 64 + k]; if (g2 < rg) off += v; tot += v; }
        float kd[8];
#pragma unroll
        for (int i = 0; i < 8; ++i) {
            const int r = rg * 8 + i; const float bc = lg[i] + off;
            const float qraw = bf2f(f.q[i]), kraw = bf2f(f.k[i]);
            const float qt = qraw * 0.125f * __expf(bc), kt = kraw * __expf(-bc);
            kd[i] = kraw * __expf(tot - bc);
            const unsigned short qb = f2bf(qt);
            *(LAS unsigned short*)(lds + GK_QT + r * 144 + k * 2) = qb; *(LAS unsigned short*)(lds + GK_KT + r * 144 + k * 2) = f2bf(kt);
            GQ[r * 64 + kperm(k)] = qb;
        }
        u32x4 w; w.x = pk2(kd[0], kd[1]); w.y = pk2(kd[2], kd[3]); w.z = pk2(kd[4], kd[5]); w.w = pk2(kd[6], kd[7]);
        *(u32x4*)(GK + k * 64 + rg * 8) = w;
        if (rg == 0) GE[k] = __expf(tot);
    }
    WG_BAR();
    if (wid < 4) {
        const int rb = wid, r = lane & 15, q = lane >> 4;
        f32x4 acc[4];
#pragma unroll
        for (int cb = 0; cb < 4; ++cb) acc[cb] = (f32x4){0.f, 0.f, 0.f, 0.f};
#pragma unroll
        for (int s = 0; s < 2; ++s) {
            const bf16x8 av = *(const LAS bf16x8*)(lds + GK_QT + (16 * rb + r) * 144 + s * 64 + q * 16);
#pragma unroll
            for (int cb = 0; cb < 4; ++cb) { const bf16x8 bv = *(const LAS bf16x8*)(lds + GK_KT + (16 * cb + r) * 144 + s * 64 + q * 16); acc[cb] = MFMA16(av, bv, acc[cb]); }
        }
#pragma unroll
        for (int cb = 0; cb < 4; ++cb)
#pragma unroll
            for (int i = 0; i < 4; ++i) { const int ii = 16 * rb + 4 * q + i, jj = 16 * cb + r; GA[ii * 64 + jj] = f2bf(jj <= ii ? acc[cb][i] : 0.f); }
    }
    WG_BAR();
}

constexpr int SB_W = 0, SB_Q = 17408, SB_K = 34816, SB_QK = 53248, SB_BYTES = 62464;
constexpr int GB_Q = 0, GB_A = 9216, GB_K = 18432, GB_BYTES = 27648;

constexpr int NLOAD = 512 - 64 * NCWAVE;
constexpr int GDN_KP = (3584 + NLOAD - 1) / NLOAD;
constexpr int GLA_KP = (1536 + NLOAD - 1) / NLOAD;

__device__ __forceinline__ void gdn_scan(const Args& a, LAS unsigned char* lds_in, int bh, int part, int tid_in) {
    const int tid = opaque_v(tid_in); LAS unsigned char* lds = opaque_v(lds_in);
    const int lane = tid & 63, wid = tid >> 6, c = lane & 15, q = lane >> 4, h = bh & 3, b = bh >> 2;
    unsigned char* ws = a.ws; unsigned char* os = (unsigned char*)a.out;
    if (wid >= NCWAVE) {
        const int lt = tid - 64 * NCWAVE;
        const u32x4* src[GDN_KP]; int cst[GDN_KP]; int dst[GDN_KP]; bool ok[GDN_KP];
#pragma unroll
        for (int k = 0; k < GDN_KP; ++k) {
            const int p = lt + k * NLOAD; ok[k] = p < 3584; const int pc = ok[k] ? p : 0; const int arr = pc >> 10, pp = pc & 1023;
            const unsigned char* base = arr == 0 ? ws + WS_DW : arr == 1 ? ws + WS_DQ : arr == 2 ? ws + WS_DK : os + OS_DQK;
            cst[k] = arr < 3 ? 1024 : 512;
            src[k] = (const u32x4*)base + (size_t)bh * 128 * cst[k] + pp;
            dst[k] = arr < 2 ? (arr == 0 ? SB_W : SB_Q) + (pp >> 4) * 272 + (pp & 15) * 16 : (arr == 2 ? SB_K : SB_QK) + (pp >> 3) * 144 + (pp & 7) * 16;
        }
        u32x4 sa[GDN_KP], sb[GDN_KP];
#define L_LOAD(set, n) do { const int n_ = (n) < NCHK ? (n) : NCHK - 1; _Pragma("unroll") for (int k = 0; k < GDN_KP; ++k) set[k] = src[k][(size_t)n_ * cst[k]]; } while (0)
#define L_STORE(set, buf) do { LAS unsigned char* B_ = lds + (buf) * SB_BYTES; _Pragma("unroll") for (int k = 0; k < GDN_KP; ++k) if (ok[k]) *(LAS u32x4*)(B_ + dst[k]) = set[k]; } while (0)
        L_LOAD(sa, 0); L_STORE(sa, 0); L_LOAD(sa, 1); L_LOAD(sb, 2);
        WG_BAR();
        for (int n = 0; n < NCHK; n += 2) {
            L_STORE(sa, 1); L_LOAD(sa, n + 3); WG_BAR();
            L_STORE(sb, 0); L_LOAD(sb, n + 4); WG_BAR();
        }
#undef L_LOAD
#undef L_STORE
        return;
    }
    const bf16* DU = (const bf16*)(os + OS_DU) + (size_t)bh * 128 * 8192; const float* DGL = (const float*)(ws + WS_DGL) + bh * 128;
    bf16* MIX = (bf16*)(ws + WS_MIX);
    const int dv = part * CW + 16 * wid + c;
    f32x4 S[8]; bf16x8 Sb[4];
#pragma unroll
    for (int i = 0; i < 8; ++i) S[i] = (f32x4){0.f, 0.f, 0.f, 0.f};
#pragma unroll
    for (int i = 0; i < 4; ++i) Sb[i] = (bf16x8){0, 0, 0, 0, 0, 0, 0, 0};
    u32x2 un[4];
#pragma unroll
    for (int rb = 0; rb < 4; ++rb) un[rb] = *(const u32x2*)(DU + dv * 64 + 16 * rb + 4 * q);
    WG_BAR();
    for (int n = 0; n < NCHK; ++n) {
        const int nn = n + 1 < NCHK ? n + 1 : n;
        const LAS unsigned char* B = lds + (n & 1) * SB_BYTES;
        const float gl = DGL[n];
        u32x2 uc[4];
#pragma unroll
        for (int rb = 0; rb < 4; ++rb) { uc[rb] = un[rb]; un[rb] = *(const u32x2*)(DU + (size_t)nn * 8192 + dv * 64 + 16 * rb + 4 * q); }
        f32x4 aO[4], aW[4];
#pragma unroll
        for (int rb = 0; rb < 4; ++rb) { aO[rb] = (f32x4){0.f, 0.f, 0.f, 0.f}; aW[rb] = (f32x4){0.f, 0.f, 0.f, 0.f}; }
#pragma unroll
        for (int s = 0; s < 4; ++s)
#pragma unroll
            for (int rb = 0; rb < 4; ++rb) {
                const bf16x8 wv = *(const LAS bf16x8*)(B + SB_W + (16 * rb + c) * 272 + s * 64 + q * 16);
                aW[rb] = MFMA16(wv, Sb[s], aW[rb]);
            }
#pragma unroll
        for (int s = 0; s < 4; ++s)
#pragma unroll
            for (int rb = 0; rb < 4; ++rb) {
                const bf16x8 qv = *(const LAS bf16x8*)(B + SB_Q + (16 * rb + c) * 272 + s * 64 + q * 16);
                aO[rb] = MFMA16(qv, Sb[s], aO[rb]);
            }
        f32x4 vn[4];
#pragma unroll
        for (int rb = 0; rb < 4; ++rb) vn[rb] = (f32x4){bflo(uc[rb].x), bfhi(uc[rb].x), bflo(uc[rb].y), bfhi(uc[rb].y)} - aW[rb];
        bf16x8 Vb[2]; Vb[0] = pack8(vn[0], vn[1]); Vb[1] = pack8(vn[2], vn[3]);
#pragma unroll
        for (int rb = 0; rb < 8; ++rb) {
            S[rb] = S[rb] * gl;
#pragma unroll
            for (int s = 0; s < 2; ++s) {
                const bf16x8 kv = *(const LAS bf16x8*)(B + SB_K + (16 * rb + c) * 144 + s * 64 + q * 16);
                S[rb] = MFMA16(kv, Vb[s], S[rb]);
            }
        }
#pragma unroll
        for (int s = 0; s < 2; ++s)
#pragma unroll
            for (int rb = 0; rb < 4; ++rb) {
                const bf16x8 kv = *(const LAS bf16x8*)(B + SB_QK + (16 * rb + c) * 144 + s * 64 + q * 16);
                aO[rb] = MFMA16(kv, Vb[s], aO[rb]);
            }
#pragma unroll
        for (int s = 0; s < 4; ++s) Sb[s] = pack8(S[2 * s], S[2 * s + 1]);
        bf16* op = MIX + (size_t)(b * SEQ + n * 64 + 4 * q) * D + h * 128 + dv;
#pragma unroll
        for (int rb = 0; rb < 4; ++rb)
#pragma unroll
            for (int i = 0; i < 4; ++i) op[(size_t)(16 * rb + i) * D] = f2bf(aO[rb][i]);
        WG_BAR();
    }
}

__device__ __forceinline__ void gla_scan(const Args& a, LAS unsigned char* lds_in, int bh, int part, int tid_in) {
    const int tid = opaque_v(tid_in); LAS unsigned char* lds = opaque_v(lds_in);
    const int lane = tid & 63, wid = tid >> 6, c = lane & 15, q = lane >> 4, h = bh & 3, b = bh >> 2;
    unsigned char* ws = a.ws; unsigned char* os = (unsigned char*)a.out;
    if (wid >= NCWAVE) {
        const int lt = tid - 64 * NCWAVE;
        const u32x4* src[GLA_KP]; int dst[GLA_KP]; bool ok[GLA_KP];
#pragma unroll
        for (int k = 0; k < GLA_KP; ++k) {
            const int p = lt + k * NLOAD; ok[k] = p < 1536; const int pc = ok[k] ? p : 0; const int arr = pc >> 9, pp = pc & 511;
            const unsigned char* base = arr == 0 ? os + OS_GQ : arr == 1 ? os + OS_GA : os + OS_GK;
            src[k] = (const u32x4*)base + (size_t)bh * 128 * 512 + pp;
            dst[k] = (arr == 0 ? GB_Q : arr == 1 ? GB_A : GB_K) + (pp >> 3) * 144 + (pp & 7) * 16;
        }
        u32x4 sa[GLA_KP], sb[GLA_KP];
#define L_LOAD(set, n) do { const int n_ = (n) < NCHK ? (n) : NCHK - 1; _Pragma("unroll") for (int k = 0; k < GLA_KP; ++k) set[k] = src[k][(size_t)n_ * 512]; } while (0)
#define L_STORE(set, buf) do { LAS unsigned char* B_ = lds + (buf) * GB_BYTES; _Pragma("unroll") for (int k = 0; k < GLA_KP; ++k) if (ok[k]) *(LAS u32x4*)(B_ + dst[k]) = set[k]; } while (0)
        L_LOAD(sa, 0); L_STORE(sa, 0); L_LOAD(sa, 1); L_LOAD(sb, 2);
        WG_BAR();
        for (int n = 0; n < NCHK; n += 2) {
            L_STORE(sa, 1); L_LOAD(sa, n + 3); WG_BAR();
            L_STORE(sb, 0); L_LOAD(sb, n + 4); WG_BAR();
        }
#undef L_LOAD
#undef L_STORE
        return;
    }
    const bf16* GV = (const bf16*)(os + OS_GV) + (size_t)bh * 128 * 8192; const float* GE = (const float*)(ws + WS_GE) + (size_t)bh * 128 * 64;
    bf16* MIX = (bf16*)(ws + WS_MIX);
    const int dv = part * CW + 16 * wid + c;
    f32x4 S[4]; bf16x8 Sb[2];
#pragma unroll
    for (int i = 0; i < 4; ++i) S[i] = (f32x4){0.f, 0.f, 0.f, 0.f};
#pragma unroll
    for (int i = 0; i < 2; ++i) Sb[i] = (bf16x8){0, 0, 0, 0, 0, 0, 0, 0};
    bf16x8 vnx[2]; f32x4 enx[4];
#pragma unroll
    for (int s = 0; s < 2; ++s) vnx[s] = *(const bf16x8*)(GV + dv * 64 + 32 * s + 8 * q);
#pragma unroll
    for (int rb = 0; rb < 4; ++rb) enx[rb] = *(const f32x4*)(GE + 16 * rb + 4 * q);
    WG_BAR();
    for (int n = 0; n < NCHK; ++n) {
        const int nn = n + 1 < NCHK ? n + 1 : n;
        const LAS unsigned char* B = lds + (n & 1) * GB_BYTES;
        bf16x8 Vb[2]; f32x4 eb[4];
#pragma unroll
        for (int s = 0; s < 2; ++s) { Vb[s] = vnx[s]; vnx[s] = *(const bf16x8*)(GV + (size_t)nn * 8192 + dv * 64 + 32 * s + 8 * q); }
#pragma unroll
        for (int rb = 0; rb < 4; ++rb) { eb[rb] = enx[rb]; enx[rb] = *(const f32x4*)(GE + (size_t)nn * 64 + 16 * rb + 4 * q); }
        f32x4 aO[4];
#pragma unroll
        for (int rb = 0; rb < 4; ++rb) aO[rb] = (f32x4){0.f, 0.f, 0.f, 0.f};
#pragma unroll
        for (int s = 0; s < 2; ++s)
#pragma unroll
            for (int rb = 0; rb < 4; ++rb) {
                const bf16x8 qv = *(const LAS bf16x8*)(B + GB_Q + (16 * rb + c) * 144 + s * 64 + q * 16);
                aO[rb] = MFMA16(qv, Sb[s], aO[rb]);
                const bf16x8 av = *(const LAS bf16x8*)(B + GB_A + (16 * rb + c) * 144 + s * 64 + q * 16);
                aO[rb] = MFMA16(av, Vb[s], aO[rb]);
            }
#pragma unroll
        for (int rb = 0; rb < 4; ++rb) {
            S[rb] = S[rb] * eb[rb];
#pragma unroll
            for (int s = 0; s < 2; ++s) {
                const bf16x8 kv = *(const LAS bf16x8*)(B + GB_K + (16 * rb + c) * 144 + s * 64 + q * 16);
                S[rb] = MFMA16(kv, Vb[s], S[rb]);
            }
        }
#pragma unroll
        for (int s = 0; s < 2; ++s) Sb[s] = pack8(S[2 * s], S[2 * s + 1]);
        bf16* op = MIX + (size_t)(b * SEQ + n * 64 + 4 * q) * D + 512 + h * 128 + dv;
#pragma unroll
        for (int rb = 0; rb < 4; ++rb)
#pragma unroll
            for (int i = 0; i < 4; ++i) op[(size_t)(16 * rb + i) * D] = f2bf(aO[rb][i]);
        WG_BAR();
    }
}

__global__ void __launch_bounds__(512, 2) fwd_kernel(Args a) {
    extern __shared__ __attribute__((aligned(16))) unsigned char lds_raw[];
    LAS unsigned char* lds = (LAS unsigned char*)lds_raw;
    const int tid = threadIdx.x, lane = tid & 63, wave = __builtin_amdgcn_readfirstlane(tid >> 6);
    const int G = gridDim.x, bx = blockIdx.x;
    const int vcu = (G % 8 == 0) ? (bx % 8) * (G / 8) + bx / 8 : bx;
    const int gw = vcu * 8 + wave, NGW = G * 8;
    unsigned char* ws = a.ws;
    const int lo = a.ph_lo, hi = a.ph_hi;
    volatile LAS unsigned* bst = (volatile LAS unsigned*)(lds + LDS_BYTES - 64);
    if (tid < 2) bst[tid] = 0u;
    __syncthreads();
    XcdBarrier bar; bar.bar = (unsigned*)ws; bar.x = 0; bar.st = bst;
    if (a.coop == 1) bar = xcd_barrier_post((unsigned*)ws, bst);
#define IN(k) (lo <= (k) && (k) < hi)
#define REPEAT(k) _Pragma("unroll 1") for (int rep_ = 0; rep_ < ((k) == XREP_PHASE ? a.pad : 1); ++rep_)
#ifndef PROBE_MASK
#define PROBE_MASK 0
#define PROBE_DIV 10
#endif
    unsigned long long* TS = (unsigned long long*)(ws + 32768);
    if (PROBE_MASK && bx == 0 && tid == 0) TS[0] = __builtin_amdgcn_s_memrealtime();
#define STAMP(k) do { if (PROBE_MASK && bx == 0 && tid == 0) TS[(k) + 1] = __builtin_amdgcn_s_memrealtime(); } while (0)
#define SEAM(k) do { if (IN(k) && IN((k) + 1)) { if (a.coop == 1) xcd_barrier(bar); else if (a.coop == 2) cg::this_grid().sync(); } STAMP(k); } while (0)
    bf16* XB = (bf16*)(ws + WS_XB); bf16* HB = (bf16*)(ws + WS_HP); bf16* MIX = (bf16*)(ws + WS_MIX);
    float* SMALL = (float*)(ws + WS_SMALL);

    if (IN(0)) REPEAT(0) { prologue(a, lds, gw, NGW, wave, lane); } SEAM(0);
    if (IN(1)) REPEAT(1) {
        pg8::Gemm g{XB, (const bf16*)(ws + WS_WGU1), M, NGU, D}; pg8::StaticOrder S; S.init(M, NGU, G, bx);
        pg8::EpiSwiglu E{HB, FF};
        pg8::gemm_phase<pg8::EpiSwiglu, pg8::StaticOrder, true, true>(lds, g, S, E);
    } SEAM(1);
    if (IN(2)) REPEAT(2) {
        pg8::Gemm g{HB, (const bf16*)(ws + WS_WD1), M, D, FF}; pg8::StaticOrder S; S.init(M, D, G, bx);
        pg8::EpiRes<false> E{a.in[0], (bf16*)a.out, ALPHA, 0.5f};
        pg8::gemm_phase<pg8::EpiRes<false>, pg8::StaticOrder, true, true>(lds, g, S, E);
    } SEAM(2);
    if (IN(3)) REPEAT(3) { ln_phase((const bf16*)a.out, nullptr, XB, a.in[4], a.in[5], gw, NGW, lane); } SEAM(3);
    if (IN(4)) REPEAT(4) {
        pg8::Gemm g{XB, (const bf16*)(ws + WS_WIN), M, NPROJ, D}; pg8::StaticOrder S; S.init(M, NPROJ, G, bx);
        pg8::EpiProj E{HB, SMALL};
        pg8::gemm_phase<pg8::EpiProj, pg8::StaticOrder, true, true>(lds, g, S, E);
    } SEAM(4);
    if (IN(5)) REPEAT(5) {
        {
            GdnPf pf; int it = bx; if (it < NCH) gdn_pf_load(pf, a, it, tid);
#pragma unroll 1
            for (; it < NCH; it += G) { const GdnPf cur = pf; if (it + G < NCH) gdn_pf_load(pf, a, it + G, tid); gdn_prep_item(a, lds, it, tid, cur); }
        }
        {
            GlaPf pf; int it = bx; if (it < NCH) gla_pf_load(pf, a, it, tid);
#pragma unroll 1
            for (; it < NCH; it += G) { const GlaPf cur = pf; if (it + G < NCH) gla_pf_load(pf, a, it + G, tid); gla_prep_item(a, lds, it, tid, cur); }
        }
    } SEAM(5);
    if (IN(6)) REPEAT(6) {
        const int xcd = bx & 7, slot = bx >> 3;
        if (slot < 4 * NPART) {
            const int sl = slot / NPART, part = slot % NPART, bh = xcd * 2 + (sl >> 1);
            if ((sl & 1) == 0) gdn_scan(a, lds, bh, part, tid); else gla_scan(a, lds, bh, part, tid);
        }
    } SEAM(6);
    if (IN(7)) { gnorm_phase(MIX, HB, a.in[10], a.in[13], gw, NGW, lane); } SEAM(7);
    if (IN(8)) REPEAT(8) {
        pg8::Gemm g{MIX, (const bf16*)(ws + WS_WOUT), M, D, D}; pg8::StaticOrder S; S.init(M, D, G, bx);
        pg8::EpiRes<true> E{XB, (bf16*)a.out, ALPHA, 1.0f};
        pg8::gemm_phase<pg8::EpiRes<true>, pg8::StaticOrder, true, true>(lds, g, S, E);
    } SEAM(8);
    if (IN(9)) { ln_phase((const bf16*)a.out, nullptr, XB, a.in[15], a.in[16], gw, NGW, lane); } SEAM(9);
    if (IN(10)) {
        pg8::Gemm g{XB, (const bf16*)(ws + WS_WGU2), M, NGU, D}; pg8::StaticOrder S; S.init(M, NGU, G, bx);
        pg8::EpiSwiglu E{HB, FF};
        pg8::gemm_phase<pg8::EpiSwiglu, pg8::StaticOrder, true, true>(lds, g, S, E);
    } SEAM(10);
    if (IN(11)) {
        pg8::Gemm g{HB, (const bf16*)(ws + WS_WD2), M, D, FF}; pg8::StaticOrder S; S.init(M, D, G, bx);
        pg8::EpiRes<true> E{XB, MIX, ALPHA, 0.5f};
        pg8::gemm_phase<pg8::EpiRes<true>, pg8::StaticOrder, true, true>(lds, g, S, E);
    } SEAM(11);
    if (IN(12)) { ln_phase(MIX, a.out, nullptr, a.in[20], a.in[21], gw, NGW, lane); }
    if (a.coop == 1) for (int i_ = 0; i_ < XREP_SYNC; ++i_) xcd_barrier(bar);
    if (PROBE_MASK && bx == 0) {
        asm volatile("s_waitcnt vmcnt(0)" ::: "memory"); __syncthreads();
        if (tid == 0) TS[13] = __builtin_amdgcn_s_memrealtime();
        __syncthreads();
        unsigned long long tot = 0;
        for (int k = 0; k < 13; ++k) if ((PROBE_MASK >> k) & 1) tot += __hip_atomic_load(&TS[k + 1], __ATOMIC_RELAXED, __HIP_MEMORY_SCOPE_AGENT) - __hip_atomic_load(&TS[k], __ATOMIC_RELAXED, __HIP_MEMORY_SCOPE_AGENT);
        int T = (int)(tot / PROBE_DIV); if (T > 8192) T = 8192;
        for (int i = tid; i < T; i += 512) a.out[i] += 0.1f;
    }
#undef IN
#undef SEAM
}

constexpr int NPHASE = 13;
#ifndef MK_MULTI
#define MK_MULTI 0
#endif
extern "C" void kernel_launch(void* const* d_in, const int* in_sizes, int n_in, void* d_out, int out_size, void* d_ws, size_t ws_size, hipStream_t stream) {
    static int grid = 0;
    if (grid == 0) {
        if (n_in != 22 || out_size != M * D || ws_size < WS_END) { fprintf(stderr, "kernel_launch: unexpected shapes (n_in %d out %d ws %zu)\n", n_in, out_size, ws_size); grid = -1; return; }
        int dev = 0, cus = 0, per_cu = 0;
        hipGetDevice(&dev); hipDeviceGetAttribute(&cus, hipDeviceAttributeMultiprocessorCount, dev);
        if (hipFuncSetAttribute((const void*)fwd_kernel, hipFuncAttributeMaxDynamicSharedMemorySize, LDS_BYTES) != hipSuccess) { fprintf(stderr, "kernel_launch: hipFuncSetAttribute failed\n"); grid = -1; return; }
        hipOccupancyMaxActiveBlocksPerMultiprocessor(&per_cu, (const void*)fwd_kernel, 512, LDS_BYTES);
        (void)hipGetLastError();
        if (per_cu < 1) per_cu = 1;
        grid = cus * 1;
        fprintf(stderr, "kernel_launch: cus %d per_cu %d grid %d\n", cus, per_cu, grid);
    }
    if (grid < 0) return;
    Args a{};
    for (int i = 0; i < 22; ++i) a.in[i] = (const float*)d_in[i];
    a.out = (float*)d_out; a.ws = (unsigned char*)d_ws; a.pad = XREP_N;
#if MK_MULTI
    for (int p = 0; p < NPHASE; ++p) { a.ph_lo = p; a.ph_hi = p + 1; a.coop = 0; hipLaunchKernelGGL(fwd_kernel, dim3(grid), dim3(512), LDS_BYTES, stream, a); }
#else
    if (hipMemsetAsync(d_ws, 0, 65536, stream) != hipSuccess) { fprintf(stderr, "kernel_launch: memset failed\n"); return; }
    a.ph_lo = 0; a.ph_hi = NPHASE; a.coop = 1;
    void* args[] = {&a};
    hipError_t e = hipLaunchCooperativeKernel((const void*)fwd_kernel, dim3(grid), dim3(512), args, LDS_BYTES, stream);
    if (e != hipSuccess) fprintf(stderr, "cooperative launch failed: %s (grid %d)\n", hipGetErrorString(e), grid);
#endif
}
```

```cpp
#include <hip/hip_runtime.h>
#include <hip/hip_cooperative_groups.h>
#include <cstdio>
#include <cstdint>
namespace cg = cooperative_groups;
#define LAS __attribute__((address_space(3)))
namespace pg8 {
#define PG8_LAS __attribute__((address_space(3)))
typedef unsigned short bf16_t;
typedef short bf16x8 __attribute__((ext_vector_type(8)));
typedef float f32x4 __attribute__((ext_vector_type(4)));
typedef unsigned u32x4 __attribute__((ext_vector_type(4)));
constexpr int BM = 256, BK = 64, HALF = 128, HTB = HALF * BK * 2  , STAGE_BYTES = 8 * HTB, NXCD = 8, WGM = 8;

__host__ __device__ __forceinline__ int lds_byte(int r, int c) { const int st = (r >> 4) * 2 + (c >> 5), rr = r & 15, cc = c & 31, ob = rr * 64 + cc * 2; return st * 1024 + (ob ^ (((ob >> 9) & 1) << 5)); }
__host__ __device__ __forceinline__ void stage_rc(int b, int& R, int& C) { const int st = b / 1024, sb = b % 1024, swz = sb ^ (((sb >> 9) & 1) << 5); R = (st >> 1) * 16 + swz / 64; C = (st & 1) * 32 + (swz % 64) / 2; }
__host__ __device__ __forceinline__ int perm32(int rho) { const int n = rho >> 4, i = rho & 15; return 8 * (i >> 2) + 4 * n + (i & 3); }

struct Unit { int pm, pn; };
struct Gemm { const bf16_t* A; const bf16_t* Bt; int M, N, K; };

struct StaticOrder {
    int nM, nN, nwg, G, c;
    __host__ __device__ void init(int M, int N, int G_, int c_) { nM = M / BM; nN = N / BM; nwg = nM * nN; G = G_; c = c_; }
    __host__ __device__ bool next(int i, Unit& u) const {
        const long L = (long)i * G + c; if (L >= nwg) return false;
        int wgid = (int)L; { const int q = nwg / NXCD, r = nwg % NXCD, xcd = wgid % NXCD, off = wgid / NXCD; wgid = (xcd < r ? xcd * (q + 1) : r * (q + 1) + (xcd - r) * q) + off; }
        const int nig = WGM * nN, gid = wgid / nig, fm = gid * WGM, gsz = (nM - fm) < WGM ? (nM - fm) : WGM;
        u.pm = fm + ((wgid % nig) % gsz); u.pn = (wgid % nig) / gsz; return true;
    }
    __device__ __forceinline__ void a_ready(const Unit&) const {}
    __device__ __forceinline__ void done(const Unit&) const {}
};

__device__ __forceinline__ unsigned cvt_pk_bf16(float lo, float hi) { unsigned r; asm volatile("v_cvt_pk_bf16_f32 %0, %1, %2" : "=v"(r) : "v"(lo), "v"(hi)); return r; }
typedef float f32x2 __attribute__((ext_vector_type(2)));
template <class Epi, class Sched, bool ALIGN_EPI = false, bool SP2 = false>
__device__ __forceinline__ void gemm_phase(PG8_LAS unsigned char* lds, const Gemm g, const Sched& S, const Epi& E) {
    const int tid = threadIdx.x, wid = __builtin_amdgcn_readfirstlane(tid >> 6), lane = tid & 63, wr = wid >> 2, wc = wid & 3, fr = lane & 15, fq = lane >> 4;
    const int K = g.K, nt = K / BK;
    unsigned voffA[2], voffB[2];
#pragma unroll
    for (int i = 0; i < 2; ++i) { int R, C; stage_rc(tid * 16 + i * 8192, R, C); const int Rb = Epi::PERM ? ((R & ~31) + perm32(R & 31)) : R;
        voffA[i] = (unsigned)(R * K + C) * 2u; voffB[i] = (unsigned)(Rb * K + C) * 2u; }
    const size_t kstep = (size_t)(BK * 2);
    const size_t hstep = (size_t)HALF * K * 2;
    const size_t tstep = 2 * hstep;
    const unsigned ldsw = (unsigned)wid * 1024u;
    const int aoff = lds_byte(wr * 64 + fr, fq * 8), boff = lds_byte(wc * 32 + fr, fq * 8);
#define PG8_SA(b, h) (((b) * 2 + (h)) * HTB)
#define PG8_SB(b, h) ((4 + (b) * 2 + (h)) * HTB)
#define PG8_STAGE(bufoff, gbase, voff) do { _Pragma("unroll") for (int _i = 0; _i < 2; ++_i) \
        __builtin_amdgcn_global_load_lds((const unsigned*)((const char*)(gbase) + (voff)[_i]), (PG8_LAS unsigned*)(lds + (bufoff) + ldsw + _i * 8192), 16, 0, 0); } while (0)
#define PG8_LDA(dst, b, h) do { _Pragma("unroll") for (int m = 0; m < 4; ++m) _Pragma("unroll") for (int k = 0; k < 2; ++k) dst[m][k] = *(const PG8_LAS bf16x8*)(lds + PG8_SA(b, h) + aoff + m * 2048 + k * 1024); } while (0)
#define PG8_LDB(dst, b, h) do { _Pragma("unroll") for (int n = 0; n < 2; ++n) _Pragma("unroll") for (int k = 0; k < 2; ++k) dst[n][k] = *(const PG8_LAS bf16x8*)(lds + PG8_SB(b, h) + boff + n * 2048 + k * 1024); } while (0)
#define PG8_MMA(ai, bj, At, Bt) do { __builtin_amdgcn_s_setprio(1); _Pragma("unroll") for (int m = 0; m < 4; ++m) _Pragma("unroll") for (int n = 0; n < 2; ++n) _Pragma("unroll") for (int k = 0; k < 2; ++k) \
        acc[ai][bj][m][n] = __builtin_amdgcn_mfma_f32_16x16x32_bf16(Bt[n][k], At[m][k], acc[ai][bj][m][n], 0, 0, 0); __builtin_amdgcn_s_setprio(0); } while (0)
#define PG8_WAIT_V(n) asm volatile("s_waitcnt vmcnt(" #n ")" ::: "memory")
#define PG8_WAIT_L(n) asm volatile("s_waitcnt lgkmcnt(" #n ")" ::: "memory")
#define PG8_BAR __builtin_amdgcn_s_barrier()
#define PG8_SCHED __builtin_amdgcn_sched_barrier(0)
    Unit cur, nxt; int ui = 0;
    if (!S.next(0, cur)) return;
    f32x4 acc[2][2][4][2];
#pragma unroll
    for (int a = 0; a < 2; ++a)
#pragma unroll
        for (int b = 0; b < 2; ++b)
#pragma unroll
            for (int m = 0; m < 4; ++m)
#pragma unroll
                for (int n = 0; n < 2; ++n) acc[a][b][m][n] = (f32x4){0.f, 0.f, 0.f, 0.f};
    bf16x8 At[4][2], B0[2][2], B1[2][2];
    const char* cA = (const char*)g.A + (size_t)cur.pm * tstep; const char* cB = (const char*)g.Bt + (size_t)cur.pn * tstep;
    S.a_ready(cur);
    if constexpr (SP2) {
        PG8_STAGE(PG8_SB(0, 0), cB, voffB); PG8_STAGE(PG8_SB(0, 1), cB + hstep, voffB); PG8_STAGE(PG8_SA(0, 0), cA, voffA); PG8_STAGE(PG8_SA(0, 1), cA + hstep, voffA);
        if (wr == 1) PG8_BAR;
        PG8_WAIT_V(2); PG8_BAR;
        PG8_STAGE(PG8_SB(1, 0), cB + kstep, voffB); PG8_STAGE(PG8_SA(1, 0), cA + kstep, voffA); PG8_STAGE(PG8_SB(1, 1), cB + hstep + kstep, voffB);
        PG8_WAIT_V(6); PG8_BAR;
    } else {
        PG8_STAGE(PG8_SB(0, 0), cB, voffB); PG8_STAGE(PG8_SA(0, 0), cA, voffA); PG8_STAGE(PG8_SB(0, 1), cB + hstep, voffB); PG8_STAGE(PG8_SA(0, 1), cA + hstep, voffA);
        if (wr == 1) PG8_BAR;
        PG8_WAIT_V(4); PG8_BAR;
        PG8_STAGE(PG8_SB(1, 0), cB + kstep, voffB); PG8_STAGE(PG8_SA(1, 0), cA + kstep, voffA); PG8_STAGE(PG8_SB(1, 1), cB + hstep + kstep, voffB);
        PG8_WAIT_V(6); PG8_BAR;
    }
    for (;;) {
        const bool has_next = S.next(ui + 1, nxt);
        const char* nA = has_next ? (const char*)g.A + (size_t)nxt.pm * tstep : cA; const char* nB = has_next ? (const char*)g.Bt + (size_t)nxt.pn * tstep : cB;
        for (int t = 0; t < nt; t += 2) {
            const bool last = (t == nt - 2);
            const char* a1 = cA + (size_t)(t + 1) * kstep;
            const char* a2 = last ? nA : cA + (size_t)(t + 2) * kstep; const char* b2 = last ? nB : cB + (size_t)(t + 2) * kstep;
            const char* a3 = a2 + kstep; const char* b3 = b2 + kstep;
            if (last && has_next) S.a_ready(nxt);
            if constexpr (SP2) {
            PG8_LDB(B0, 0, 0); PG8_LDB(B1, 0, 1); PG8_SCHED; PG8_LDA(At, 0, 0); PG8_STAGE(PG8_SA(1, 1), a1 + hstep, voffA);
            PG8_WAIT_V(8); PG8_WAIT_L(0); PG8_BAR; PG8_MMA(0, 0, At, B0); PG8_MMA(0, 1, At, B1); PG8_BAR; PG8_SCHED;
            PG8_LDA(At, 0, 1); PG8_STAGE(PG8_SB(0, 0), b2, voffB); PG8_STAGE(PG8_SB(0, 1), b2 + hstep, voffB); PG8_STAGE(PG8_SA(0, 0), a2, voffA);
            PG8_WAIT_V(8); PG8_WAIT_L(0); PG8_BAR; PG8_MMA(1, 0, At, B0); PG8_MMA(1, 1, At, B1); PG8_BAR; PG8_SCHED;
            PG8_LDB(B0, 1, 0); PG8_LDB(B1, 1, 1); PG8_SCHED; PG8_LDA(At, 1, 0); PG8_STAGE(PG8_SA(0, 1), a2 + hstep, voffA);
            PG8_WAIT_V(8); PG8_WAIT_L(0); PG8_BAR; PG8_MMA(0, 0, At, B0); PG8_MMA(0, 1, At, B1); PG8_BAR; PG8_SCHED;
            PG8_LDA(At, 1, 1); PG8_STAGE(PG8_SB(1, 0), b3, voffB); PG8_STAGE(PG8_SB(1, 1), b3 + hstep, voffB); PG8_STAGE(PG8_SA(1, 0), a3, voffA);
            PG8_WAIT_V(8); PG8_WAIT_L(0); PG8_BAR; PG8_MMA(1, 0, At, B0); PG8_MMA(1, 1, At, B1); PG8_BAR; PG8_SCHED;
            } else {
            PG8_LDB(B0, 0, 0); PG8_SCHED; PG8_LDA(At, 0, 0); PG8_STAGE(PG8_SA(1, 1), a1 + hstep, voffA);
            PG8_WAIT_L(8); PG8_BAR; PG8_WAIT_L(0); PG8_MMA(0, 0, At, B0); PG8_BAR; PG8_SCHED;
            PG8_LDB(B1, 0, 1); PG8_STAGE(PG8_SB(0, 0), b2, voffB);
            PG8_BAR; PG8_WAIT_L(0); PG8_MMA(0, 1, At, B1); PG8_BAR;
            PG8_LDA(At, 0, 1); PG8_STAGE(PG8_SA(0, 0), a2, voffA);
            PG8_BAR; PG8_WAIT_L(0); PG8_MMA(1, 0, At, B0); PG8_BAR; PG8_SCHED;
            PG8_STAGE(PG8_SB(0, 1), b2 + hstep, voffB);
            PG8_WAIT_V(6); PG8_BAR; PG8_MMA(1, 1, At, B1); PG8_BAR;
            PG8_LDB(B0, 1, 0); PG8_SCHED; PG8_LDA(At, 1, 0); PG8_STAGE(PG8_SA(0, 1), a2 + hstep, voffA);
            PG8_WAIT_L(8); PG8_BAR; PG8_WAIT_L(0); PG8_MMA(0, 0, At, B0); PG8_BAR; PG8_SCHED;
            PG8_LDB(B1, 1, 1); PG8_STAGE(PG8_SB(1, 0), b3, voffB);
            PG8_BAR; PG8_WAIT_L(0); PG8_MMA(0, 1, At, B1); PG8_BAR;
            PG8_LDA(At, 1, 1); PG8_STAGE(PG8_SA(1, 0), a3, voffA);
            PG8_BAR; PG8_WAIT_L(0); PG8_MMA(1, 0, At, B0); PG8_BAR; PG8_SCHED;
            PG8_STAGE(PG8_SB(1, 1), b3 + hstep, voffB);
            PG8_WAIT_V(6); PG8_BAR; PG8_MMA(1, 1, At, B1); PG8_BAR;
            }
        }
        if constexpr (ALIGN_EPI) { if (wr == 0) PG8_BAR; }
        if constexpr (!Epi::AFTER_DRAIN) { E(acc, cur, wr, wc, fr, fq); S.done(cur); }
        if (!has_next) break;
#pragma unroll
        for (int a = 0; a < 2; ++a)
#pragma unroll
            for (int b = 0; b < 2; ++b)
#pragma unroll
                for (int m = 0; m < 4; ++m)
#pragma unroll
                    for (int n = 0; n < 2; ++n) acc[a][b][m][n] = (f32x4){0.f, 0.f, 0.f, 0.f};
        cur = nxt; cA = nA; cB = nB; ++ui;
        if constexpr (ALIGN_EPI) { if (wr == 1) PG8_BAR; }
    }
    PG8_WAIT_V(0);
    if constexpr (!ALIGN_EPI) { if (wr == 0) PG8_BAR; }
    PG8_BAR;
    if constexpr (Epi::AFTER_DRAIN) { E.fused(acc, cur, wr, wc, fr, fq, lds, wid, lane); S.done(cur); }
#undef PG8_SA
#undef PG8_SB
#undef PG8_STAGE
#undef PG8_LDA
#undef PG8_LDB
#undef PG8_MMA
#undef PG8_WAIT_V
#undef PG8_WAIT_L
#undef PG8_BAR
#undef PG8_SCHED
}
}

namespace pg8 {
__device__ __forceinline__ float silu_f(float x) { return x * __builtin_amdgcn_rcpf(1.0f + __expf(-x)); }
__device__ __forceinline__ float bflo_f(unsigned u) { return __uint_as_float(u << 16); }
__device__ __forceinline__ float bfhi_f(unsigned u) { return __uint_as_float(u & 0xffff0000u); }

struct EpiSwiglu {
    static constexpr bool PERM = true, AFTER_DRAIN = false;
    bf16_t* O; int ldc;
    __device__ __forceinline__ void operator()(const f32x4 (&acc)[2][2][4][2], const Unit& u, int wr, int wc, int fr, int fq) const {
        const int row0 = u.pm * BM + wr * 64 + fr, col0 = u.pn * HALF + wc * 32 + 8 * fq;
#pragma unroll
        for (int ai = 0; ai < 2; ++ai)
#pragma unroll
            for (int m = 0; m < 4; ++m) {
                bf16_t* rowp = O + (size_t)(row0 + ai * HALF + m * 16) * ldc + col0;
                const f32x4 g0 = acc[ai][0][m][0], g1 = acc[ai][0][m][1], u0 = acc[ai][1][m][0], u1 = acc[ai][1][m][1];
                u32x4 w;
                w.x = cvt_pk_bf16(silu_f(g0[0]) * u0[0], silu_f(g0[1]) * u0[1]);
                w.y = cvt_pk_bf16(silu_f(g0[2]) * u0[2], silu_f(g0[3]) * u0[3]);
                w.z = cvt_pk_bf16(silu_f(g1[0]) * u1[0], silu_f(g1[1]) * u1[1]);
                w.w = cvt_pk_bf16(silu_f(g1[2]) * u1[2], silu_f(g1[3]) * u1[3]);
                *(u32x4*)rowp = w;
            }
    }
};

template <bool RES_BF16> struct EpiRes {
    static constexpr bool PERM = true, AFTER_DRAIN = false;
    const void* res; bf16_t* out; float alpha, scale;
    __device__ __forceinline__ void operator()(const f32x4 (&acc)[2][2][4][2], const Unit& u, int wr, int wc, int fr, int fq) const {
#pragma unroll
        for (int ai = 0; ai < 2; ++ai)
#pragma unroll
            for (int m = 0; m < 4; ++m) {
                const int row = u.pm * BM + wr * 64 + fr + ai * HALF + m * 16;
#pragma unroll
                for (int bj = 0; bj < 2; ++bj) {
                    const int col = u.pn * BM + bj * HALF + wc * 32 + 8 * fq; const size_t off = (size_t)row * 1024 + col;
                    f32x4 r0, r1;
                    if (RES_BF16) { const u32x4 rw = *(const u32x4*)((const bf16_t*)res + off);
                        r0 = (f32x4){bflo_f(rw.x), bfhi_f(rw.x), bflo_f(rw.y), bfhi_f(rw.y)}; r1 = (f32x4){bflo_f(rw.z), bfhi_f(rw.z), bflo_f(rw.w), bfhi_f(rw.w)}; }
                    else { r0 = *(const f32x4*)((const float*)res + off); r1 = *(const f32x4*)((const float*)res + off + 4); }
                    const f32x4 o0 = r0 * alpha + acc[ai][bj][m][0] * scale, o1 = r1 * alpha + acc[ai][bj][m][1] * scale;
                    u32x4 w; w.x = cvt_pk_bf16(o0[0], o0[1]); w.y = cvt_pk_bf16(o0[2], o0[3]); w.z = cvt_pk_bf16(o1[0], o1[1]); w.w = cvt_pk_bf16(o1[2], o1[3]);
                    *(u32x4*)(out + off) = w;
                }
            }
    }
};

struct EpiProj {
    static constexpr bool PERM = true, AFTER_DRAIN = false;
    bf16_t* P; float* SM;
    __device__ __forceinline__ void operator()(const f32x4 (&acc)[2][2][4][2], const Unit& u, int wr, int wc, int fr, int fq) const {
        const int row0 = u.pm * BM + wr * 64 + fr;
        if (u.pn < 14) {
            const int col0 = u.pn * BM + wc * 32 + 8 * fq;
#pragma unroll
            for (int ai = 0; ai < 2; ++ai)
#pragma unroll
                for (int m = 0; m < 4; ++m) { bf16_t* rowp = P + (size_t)(row0 + ai * HALF + m * 16) * 3584 + col0;
#pragma unroll
                    for (int bj = 0; bj < 2; ++bj) { const f32x4 v0 = acc[ai][bj][m][0], v1 = acc[ai][bj][m][1];
                        u32x4 w; w.x = cvt_pk_bf16(v0[0], v0[1]); w.y = cvt_pk_bf16(v0[2], v0[3]); w.z = cvt_pk_bf16(v1[0], v1[1]); w.w = cvt_pk_bf16(v1[2], v1[3]);
                        *(u32x4*)(rowp + bj * HALF) = w; } }
        } else if (wc == 0) {
#pragma unroll
            for (int ai = 0; ai < 2; ++ai)
#pragma unroll
                for (int m = 0; m < 4; ++m) { float* rowp = SM + (size_t)(row0 + ai * HALF + m * 16) * 32 + 8 * fq;
                    *(f32x4*)rowp = acc[ai][0][m][0]; *(f32x4*)(rowp + 4) = acc[ai][0][m][1]; }
        }
    }
};
}
#define XB_TMO      128
#define XB_XCNT(j)  (256  + 64 * (j))
#define XB_XSUB(j)  (1280 + 64 * (j))
#define XB_XGEN(j)  (2304 + 64 * (j))
#define XB_TOP      3328
#define XB_TOPGEN   3392
#define XCD_BAR_WORDS 3456
#define XB_SPIN_CAP (1u << 18)

__device__ __forceinline__ unsigned xb_ld(unsigned* p)              { return __hip_atomic_load(p, __ATOMIC_RELAXED, __HIP_MEMORY_SCOPE_AGENT); }
__device__ __forceinline__ unsigned xb_add(unsigned* p, unsigned v) { return __hip_atomic_fetch_add(p, v, __ATOMIC_RELAXED, __HIP_MEMORY_SCOPE_AGENT); }
__device__ __forceinline__ unsigned xb_xcc_id() { return (unsigned)__builtin_amdgcn_s_getreg((3 << 11) | 20) & 0xFu; }
#define XB_SPIN(cond, bar) do { unsigned _sp = 0; while (cond) { __builtin_amdgcn_s_sleep(1); \
    if ((++_sp & 255u) == 0u) { if (xb_ld(&(bar)[XB_TMO])) break; if (_sp > XB_SPIN_CAP) { atomicAdd(&(bar)[XB_TMO], 1u); break; } } } } while (0)

struct XcdBarrier {
    unsigned* bar; unsigned x;
    volatile LAS unsigned* st;
};

__device__ __forceinline__ XcdBarrier xcd_barrier_post(unsigned* bar, volatile LAS unsigned* st) {
    XcdBarrier b; b.bar = bar; b.x = xb_xcc_id(); b.st = st;
    if (threadIdx.x == 0) (void)xb_add(&bar[XB_XCNT(b.x)], 1u);
    return b;
}
__device__ __forceinline__ void xcd_barrier_complete(unsigned* bar, unsigned x, unsigned& nloc, unsigned& nx) {
    const unsigned G = gridDim.x * gridDim.y * gridDim.z;
    unsigned sum, cnt, mine, sp = 0u;
    for (;;) {
        sum = 0u; cnt = 0u; mine = 0u;
#pragma unroll
        for (unsigned j = 0; j < 16; ++j) { const unsigned c = xb_ld(&bar[XB_XCNT(j)]); sum += c; cnt += (c > 0u) ? 1u : 0u; mine = (j == x) ? c : mine; }
        if (sum == G) break;
        __builtin_amdgcn_s_sleep(1);
        if ((++sp & 255u) == 0u) { if (xb_ld(&bar[XB_TMO])) break; if (sp > XB_SPIN_CAP) { atomicAdd(&bar[XB_TMO], 1u); break; } }
    }
    nloc = mine > 0u ? mine : 1u; nx = cnt > 0u ? cnt : 1u;
}

__device__ __forceinline__ void xcd_barrier(const XcdBarrier& b) {
    asm volatile("s_waitcnt vmcnt(0)" ::: "memory");
    __syncthreads();
    if (threadIdx.x == 0) {
        unsigned* bar = b.bar;
        __builtin_amdgcn_s_waitcnt(0);
        unsigned nloc = b.st[0], nx = b.st[1];
        if (nloc == 0u) { xcd_barrier_complete(bar, b.x, nloc, nx); b.st[0] = nloc; b.st[1] = nx; }
        const unsigned old = xb_add(&bar[XB_XSUB(b.x)], 1u);
        const unsigned gen = old / nloc;
        if (old + 1u == (gen + 1u) * nloc) {
            __builtin_amdgcn_fence(__ATOMIC_RELEASE, "agent");
            asm volatile("s_waitcnt vmcnt(0)" ::: "memory");
            const unsigned og = xb_add(&bar[XB_TOP], 1u);
            const unsigned tg = og / nx;
            if (og + 1u == (tg + 1u) * nx) xb_add(&bar[XB_TOPGEN], 1u);
            else XB_SPIN(xb_ld(&bar[XB_TOPGEN]) == tg, bar);
            __builtin_amdgcn_fence(__ATOMIC_ACQUIRE, "agent");
            xb_add(&bar[XB_XGEN(b.x)], 1u);
            asm volatile("s_waitcnt vmcnt(0)" ::: "memory");
        } else {
            XB_SPIN(xb_ld(&bar[XB_XGEN(b.x)]) == gen, bar);
            __builtin_amdgcn_fence(__ATOMIC_ACQUIRE, "agent");
            asm volatile("s_waitcnt vmcnt(0)" ::: "memory");
        }
    }
    __syncthreads();
}

typedef unsigned short bf16;
typedef unsigned u32x4 __attribute__((ext_vector_type(4)));
typedef unsigned u32x2 __attribute__((ext_vector_type(2)));
typedef float f32x4 __attribute__((ext_vector_type(4)));
typedef short bf16x8 __attribute__((ext_vector_type(8)));
typedef float f32x2_t __attribute__((ext_vector_type(2)));
typedef __bf16 bf16x2_t __attribute__((ext_vector_type(2)));

constexpr int M = 32768, D = 1024, FF = 2816, NGU = 2 * FF, NPROJ = 3840, PW = 3584, SEQ = 8192, NCHK = 128, NCH = 2048;
constexpr int WIN_N = 3608;
constexpr float ALPHA = 1.189207115002721f;
constexpr float LN_EPS = 1e-5f, RMS_EPS = 1e-6f;
constexpr size_t MiB = 1u << 20;
constexpr size_t WS_WGU1 = 1 * MiB, WS_WD1 = 12 * MiB, WS_WIN = 18 * MiB, WS_WOUT = 26 * MiB, WS_WGU2 = 28 * MiB, WS_WD2 = 39 * MiB, WS_SMALL = 45 * MiB;
constexpr size_t WS_HP = 49 * MiB;
constexpr size_t WS_XB = 273 * MiB;
constexpr size_t WS_MIX = 337 * MiB;
constexpr size_t WS_DW = 401 * MiB, WS_DQ = 433 * MiB, WS_DK = 465 * MiB, WS_GE = 497 * MiB, WS_DGL = 498 * MiB, WS_END = 512 * MiB;
constexpr size_t OS_DU = 0, OS_GQ = 32 * MiB, OS_GA = 48 * MiB, OS_GK = 64 * MiB, OS_GV = 80 * MiB, OS_DQK = 112 * MiB;
constexpr int LDS_BYTES = 147456;
constexpr int NPART = 4, CW = 128 / NPART, NSL = 1, NCWAVE = CW / (16 * NSL);

__device__ __forceinline__ unsigned pk2(float lo, float hi) { f32x2_t v = {lo, hi}; bf16x2_t b = __builtin_convertvector(v, bf16x2_t); return __builtin_bit_cast(unsigned, b); }
__device__ __forceinline__ unsigned short f2bf(float f) { return (unsigned short)(pk2(f, 0.f) & 0xffffu); }
__device__ __forceinline__ float bf2f(unsigned short h) { return __uint_as_float((unsigned)h << 16); }
__device__ __forceinline__ float bflo(unsigned u) { return __uint_as_float(u << 16); }
__device__ __forceinline__ float bfhi(unsigned u) { return __uint_as_float(u & 0xffff0000u); }
__device__ __forceinline__ float silu(float x) { return x * __builtin_amdgcn_rcpf(1.0f + __expf(-x)); }
__device__ __forceinline__ int kperm(int a) { return (a & ~31) | (((a >> 2) & 3) << 3) | (((a >> 4) & 1) << 2) | (a & 3); }
__device__ __forceinline__ float wave_sum(float v) {
#pragma unroll
    for (int o = 1; o < 64; o <<= 1) v += __shfl_xor(v, o);
    return v;
}
template <class T> __device__ __forceinline__ T opaque_v(T p) { asm volatile("" : "+v"(p)); return p; }
#define WG_BAR() do { asm volatile("s_waitcnt lgkmcnt(0)" ::: "memory"); __builtin_amdgcn_s_barrier(); asm volatile("" ::: "memory"); } while (0)
#define MFMA16(a, b, c) __builtin_amdgcn_mfma_f32_16x16x32_bf16((a), (b), (c), 0, 0, 0)
__device__ __forceinline__ bf16x8 pack8(const f32x4& lo, const f32x4& hi) {
    u32x4 p; p.x = pk2(lo[0], lo[1]); p.y = pk2(lo[2], lo[3]); p.z = pk2(hi[0], hi[1]); p.w = pk2(hi[2], hi[3]); return __builtin_bit_cast(bf16x8, p);
}

#ifndef XREP_PHASE
#define XREP_PHASE -1
#define XREP_N 1
#define XREP_SYNC 0
#endif
struct Args { const float* in[22]; float* out; unsigned char* ws; int ph_lo, ph_hi, coop, pad; };

struct ColGU { const float* g; const float* u; __device__ __forceinline__ const float* operator()(int d) const { const int t = d >> 8, w = d & 255;
    const uintptr_t gp = (uintptr_t)g, up = (uintptr_t)u; const uintptr_t base = gp + (uintptr_t)((w >> 7) & 1) * (up - gp); return (const float*)base + t * 128 + (w & 127); } };
struct ColPlain { const float* w; __device__ __forceinline__ const float* operator()(int d) const { return w + d; } };
struct ColWin { const float* w; __device__ __forceinline__ const float* operator()(int d) const {
    if (d < 2048) return w + d; if (d < 3584) return w + d + 8; if (d < 3592) return w + d - 1536; if (d < 3608) return w + d; return nullptr; } };

template <class ColPtr>
__device__ __forceinline__ void transpose_item(const ColPtr& cp, int nsrc, int K, bf16* WT, LAS float* scr, int kb, int nb, int lane) {
    const int k0 = 64 * kb, n0 = 32 * nb;
    const float* colp = cp(n0 + (lane & 31));
#pragma unroll 8
    for (int i = 0; i < 32; ++i) { const int kk = 2 * i + (lane >> 5); scr[kk * 33 + (lane & 31)] = colp ? colp[(size_t)(k0 + kk) * nsrc] : 0.f; }
    asm volatile("s_waitcnt lgkmcnt(0)" ::: "memory");
    const int c = lane & 7;
#pragma unroll
    for (int j = 0; j < 4; ++j) { const int n = (lane >> 3) + 8 * j; const LAS float* s = scr + (8 * c) * 33 + n;
        u32x4 o; o.x = pk2(s[0 * 33], s[1 * 33]); o.y = pk2(s[2 * 33], s[3 * 33]); o.z = pk2(s[4 * 33], s[5 * 33]); o.w = pk2(s[6 * 33], s[7 * 33]);
        *(u32x4*)(WT + (size_t)(n0 + n) * K + k0 + 8 * c) = o; }
    asm volatile("s_waitcnt lgkmcnt(0)" ::: "memory");
}

__device__ __forceinline__ void prologue(const Args& a, LAS unsigned char* lds, int gw, int NGW, int wave, int lane, int part) {
    unsigned char* ws = a.ws;
    LAS float* scr = (LAS float*)(lds + wave * 16384);
    constexpr int I_GU = 16 * (NGU / 32), I_D = (FF / 64) * (D / 32), I_IN = 16 * (NPROJ / 32), I_O = 16 * (D / 32);
    if (part == 0) {
        constexpr int NITEMS = I_GU + I_D + I_IN;
        for (int it = gw; it < NITEMS; it += NGW) {
            int r = it;
            if (r < I_GU) { ColGU c{a.in[1], a.in[2]}; transpose_item(c, FF, D, (bf16*)(ws + WS_WGU1), scr, r / (NGU / 32), r % (NGU / 32), lane); continue; } r -= I_GU;
            if (r < I_D) { ColPlain c{a.in[3]}; transpose_item(c, D, FF, (bf16*)(ws + WS_WD1), scr, r / (D / 32), r % (D / 32), lane); continue; } r -= I_D;
            { ColWin c{a.in[6]}; transpose_item(c, WIN_N, D, (bf16*)(ws + WS_WIN), scr, r / (NPROJ / 32), r % (NPROJ / 32), lane); }
        }
    } else {
        constexpr int NITEMS = I_GU + I_D + I_O;
        for (int it = gw; it < NITEMS; it += NGW) {
            int r = it;
            if (r < I_GU) { ColGU c{a.in[17], a.in[18]}; transpose_item(c, FF, D, (bf16*)(ws + WS_WGU2), scr, r / (NGU / 32), r % (NGU / 32), lane); continue; } r -= I_GU;
            if (r < I_D) { ColPlain c{a.in[19]}; transpose_item(c, D, FF, (bf16*)(ws + WS_WD2), scr, r / (D / 32), r % (D / 32), lane); continue; } r -= I_D;
            { ColPlain c{a.in[14]}; transpose_item(c, D, D, (bf16*)(ws + WS_WOUT), scr, r / (D / 32), r % (D / 32), lane); }
        }
        return;
    }
    const float* x = a.in[0]; bf16* xb = (bf16*)(ws + WS_XB);
    const size_t nthr = (size_t)NGW * 64, t0 = (size_t)gw * 64 + lane;
    for (size_t i = t0; i < (size_t)M * D / 8; i += nthr) {
        const f32x4 v0 = *(const f32x4*)(x + i * 8), v1 = *(const f32x4*)(x + i * 8 + 4);
        u32x4 o; o.x = pk2(v0[0], v0[1]); o.y = pk2(v0[2], v0[3]); o.z = pk2(v1[0], v1[1]); o.w = pk2(v1[2], v1[3]);
        *(u32x4*)(xb + i * 8) = o;
    }
}

__device__ __forceinline__ void ln_phase(const bf16* Y, float* Xf, bf16* Xb, const float* g, const float* b, int gw, int NGW, int lane) {
    float gv[16], bv[16];
#pragma unroll
    for (int j = 0; j < 2; ++j)
#pragma unroll
        for (int e = 0; e < 8; ++e) { gv[8 * j + e] = g[512 * j + 8 * lane + e]; bv[8 * j + e] = b[512 * j + 8 * lane + e]; }
#pragma unroll 2
    for (int m = gw; m < M; m += NGW) {
        const u32x4* yr = (const u32x4*)(Y + (size_t)m * D) + lane;
        const u32x4 y0 = yr[0], y1 = yr[64];
        float v[16]; float s = 0.f;
#pragma unroll
        for (int e = 0; e < 4; ++e) { v[2 * e] = bflo(y0[e]); v[2 * e + 1] = bfhi(y0[e]); v[8 + 2 * e] = bflo(y1[e]); v[9 + 2 * e] = bfhi(y1[e]); }
#pragma unroll
        for (int e = 0; e < 16; ++e) s += v[e];
        const float mean = wave_sum(s) * (1.f / D); float s2 = 0.f;
#pragma unroll
        for (int e = 0; e < 16; ++e) { v[e] -= mean; s2 += v[e] * v[e]; }
        const float rstd = 1.0f / sqrtf(wave_sum(s2) * (1.f / D) + LN_EPS);
#pragma unroll
        for (int e = 0; e < 16; ++e) v[e] = v[e] * rstd * gv[e] + bv[e];
        if (Xf) {
            f32x4* o = (f32x4*)(Xf + (size_t)m * D + 8 * lane);
            o[0] = (f32x4){v[0], v[1], v[2], v[3]}; o[1] = (f32x4){v[4], v[5], v[6], v[7]};
            o[128] = (f32x4){v[8], v[9], v[10], v[11]}; o[129] = (f32x4){v[12], v[13], v[14], v[15]};
        }
        if (Xb) {
            u32x4* o = (u32x4*)(Xb + (size_t)m * D) + lane;
            o[0] = (u32x4){pk2(v[0], v[1]), pk2(v[2], v[3]), pk2(v[4], v[5]), pk2(v[6], v[7])};
            o[64] = (u32x4){pk2(v[8], v[9]), pk2(v[10], v[11]), pk2(v[12], v[13]), pk2(v[14], v[15])};
        }
    }
}

__device__ __forceinline__ void gnorm_phase(bf16* MIX, const bf16* P, const float* wa, const float* wb, int gw, int NGW, int lane) {
    const int hd = lane >> 3, cc = (lane & 7) * 16;
    const float* wn = (hd < 4 ? wa : wb) + cc;
    float wv[16];
#pragma unroll
    for (int j = 0; j < 16; ++j) wv[j] = wn[j];
    const int gcol = (hd < 4 ? 1536 : 3072) + (hd & 3) * 128 + cc;
    for (int m = gw; m < M; m += NGW) {
        bf16* op = MIX + (size_t)m * D + lane * 16;
        const u32x4 o0 = *(const u32x4*)op, o1 = *(const u32x4*)(op + 8);
        const u32x4 g0 = *(const u32x4*)(P + (size_t)m * PW + gcol), g1 = *(const u32x4*)(P + (size_t)m * PW + gcol + 8);
        float o[16], g[16];
#pragma unroll
        for (int j = 0; j < 4; ++j) { o[2 * j] = bflo(o0[j]); o[2 * j + 1] = bfhi(o0[j]); o[8 + 2 * j] = bflo(o1[j]); o[9 + 2 * j] = bfhi(o1[j]);
                                      g[2 * j] = bflo(g0[j]); g[2 * j + 1] = bfhi(g0[j]); g[8 + 2 * j] = bflo(g1[j]); g[9 + 2 * j] = bfhi(g1[j]); }
        float ss = 0.f;
#pragma unroll
        for (int j = 0; j < 16; ++j) ss += o[j] * o[j];
        ss += __shfl_xor(ss, 1); ss += __shfl_xor(ss, 2); ss += __shfl_xor(ss, 4);
        const float rs = 1.0f / sqrtf(ss * (1.f / 128.f) + RMS_EPS);
        u32x4 r0, r1;
#pragma unroll
        for (int j = 0; j < 4; ++j) {
            r0[j] = pk2(o[2 * j] * rs * wv[2 * j] * silu(g[2 * j]), o[2 * j + 1] * rs * wv[2 * j + 1] * silu(g[2 * j + 1]));
            r1[j] = pk2(o[8 + 2 * j] * rs * wv[8 + 2 * j] * silu(g[8 + 2 * j]), o[9 + 2 * j] * rs * wv[9 + 2 * j] * silu(g[9 + 2 * j]));
        }
        *(u32x4*)op = r0; *(u32x4*)(op + 8) = r1;
    }
}

constexpr int PK_KN = 0, PK_QN = 17408, PK_RHS = 34816, PK_QF = 100352, PK_SC = 133120;
#ifndef PROBE_MASK
#define PROBE_MASK 0
#define PROBE_DIV 10
#endif
#define ACC_T0() unsigned long long t0_ = 0; if (PROBE_MASK >> 13) { if (blockIdx.x == 0 && threadIdx.x == 0) t0_ = __builtin_amdgcn_s_memrealtime(); }
#define ACC_ADD(slot) do { if (PROBE_MASK >> 13) { if (blockIdx.x == 0 && threadIdx.x == 0) { const unsigned long long t1_ = __builtin_amdgcn_s_memrealtime(); unsigned long long* A_ = (unsigned long long*)(a.ws + 32768) + 32 + (slot); *A_ += t1_ - t0_; t0_ = t1_; } } } while (0)
struct GdnPf { unsigned x[3][11]; f32x2_t w[3][4]; float s0, s1, dtb, alog; };
__device__ __forceinline__ void gdn_pf_load(GdnPf& f, const Args& a, int item, int tid) {
    const int n = item & 127, bh = item >> 7, h = bh & 3, b = bh >> 2, t0 = b * SEQ + n * 64;
    const int c2 = tid & 63, rg = tid >> 6;
    const bf16* P = (const bf16*)(a.ws + WS_HP);
    const float* cw = a.in[7];
#pragma unroll
    for (int mat = 0; mat < 3; ++mat) {
        const int ch = mat * 512 + h * 128 + 2 * c2;
#pragma unroll
        for (int i = 0; i < 11; ++i) { const int row = rg * 8 - 3 + i; const bool ok = !(n == 0 && row < 0);
            f.x[mat][i] = ok ? *(const unsigned*)(P + (size_t)(t0 + row) * PW + ch) : 0u; }
#pragma unroll
        for (int j = 0; j < 4; ++j) f.w[mat][j] = *(const f32x2_t*)(cw + j * 1536 + ch);
    }
    const float* sm = (const float*)(a.ws + WS_SMALL) + (size_t)(t0 + (tid & 63)) * 32;
    f.s0 = sm[h]; f.s1 = sm[4 + h]; f.dtb = a.in[9][h]; f.alog = a.in[8][h];
}
__device__ __forceinline__ void gdn_prep_item(const Args& a, LAS unsigned char* lds_in, int item, int tid_in, const GdnPf& f) {
    const int tid = opaque_v(tid_in); LAS unsigned char* lds = opaque_v(lds_in);
    const int bh = item >> 7, h = bh & 3;
    const int ci = item;
    const int lane = tid & 63, wid = tid >> 6;
    unsigned char* ws = a.ws;
    LAS float* RHS = opaque_v((LAS float*)(lds + PK_RHS)); LAS float* QF = opaque_v((LAS float*)(lds + PK_QF)); LAS float* AM = QF; LAS float* SC = opaque_v((LAS float*)(lds + PK_SC));
    LAS unsigned char* KNp = opaque_v(lds + PK_KN); LAS unsigned char* QNp = opaque_v(lds + PK_QN);
    bf16* DW = (bf16*)(ws + WS_DW) + (size_t)ci * 8192; bf16* DQ = (bf16*)(ws + WS_DQ) + (size_t)ci * 8192; bf16* DK = (bf16*)(ws + WS_DK) + (size_t)ci * 8192;
    bf16* DQK = (bf16*)((unsigned char*)a.out + OS_DQK) + (size_t)ci * 4096; bf16* DU = (bf16*)((unsigned char*)a.out + OS_DU) + (size_t)ci * 8192;
    float* DGL = (float*)(ws + WS_DGL);
    ACC_T0();
    if (tid < 64) {
        const float be = __builtin_amdgcn_rcpf(1.0f + __expf(-f.s0));
        const float xx = f.s1 + f.dtb;
        const float sp = xx > 20.f ? xx : log1pf(__expf(xx));
        float G = -__expf(f.alog) * sp;
#pragma unroll
        for (int o = 1; o < 64; o <<= 1) { const float t = __shfl_up(G, o); if (lane >= o) G += t; }
        const float Gl = __shfl(G, 63);
        SC[tid] = G; SC[64 + tid] = be; SC[128 + tid] = __expf(G); SC[192 + tid] = __expf(Gl - G);
        if (tid == 63) DGL[ci] = __expf(G);
    }
    {
        const int c2 = tid & 63, rg = tid >> 6;
#pragma unroll
        for (int mat = 0; mat < 3; ++mat) {
            float xa[11], xb[11];
#pragma unroll
            for (int i = 0; i < 11; ++i) { xa[i] = bflo(f.x[mat][i]); xb[i] = bfhi(f.x[mat][i]); }
            LAS float* dstp = (mat == 0 ? QF + rg * 8 * 128 : RHS + rg * 8 * 256 + (mat == 1 ? 128 : 0)) + 2 * c2; const int dstr = mat == 0 ? 128 : 256;
#pragma unroll
            for (int r = 0; r < 8; ++r) {
                const float ya = f.w[mat][0].x * xa[r] + f.w[mat][1].x * xa[r + 1] + f.w[mat][2].x * xa[r + 2] + f.w[mat][3].x * xa[r + 3];
                const float yb = f.w[mat][0].y * xb[r] + f.w[mat][1].y * xb[r + 1] + f.w[mat][2].y * xb[r + 2] + f.w[mat][3].y * xb[r + 3];
                *(LAS f32x2_t*)(dstp + r * dstr) = (f32x2_t){silu(ya), silu(yb)};
            }
        }
    }
    WG_BAR(); ACC_ADD(2);
    {
        const int l5 = tid & 31, rbase = tid >> 5;
        const int g32 = l5 >> 3, hi = (l5 >> 2) & 1, q4 = l5 & 3;
#pragma unroll
        for (int aa = 0; aa < 4; ++aa) {
            const int r = rbase + 16 * aa;
            const float be = SC[64 + r], eg = SC[128 + r];
            f32x4 qv = *(const LAS f32x4*)(QF + r * 128 + 4 * l5), kv = *(const LAS f32x4*)(RHS + r * 256 + 128 + 4 * l5), vv = *(const LAS f32x4*)(RHS + r * 256 + 4 * l5);
            float sq = (qv[0] * qv[0] + qv[1] * qv[1]) + (qv[2] * qv[2] + qv[3] * qv[3]), sk = (kv[0] * kv[0] + kv[1] * kv[1]) + (kv[2] * kv[2] + kv[3] * kv[3]);
#pragma unroll
            for (int o = 1; o < 32; o <<= 1) { sq += __shfl_xor(sq, o); sk += __shfl_xor(sk, o); }
            const float rq = __builtin_amdgcn_rsqf(sq + RMS_EPS) * 0.08838834764831845f, rk = __builtin_amdgcn_rsqf(sk + RMS_EPS);
            qv = qv * rq; kv = kv * rk;
            *(LAS f32x4*)(RHS + r * 256 + 128 + 4 * l5) = kv * (be * eg);
            *(LAS f32x4*)(RHS + r * 256 + 4 * l5) = vv * be;
            u32x2 kw, qw; kw.x = pk2(kv[0], kv[1]); kw.y = pk2(kv[2], kv[3]); qw.x = pk2(qv[0], qv[1]); qw.y = pk2(qv[2], qv[3]);
            *(LAS u32x2*)(KNp + r * 272 + 8 * l5) = kw; *(LAS u32x2*)(QNp + r * 272 + 8 * l5) = qw;
            u32x2 mine; mine.x = pk2(qv[0] * eg, qv[1] * eg); mine.y = pk2(qv[2] * eg, qv[3] * eg);
            u32x2 oth; oth.x = __shfl_xor(mine.x, 4); oth.y = __shfl_xor(mine.y, 4);
            if ((aa >> 1) == hi) { const int rr = r; u32x4 w = hi == 0 ? (u32x4){mine.x, mine.y, oth.x, oth.y} : (u32x4){oth.x, oth.y, mine.x, mine.y};
                *(u32x4*)(DQ + rr * 128 + g32 * 32 + 8 * q4) = w; }
        }
    }
    WG_BAR(); ACC_ADD(3);
    {
        const int cb = wid & 3; const bool isqk = wid >= 4; const int r = lane & 15, q = lane >> 4;
        const LAS unsigned char* Ab = isqk ? QNp : KNp;
        bf16x8 bv[4];
#pragma unroll
        for (int s = 0; s < 4; ++s) bv[s] = *(const LAS bf16x8*)(KNp + (16 * cb + r) * 272 + s * 64 + q * 16);
        const int jj = 16 * cb + r; const float Gj = SC[jj];
#pragma unroll 1
        for (int rb = 0; rb < 4; ++rb) {
            f32x4 acc = (f32x4){0.f, 0.f, 0.f, 0.f};
            if (rb >= cb) {
#pragma unroll
                for (int s = 0; s < 4; ++s) { const bf16x8 av = *(const LAS bf16x8*)(Ab + (16 * rb + r) * 272 + s * 64 + q * 16); acc = MFMA16(av, bv[s], acc); }
            }
#pragma unroll
            for (int i = 0; i < 4; ++i) {
                const int ii = 16 * rb + 4 * q + i; const float d = __expf(fminf(SC[ii] - Gj, 0.f));
                if (isqk) { DQK[ii * 64 + kperm(jj)] = f2bf((jj <= ii) ? acc[i] * d : 0.f); }
                else if (rb >= cb) { AM[ii * 68 + jj] = (jj < ii) ? SC[64 + ii] * acc[i] * d : 0.f; }
            }
        }
    }
    WG_BAR(); ACC_ADD(4);
    if (tid >= 256 && tid < 384) {
        const int c = tid - 256;
#pragma unroll 1
        for (int k8 = 0; k8 < 8; ++k8) {
            float v[8];
#pragma unroll
            for (int e = 0; e < 8; ++e) v[e] = bf2f(*(const LAS unsigned short*)(KNp + (8 * k8 + e) * 272 + c * 2)) * SC[192 + 8 * k8 + e];
            const int m = k8 & 3, pos0 = 32 * (k8 >> 2) + 16 * (m & 1) + 4 * (m >> 1);
            u32x2 w0, w1; w0.x = pk2(v[0], v[1]); w0.y = pk2(v[2], v[3]); w1.x = pk2(v[4], v[5]); w1.y = pk2(v[6], v[7]);
            *(u32x2*)(DK + c * 64 + pos0) = w0; *(u32x2*)(DK + c * 64 + pos0 + 8) = w1;
        }
    }
#pragma unroll 1
    for (int J = 0; J < 4; ++J) {
        if (tid < 256) {
            const int c = tid; LAS float* rj = RHS + c + J * 16 * 256; const LAS float* aj = AM + (J * 16) * 68 + J * 16; const int pc = kperm(c & 127);
            float x[16];
#pragma unroll
            for (int r = 0; r < 16; ++r) x[r] = rj[r * 256];
#pragma unroll
            for (int hf = 0; hf < 2; ++hf) {
                f32x4 ad[8][4];
#pragma unroll
                for (int r8 = 0; r8 < 8; ++r8)
#pragma unroll
                    for (int jb = 0; jb < (8 * hf + r8 + 3) / 4; ++jb) ad[r8][jb] = *(const LAS f32x4*)(aj + (8 * hf + r8) * 68 + 4 * jb);
#pragma unroll
                for (int r8 = 0; r8 < 8; ++r8) {
                    const int r = 8 * hf + r8; f32x2_t a2 = (f32x2_t){x[r], 0.f};
#pragma unroll
                    for (int m = 0; m < r / 2; ++m)
                        a2 -= ((m & 1) ? __builtin_shufflevector(ad[r8][m >> 1], ad[r8][m >> 1], 2, 3) : __builtin_shufflevector(ad[r8][m >> 1], ad[r8][m >> 1], 0, 1)) * (f32x2_t){x[2 * m], x[2 * m + 1]};
                    float acc = a2.x + a2.y;
                    if (r & 1) acc -= ad[r8][(r - 1) >> 2][(r - 1) & 3] * x[r - 1];
                    x[r] = acc;
                }
            }
            if (J < 3) {
#pragma unroll
                for (int r = 0; r < 16; ++r) rj[r * 256] = x[r];
            }
            if (c < 128) {
#pragma unroll
                for (int k8 = 0; k8 < 2; ++k8) { u32x4 w; w.x = pk2(x[8 * k8], x[8 * k8 + 1]); w.y = pk2(x[8 * k8 + 2], x[8 * k8 + 3]); w.z = pk2(x[8 * k8 + 4], x[8 * k8 + 5]); w.w = pk2(x[8 * k8 + 6], x[8 * k8 + 7]);
                    *(u32x4*)(DU + c * 64 + 16 * J + 8 * k8) = w; }
            } else {
#pragma unroll
                for (int r = 0; r < 16; ++r) DW[(16 * J + r) * 128 + pc] = f2bf(x[r]);
            }
        }
        WG_BAR();
        if (J < 3) {
            const int c16 = lane & 15, q = lane >> 4, nblk = (3 - J) * 16;
#pragma unroll 2
            for (int blk = wid; blk < nblk; blk += 8) {
                const int rb = J + 1 + (blk >> 4), cb = blk & 15;
                LAS float* cp = RHS + (16 * rb + 4 * q) * 256 + 16 * cb + c16;
                const LAS float* ap = AM + (16 * rb + c16) * 68 + 16 * J + q;
                const LAS float* bp = RHS + (16 * J + q) * 256 + 16 * cb + c16;
                f32x4 acc = (f32x4){cp[0], cp[256], cp[512], cp[768]};
#pragma unroll
                for (int s4 = 0; s4 < 4; ++s4) acc = __builtin_amdgcn_mfma_f32_16x16x4f32(-ap[4 * s4], bp[4 * s4 * 256], acc, 0, 0, 0);
                cp[0] = acc[0]; cp[256] = acc[1]; cp[512] = acc[2]; cp[768] = acc[3];
            }
            WG_BAR();
        }
    }
    ACC_ADD(5);
}

constexpr int GK_QT = 0, GK_KT = 9216, GK_PS = 18432, GK_LR = 20480;
struct GlaPf { f32x4 lr; unsigned v[8]; unsigned short q[8], k[8]; float wg[16]; float bg; };
__device__ __forceinline__ void gla_pf_load(GlaPf& f, const Args& a, int item, int tid) {
    const int n = item & 127, bh = item >> 7, h = bh & 3, b = bh >> 2, t0 = b * SEQ + n * 64;
    const bf16* P = (const bf16*)(a.ws + WS_HP);
    const float* SMALL = (const float*)(a.ws + WS_SMALL);
    f.lr = *(const f32x4*)(SMALL + (size_t)(t0 + ((tid & 255) >> 2)) * 32 + 8 + (tid & 3) * 4);
    const int dvp = tid & 63, tg = tid >> 6;
#pragma unroll
    for (int j = 0; j < 8; ++j) f.v[j] = *(const unsigned*)(P + (size_t)(t0 + tg * 8 + j) * PW + 2560 + h * 128 + 2 * dvp);
    const int k = tid & 63, rg = tid >> 6;
#pragma unroll
    for (int i = 0; i < 8; ++i) { f.q[i] = P[(size_t)(t0 + rg * 8 + i) * PW + 2048 + h * 64 + k]; f.k[i] = P[(size_t)(t0 + rg * 8 + i) * PW + 2304 + h * 64 + k]; }
#pragma unroll
    for (int j = 0; j < 16; ++j) f.wg[j] = a.in[11][j * 256 + h * 64 + k];
    f.bg = a.in[12][h * 64 + k];
}
__device__ __forceinline__ void gla_prep_item(const Args& a, LAS unsigned char* lds_in, int item, int tid_in, const GlaPf& f) {
    const int tid = opaque_v(tid_in); LAS unsigned char* lds = opaque_v(lds_in);
    const int ci = item;
    const int lane = tid & 63, wid = tid >> 6;
    unsigned char* ws = a.ws;
    unsigned char* os = (unsigned char*)a.out;
    bf16* GQ = (bf16*)(os + OS_GQ) + (size_t)ci * 4096; bf16* GA = (bf16*)(os + OS_GA) + (size_t)ci * 4096; bf16* GK = (bf16*)(os + OS_GK) + (size_t)ci * 4096;
    bf16* GV = (bf16*)(os + OS_GV) + (size_t)ci * 8192; float* GE = (float*)(ws + WS_GE) + (size_t)ci * 64;
    LAS float* PS = (LAS float*)(lds + GK_PS); LAS float* LR = (LAS float*)(lds + GK_LR);
    if (tid < 256) *(LAS f32x4*)(LR + tid * 4) = f.lr;
    {
        const int dvp = tid & 63, tg = tid >> 6;
        u32x4 w0, w1;
#pragma unroll
        for (int m = 0; m < 4; ++m) { w0[m] = (f.v[2 * m] & 0xffffu) | (f.v[2 * m + 1] << 16); w1[m] = (f.v[2 * m] >> 16) | (f.v[2 * m + 1] & 0xffff0000u); }
        *(u32x4*)(GV + (2 * dvp) * 64 + tg * 8) = w0; *(u32x4*)(GV + (2 * dvp + 1) * 64 + tg * 8) = w1;
    }
    WG_BAR();
    const int k = tid & 63, rg = tid >> 6;
    float lg[8];
    {
        float run = 0.f;
#pragma unroll
        for (int i = 0; i < 8; ++i) {
            const int r = rg * 8 + i; float x = f.bg;
#pragma unroll
            for (int j = 0; j < 16; ++j) x += LR[r * 16 + j] * f.wg[j];
            const float ls = fminf(x, 0.f) - __logf(1.0f + __expf(-fabsf(x)));
            run += ls * (1.0f / 16.0f); lg[i] = run;
        }
        PS[rg * 64 + k] = run;
    }
    WG_BAR();
    {
        float off = 0.f, tot = 0.f;
#pragma unroll
        for (int g2 = 0; g2 < 8; ++g2) { const float v = PS[g2 * 64 + k]; if (g2 < rg) off += v; tot += v; }
        float kd[8];
#pragma unroll
        for (int i = 0; i < 8; ++i) {
            const int r = rg * 8 + i; const float bc = lg[i] + off;
            const float qraw = bf2f(f.q[i]), kraw = bf2f(f.k[i]);
            const float qt = qraw * 0.125f * __expf(bc), kt = kraw * __expf(-bc);
            kd[i] = kraw * __expf(tot - bc);
            const unsigned short qb = f2bf(qt);
            *(LAS unsigned short*)(lds + GK_QT + r * 144 + k * 2) = qb; *(LAS unsigned short*)(lds + GK_KT + r * 144 + k * 2) = f2bf(kt);
            GQ[r * 64 + kperm(k)] = qb;
        }
        u32x4 w; w.x = pk2(kd[0], kd[1]); w.y = pk2(kd[2], kd[3]); w.z = pk2(kd[4], kd[5]); w.w = pk2(kd[6], kd[7]);
        *(u32x4*)(GK + k * 64 + rg * 8) = w;
        if (rg == 0) GE[k] = __expf(tot);
    }
    WG_BAR();
    if (wid < 4) {
        const int rb = wid, r = lane & 15, q = lane >> 4;
        f32x4 acc[4];
#pragma unroll
        for (int cb = 0; cb < 4; ++cb) acc[cb] = (f32x4){0.f, 0.f, 0.f, 0.f};
#pragma unroll
        for (int s = 0; s < 2; ++s) {
            const bf16x8 av = *(const LAS bf16x8*)(lds + GK_QT + (16 * rb + r) * 144 + s * 64 + q * 16);
#pragma unroll
            for (int cb = 0; cb < 4; ++cb) { const bf16x8 bv = *(const LAS bf16x8*)(lds + GK_KT + (16 * cb + r) * 144 + s * 64 + q * 16); acc[cb] = MFMA16(av, bv, acc[cb]); }
        }
#pragma unroll
        for (int cb = 0; cb < 4; ++cb)
#pragma unroll
            for (int i = 0; i < 4; ++i) { const int ii = 16 * rb + 4 * q + i, jj = 16 * cb + r; GA[ii * 64 + jj] = f2bf(jj <= ii ? acc[cb][i] : 0.f); }
    }
    WG_BAR();
}

constexpr int SB_W = 0, SB_Q = 17408, SB_K = 34816, SB_QK = 53248, SB_BYTES = 62464;
constexpr int GB_Q = 0, GB_A = 9216, GB_K = 18432, GB_BYTES = 27648;

constexpr int NLOAD = 512 - 64 * NCWAVE;
constexpr int GDN_KP = (3584 + NLOAD - 1) / NLOAD;
constexpr int GLA_KP = (1536 + NLOAD - 1) / NLOAD;

__device__ __forceinline__ void gdn_scan(const Args& a, LAS unsigned char* lds_in, int bh, int part, int tid_in) {
    const int tid = opaque_v(tid_in); LAS unsigned char* lds = opaque_v(lds_in);
    const int lane = tid & 63, wid = tid >> 6, c = lane & 15, q = lane >> 4, h = bh & 3, b = bh >> 2;
    unsigned char* ws = a.ws; unsigned char* os = (unsigned char*)a.out;
    if (wid >= NCWAVE) {
        const int lt = tid - 64 * NCWAVE;
        const u32x4* src[GDN_KP]; int cst[GDN_KP]; int dst[GDN_KP]; bool ok[GDN_KP];
#pragma unroll
        for (int k = 0; k < GDN_KP; ++k) {
            const int p = lt + k * NLOAD; ok[k] = p < 3584; const int pc = ok[k] ? p : 0; const int arr = pc >> 10, pp = pc & 1023;
            const unsigned char* base = arr == 0 ? ws + WS_DW : arr == 1 ? ws + WS_DQ : arr == 2 ? ws + WS_DK : os + OS_DQK;
            cst[k] = arr < 3 ? 1024 : 512;
            src[k] = (const u32x4*)base + (size_t)bh * 128 * cst[k] + pp;
            dst[k] = arr < 2 ? (arr == 0 ? SB_W : SB_Q) + (pp >> 4) * 272 + (pp & 15) * 16 : (arr == 2 ? SB_K : SB_QK) + (pp >> 3) * 144 + (pp & 7) * 16;
        }
        u32x4 sa[GDN_KP], sb[GDN_KP];
#define L_LOAD(set, n) do { const int n_ = (n) < NCHK ? (n) : NCHK - 1; _Pragma("unroll") for (int k = 0; k < GDN_KP; ++k) set[k] = src[k][(size_t)n_ * cst[k]]; } while (0)
#define L_STORE(set, buf) do { LAS unsigned char* B_ = lds + (buf) * SB_BYTES; _Pragma("unroll") for (int k = 0; k < GDN_KP; ++k) if (ok[k]) *(LAS u32x4*)(B_ + dst[k]) = set[k]; } while (0)
        L_LOAD(sa, 0); L_STORE(sa, 0); L_LOAD(sa, 1); L_LOAD(sb, 2);
        WG_BAR();
        for (int n = 0; n < NCHK; n += 2) {
            L_STORE(sa, 1); L_LOAD(sa, n + 3); WG_BAR();
            L_STORE(sb, 0); L_LOAD(sb, n + 4); WG_BAR();
        }
#undef L_LOAD
#undef L_STORE
        return;
    }
    const bf16* DU = (const bf16*)(os + OS_DU) + (size_t)bh * 128 * 8192; const float* DGL = (const float*)(ws + WS_DGL) + bh * 128;
    bf16* MIX = (bf16*)(ws + WS_MIX);
    const int dv0 = part * CW + 16 * NSL * wid + c;
    f32x4 S[NSL][8]; bf16x8 Sb[NSL][4];
#pragma unroll
    for (int sl = 0; sl < NSL; ++sl) {
#pragma unroll
        for (int i = 0; i < 8; ++i) S[sl][i] = (f32x4){0.f, 0.f, 0.f, 0.f};
#pragma unroll
        for (int i = 0; i < 4; ++i) Sb[sl][i] = (bf16x8){0, 0, 0, 0, 0, 0, 0, 0};
    }
    u32x2 un[NSL][4];
#pragma unroll
    for (int sl = 0; sl < NSL; ++sl)
#pragma unroll
        for (int rb = 0; rb < 4; ++rb) un[sl][rb] = *(const u32x2*)(DU + (dv0 + 16 * sl) * 64 + 16 * rb + 4 * q);
    float gln = DGL[lane & 0];
    WG_BAR();
    for (int n = 0; n < NCHK; ++n) {
        const int nn = n + 1 < NCHK ? n + 1 : n;
        const LAS unsigned char* B = lds + (n & 1) * SB_BYTES;
        const float gl = gln; gln = DGL[nn + (lane & 0)];
        u32x2 uc[NSL][4];
#pragma unroll
        for (int sl = 0; sl < NSL; ++sl)
#pragma unroll
            for (int rb = 0; rb < 4; ++rb) { uc[sl][rb] = un[sl][rb]; un[sl][rb] = *(const u32x2*)(DU + (size_t)nn * 8192 + (dv0 + 16 * sl) * 64 + 16 * rb + 4 * q); }
        f32x4 aO[NSL][4], aW[NSL][4];
#pragma unroll
        for (int sl = 0; sl < NSL; ++sl)
#pragma unroll
            for (int rb = 0; rb < 4; ++rb) { aO[sl][rb] = (f32x4){0.f, 0.f, 0.f, 0.f}; aW[sl][rb] = (f32x4){0.f, 0.f, 0.f, 0.f}; }
#pragma unroll
        for (int s = 0; s < 4; ++s)
#pragma unroll
            for (int rb = 0; rb < 4; ++rb) {
                const bf16x8 wv = *(const LAS bf16x8*)(B + SB_W + (16 * rb + c) * 272 + s * 64 + q * 16);
#pragma unroll
                for (int sl = 0; sl < NSL; ++sl) aW[sl][rb] = MFMA16(wv, Sb[sl][s], aW[sl][rb]);
            }
#pragma unroll
        for (int s = 0; s < 4; ++s)
#pragma unroll
            for (int rb = 0; rb < 4; ++rb) {
                const bf16x8 qv = *(const LAS bf16x8*)(B + SB_Q + (16 * rb + c) * 272 + s * 64 + q * 16);
#pragma unroll
                for (int sl = 0; sl < NSL; ++sl) aO[sl][rb] = MFMA16(qv, Sb[sl][s], aO[sl][rb]);
            }
        bf16x8 Vb[NSL][2];
#pragma unroll
        for (int sl = 0; sl < NSL; ++sl) {
            f32x4 vn[4];
#pragma unroll
            for (int rb = 0; rb < 4; ++rb) vn[rb] = (f32x4){bflo(uc[sl][rb].x), bfhi(uc[sl][rb].x), bflo(uc[sl][rb].y), bfhi(uc[sl][rb].y)} - aW[sl][rb];
            Vb[sl][0] = pack8(vn[0], vn[1]); Vb[sl][1] = pack8(vn[2], vn[3]);
        }
#pragma unroll
        for (int rb = 0; rb < 8; ++rb) {
#pragma unroll
            for (int sl = 0; sl < NSL; ++sl) S[sl][rb] = S[sl][rb] * gl;
#pragma unroll
            for (int s = 0; s < 2; ++s) {
                const bf16x8 kv = *(const LAS bf16x8*)(B + SB_K + (16 * rb + c) * 144 + s * 64 + q * 16);
#pragma unroll
                for (int sl = 0; sl < NSL; ++sl) S[sl][rb] = MFMA16(kv, Vb[sl][s], S[sl][rb]);
            }
        }
#pragma unroll
        for (int s = 0; s < 2; ++s)
#pragma unroll
            for (int rb = 0; rb < 4; ++rb) {
                const bf16x8 kv = *(const LAS bf16x8*)(B + SB_QK + (16 * rb + c) * 144 + s * 64 + q * 16);
#pragma unroll
                for (int sl = 0; sl < NSL; ++sl) aO[sl][rb] = MFMA16(kv, Vb[sl][s], aO[sl][rb]);
            }
#pragma unroll
        for (int sl = 0; sl < NSL; ++sl) {
#pragma unroll
            for (int s = 0; s < 4; ++s) Sb[sl][s] = pack8(S[sl][2 * s], S[sl][2 * s + 1]);
            bf16* op = MIX + (size_t)(b * SEQ + n * 64 + 4 * q) * D + h * 128 + dv0 + 16 * sl;
#pragma unroll
            for (int rb = 0; rb < 4; ++rb)
#pragma unroll
                for (int i = 0; i < 4; ++i) op[(size_t)(16 * rb + i) * D] = f2bf(aO[sl][rb][i]);
        }
        WG_BAR();
    }
}

__device__ __forceinline__ void gla_scan(const Args& a, LAS unsigned char* lds_in, int bh, int part, int tid_in) {
    const int tid = opaque_v(tid_in); LAS unsigned char* lds = opaque_v(lds_in);
    const int lane = tid & 63, wid = tid >> 6, c = lane & 15, q = lane >> 4, h = bh & 3, b = bh >> 2;
    unsigned char* ws = a.ws; unsigned char* os = (unsigned char*)a.out;
    if (wid >= NCWAVE) {
        const int lt = tid - 64 * NCWAVE;
        const u32x4* src[GLA_KP]; int dst[GLA_KP]; bool ok[GLA_KP];
#pragma unroll
        for (int k = 0; k < GLA_KP; ++k) {
            const int p = lt + k * NLOAD; ok[k] = p < 1536; const int pc = ok[k] ? p : 0; const int arr = pc >> 9, pp = pc & 511;
            const unsigned char* base = arr == 0 ? os + OS_GQ : arr == 1 ? os + OS_GA : os + OS_GK;
            src[k] = (const u32x4*)base + (size_t)bh * 128 * 512 + pp;
            dst[k] = (arr == 0 ? GB_Q : arr == 1 ? GB_A : GB_K) + (pp >> 3) * 144 + (pp & 7) * 16;
        }
        u32x4 sa[GLA_KP], sb[GLA_KP];
#define L_LOAD(set, n) do { const int n_ = (n) < NCHK ? (n) : NCHK - 1; _Pragma("unroll") for (int k = 0; k < GLA_KP; ++k) set[k] = src[k][(size_t)n_ * 512]; } while (0)
#define L_STORE(set, buf) do { LAS unsigned char* B_ = lds + (buf) * GB_BYTES; _Pragma("unroll") for (int k = 0; k < GLA_KP; ++k) if (ok[k]) *(LAS u32x4*)(B_ + dst[k]) = set[k]; } while (0)
        L_LOAD(sa, 0); L_STORE(sa, 0); L_LOAD(sa, 1); L_LOAD(sb, 2);
        WG_BAR();
        for (int n = 0; n < NCHK; n += 2) {
            L_STORE(sa, 1); L_LOAD(sa, n + 3); WG_BAR();
            L_STORE(sb, 0); L_LOAD(sb, n + 4); WG_BAR();
        }
#undef L_LOAD
#undef L_STORE
        return;
    }
    const bf16* GV = (const bf16*)(os + OS_GV) + (size_t)bh * 128 * 8192; const float* GE = (const float*)(ws + WS_GE) + (size_t)bh * 128 * 64;
    bf16* MIX = (bf16*)(ws + WS_MIX);
    const int dv0 = part * CW + 16 * NSL * wid + c;
    f32x4 S[NSL][4]; bf16x8 Sb[NSL][2];
#pragma unroll
    for (int sl = 0; sl < NSL; ++sl) {
#pragma unroll
        for (int i = 0; i < 4; ++i) S[sl][i] = (f32x4){0.f, 0.f, 0.f, 0.f};
#pragma unroll
        for (int i = 0; i < 2; ++i) Sb[sl][i] = (bf16x8){0, 0, 0, 0, 0, 0, 0, 0};
    }
    bf16x8 vnx[NSL][2]; f32x4 enx[4];
#pragma unroll
    for (int sl = 0; sl < NSL; ++sl)
#pragma unroll
        for (int s = 0; s < 2; ++s) vnx[sl][s] = *(const bf16x8*)(GV + (dv0 + 16 * sl) * 64 + 32 * s + 8 * q);
#pragma unroll
    for (int rb = 0; rb < 4; ++rb) enx[rb] = *(const f32x4*)(GE + 16 * rb + 4 * q);
    WG_BAR();
    for (int n = 0; n < NCHK; ++n) {
        const int nn = n + 1 < NCHK ? n + 1 : n;
        const LAS unsigned char* B = lds + (n & 1) * GB_BYTES;
        bf16x8 Vb[NSL][2]; f32x4 eb[4];
#pragma unroll
        for (int sl = 0; sl < NSL; ++sl)
#pragma unroll
            for (int s = 0; s < 2; ++s) { Vb[sl][s] = vnx[sl][s]; vnx[sl][s] = *(const bf16x8*)(GV + (size_t)nn * 8192 + (dv0 + 16 * sl) * 64 + 32 * s + 8 * q); }
#pragma unroll
        for (int rb = 0; rb < 4; ++rb) { eb[rb] = enx[rb]; enx[rb] = *(const f32x4*)(GE + (size_t)nn * 64 + 16 * rb + 4 * q); }
        f32x4 aO[NSL][4];
#pragma unroll
        for (int sl = 0; sl < NSL; ++sl)
#pragma unroll
            for (int rb = 0; rb < 4; ++rb) aO[sl][rb] = (f32x4){0.f, 0.f, 0.f, 0.f};
#pragma unroll
        for (int s = 0; s < 2; ++s)
#pragma unroll
            for (int rb = 0; rb < 4; ++rb) {
                const bf16x8 qv = *(const LAS bf16x8*)(B + GB_Q + (16 * rb + c) * 144 + s * 64 + q * 16);
                const bf16x8 av = *(const LAS bf16x8*)(B + GB_A + (16 * rb + c) * 144 + s * 64 + q * 16);
#pragma unroll
                for (int sl = 0; sl < NSL; ++sl) { aO[sl][rb] = MFMA16(qv, Sb[sl][s], aO[sl][rb]); aO[sl][rb] = MFMA16(av, Vb[sl][s], aO[sl][rb]); }
            }
#pragma unroll
        for (int rb = 0; rb < 4; ++rb) {
#pragma unroll
            for (int sl = 0; sl < NSL; ++sl) S[sl][rb] = S[sl][rb] * eb[rb];
#pragma unroll
            for (int s = 0; s < 2; ++s) {
                const bf16x8 kv = *(const LAS bf16x8*)(B + GB_K + (16 * rb + c) * 144 + s * 64 + q * 16);
#pragma unroll
                for (int sl = 0; sl < NSL; ++sl) S[sl][rb] = MFMA16(kv, Vb[sl][s], S[sl][rb]);
            }
        }
#pragma unroll
        for (int sl = 0; sl < NSL; ++sl) {
#pragma unroll
            for (int s = 0; s < 2; ++s) Sb[sl][s] = pack8(S[sl][2 * s], S[sl][2 * s + 1]);
            bf16* op = MIX + (size_t)(b * SEQ + n * 64 + 4 * q) * D + 512 + h * 128 + dv0 + 16 * sl;
#pragma unroll
            for (int rb = 0; rb < 4; ++rb)
#pragma unroll
                for (int i = 0; i < 4; ++i) op[(size_t)(16 * rb + i) * D] = f2bf(aO[sl][rb][i]);
        }
        WG_BAR();
    }
}

__global__ void __launch_bounds__(512, 2) fwd_kernel(Args a) {
    extern __shared__ __attribute__((aligned(16))) unsigned char lds_raw[];
    LAS unsigned char* lds = (LAS unsigned char*)lds_raw;
    const int tid = threadIdx.x, lane = tid & 63, wave = __builtin_amdgcn_readfirstlane(tid >> 6);
    const int G = gridDim.x, bx = blockIdx.x;
    const int vcu = (G % 8 == 0) ? (bx % 8) * (G / 8) + bx / 8 : bx;
    const int gw = vcu * 8 + wave, NGW = G * 8;
    unsigned char* ws = a.ws;
    const int lo = a.ph_lo, hi = a.ph_hi;
    volatile LAS unsigned* bst = (volatile LAS unsigned*)(lds + LDS_BYTES - 64);
    if (tid < 2) bst[tid] = 0u;
    __syncthreads();
    XcdBarrier bar; bar.bar = (unsigned*)ws; bar.x = 0; bar.st = bst;
    if (a.coop == 1) bar = xcd_barrier_post((unsigned*)ws, bst);
#define IN(k) (lo <= (k) && (k) < hi)
#define REPEAT(k) _Pragma("unroll 1") for (int rep_ = 0; rep_ < ((k) == XREP_PHASE ? a.pad : 1); ++rep_)
#ifndef PROBE_MASK
#define PROBE_MASK 0
#define PROBE_DIV 10
#endif
    unsigned long long* TS = (unsigned long long*)(ws + 32768);
    if (PROBE_MASK && bx == 0 && tid == 0) { TS[0] = __builtin_amdgcn_s_memrealtime(); for (int k = 0; k < 16; ++k) TS[32 + k] = 0; }
#define STAMP(k) do { if (PROBE_MASK && bx == 0 && tid == 0) TS[(k) + 1] = __builtin_amdgcn_s_memrealtime(); } while (0)
#define SEAM(k) do { if (IN(k) && IN((k) + 1)) { if (a.coop == 1) xcd_barrier(bar); else if (a.coop == 2) cg::this_grid().sync(); } STAMP(k); } while (0)
    bf16* XB = (bf16*)(ws + WS_XB); bf16* HB = (bf16*)(ws + WS_HP); bf16* MIX = (bf16*)(ws + WS_MIX);
    float* SMALL = (float*)(ws + WS_SMALL);

    if (IN(0)) REPEAT(0) { prologue(a, lds, gw, NGW, wave, lane, 0); } SEAM(0);
    if (IN(1)) REPEAT(1) {
        pg8::Gemm g{XB, (const bf16*)(ws + WS_WGU1), M, NGU, D}; pg8::StaticOrder S; S.init(M, NGU, G, bx);
        pg8::EpiSwiglu E{HB, FF};
        pg8::gemm_phase<pg8::EpiSwiglu, pg8::StaticOrder, true, true>(lds, g, S, E);
    } SEAM(1);
    if (IN(2)) REPEAT(2) {
        pg8::Gemm g{HB, (const bf16*)(ws + WS_WD1), M, D, FF}; pg8::StaticOrder S; S.init(M, D, G, bx);
        pg8::EpiRes<false> E{a.in[0], (bf16*)a.out, ALPHA, 0.5f};
        pg8::gemm_phase<pg8::EpiRes<false>, pg8::StaticOrder, true, true>(lds, g, S, E);
    } SEAM(2);
    if (IN(3)) REPEAT(3) { ln_phase((const bf16*)a.out, nullptr, XB, a.in[4], a.in[5], gw, NGW, lane); } SEAM(3);
    if (IN(4)) REPEAT(4) {
        pg8::Gemm g{XB, (const bf16*)(ws + WS_WIN), M, NPROJ, D}; pg8::StaticOrder S; S.init(M, NPROJ, G, bx);
        pg8::EpiProj E{HB, SMALL};
        pg8::gemm_phase<pg8::EpiProj, pg8::StaticOrder, true, true>(lds, g, S, E);
    } SEAM(4);
    if (IN(5)) REPEAT(5) {
        {
            GdnPf pf; int it = bx; if (it < NCH) gdn_pf_load(pf, a, it, tid);
            ACC_T0();
#pragma unroll 1
            for (; it < NCH; it += G) { const GdnPf cur = pf; if (it + G < NCH) gdn_pf_load(pf, a, it + G, tid); gdn_prep_item(a, lds, it, tid, cur); }
            ACC_ADD(0);
        }
        {
            GlaPf pf; int it = bx; if (it < NCH) gla_pf_load(pf, a, it, tid);
            ACC_T0();
#pragma unroll 1
            for (; it < NCH; it += G) { const GlaPf cur = pf; if (it + G < NCH) gla_pf_load(pf, a, it + G, tid); gla_prep_item(a, lds, it, tid, cur); }
            ACC_ADD(1);
        }
    } SEAM(5);
    if (IN(6)) REPEAT(6) {
        const int xcd = bx & 7, slot = bx >> 3;
        if (slot < 4 * NPART) {
            const int sl = slot / NPART, part = slot % NPART, bh = xcd * 2 + (sl >> 1);
            if ((sl & 1) == 0) gdn_scan(a, lds, bh, part, tid); else gla_scan(a, lds, bh, part, tid);
        } else {
            const int nidle = G - 32 * NPART, idx = (slot - 4 * NPART) * 8 + xcd;
            prologue(a, lds, idx * 8 + wave, nidle * 8, wave, lane, 1);
        }
    } SEAM(6);
    if (IN(7)) { gnorm_phase(MIX, HB, a.in[10], a.in[13], gw, NGW, lane); } SEAM(7);
    if (IN(8)) REPEAT(8) {
        pg8::Gemm g{MIX, (const bf16*)(ws + WS_WOUT), M, D, D}; pg8::StaticOrder S; S.init(M, D, G, bx);
        pg8::EpiRes<true> E{XB, (bf16*)a.out, ALPHA, 1.0f};
        pg8::gemm_phase<pg8::EpiRes<true>, pg8::StaticOrder, true, true>(lds, g, S, E);
    } SEAM(8);
    if (IN(9)) { ln_phase((const bf16*)a.out, nullptr, XB, a.in[15], a.in[16], gw, NGW, lane); } SEAM(9);
    if (IN(10)) {
        pg8::Gemm g{XB, (const bf16*)(ws + WS_WGU2), M, NGU, D}; pg8::StaticOrder S; S.init(M, NGU, G, bx);
        pg8::EpiSwiglu E{HB, FF};
        pg8::gemm_phase<pg8::EpiSwiglu, pg8::StaticOrder, true, true>(lds, g, S, E);
    } SEAM(10);
    if (IN(11)) {
        pg8::Gemm g{HB, (const bf16*)(ws + WS_WD2), M, D, FF}; pg8::StaticOrder S; S.init(M, D, G, bx);
        pg8::EpiRes<true> E{XB, MIX, ALPHA, 0.5f};
        pg8::gemm_phase<pg8::EpiRes<true>, pg8::StaticOrder, true, true>(lds, g, S, E);
    } SEAM(11);
    if (IN(12)) { ln_phase(MIX, a.out, nullptr, a.in[20], a.in[21], gw, NGW, lane); }
    if (a.coop == 1) for (int i_ = 0; i_ < XREP_SYNC; ++i_) xcd_barrier(bar);
    if (PROBE_MASK && bx == 0) {
        asm volatile("s_waitcnt vmcnt(0)" ::: "memory"); __syncthreads();
        if (tid == 0) TS[13] = __builtin_amdgcn_s_memrealtime();
        __syncthreads();
        unsigned long long tot = 0;
        for (int k = 0; k < 13; ++k) if ((PROBE_MASK >> k) & 1) tot += __hip_atomic_load(&TS[k + 1], __ATOMIC_RELAXED, __HIP_MEMORY_SCOPE_AGENT) - __hip_atomic_load(&TS[k], __ATOMIC_RELAXED, __HIP_MEMORY_SCOPE_AGENT);
        for (int k = 0; k < 16; ++k) if ((PROBE_MASK >> (13 + k)) & 1) tot += __hip_atomic_load(&TS[32 + k], __ATOMIC_RELAXED, __HIP_MEMORY_SCOPE_AGENT);
        int T = (int)(tot / PROBE_DIV); if (T > 8192) T = 8192;
        for (int i = tid; i < T; i += 512) a.out[i] += 0.1f;
    }
#undef IN
#undef SEAM
}

constexpr int NPHASE = 13;
#ifndef MK_MULTI
#define MK_MULTI 0
#endif
extern "C" void kernel_launch(void* const* d_in, const int* in_sizes, int n_in, void* d_out, int out_size, void* d_ws, size_t ws_size, hipStream_t stream) {
    static int grid = 0;
    if (grid == 0) {
        if (n_in != 22 || out_size != M * D || ws_size < WS_END) { fprintf(stderr, "kernel_launch: unexpected shapes (n_in %d out %d ws %zu)\n", n_in, out_size, ws_size); grid = -1; return; }
        int dev = 0, cus = 0, per_cu = 0;
        hipGetDevice(&dev); hipDeviceGetAttribute(&cus, hipDeviceAttributeMultiprocessorCount, dev);
        if (hipFuncSetAttribute((const void*)fwd_kernel, hipFuncAttributeMaxDynamicSharedMemorySize, LDS_BYTES) != hipSuccess) { fprintf(stderr, "kernel_launch: hipFuncSetAttribute failed\n"); grid = -1; return; }
        hipOccupancyMaxActiveBlocksPerMultiprocessor(&per_cu, (const void*)fwd_kernel, 512, LDS_BYTES);
        (void)hipGetLastError();
        if (per_cu < 1) per_cu = 1;
        grid = cus * 1;
        fprintf(stderr, "kernel_launch: cus %d per_cu %d grid %d\n", cus, per_cu, grid);
    }
    if (grid < 0) return;
    Args a{};
    for (int i = 0; i < 22; ++i) a.in[i] = (const float*)d_in[i];
    a.out = (float*)d_out; a.ws = (unsigned char*)d_ws; a.pad = XREP_N;
#if MK_MULTI
    for (int p = 0; p < NPHASE; ++p) { a.ph_lo = p; a.ph_hi = p + 1; a.coop = 0; hipLaunchKernelGGL(fwd_kernel, dim3(grid), dim3(512), LDS_BYTES, stream, a); }
#else
    if (hipMemsetAsync(d_ws, 0, 65536, stream) != hipSuccess) { fprintf(stderr, "kernel_launch: memset failed\n"); return; }
    a.ph_lo = 0; a.ph_hi = NPHASE; a.coop = 1;
    void* args[] = {&a};
    hipError_t e = hipLaunchCooperativeKernel((const void*)fwd_kernel, dim3(grid), dim3(512), args, LDS_BYTES, stream);
    if (e != hipSuccess) fprintf(stderr, "cooperative launch failed: %s (grid %d)\n", hipGetErrorString(e), grid);
#endif
}
```

```cpp
#include <hip/hip_runtime.h>
#include <hip/hip_cooperative_groups.h>
#include <cstdio>
#include <cstdint>
namespace cg = cooperative_groups;
#define LAS __attribute__((address_space(3)))
namespace pg8 {
#define PG8_LAS __attribute__((address_space(3)))
typedef unsigned short bf16_t;
typedef short bf16x8 __attribute__((ext_vector_type(8)));
typedef float f32x4 __attribute__((ext_vector_type(4)));
typedef unsigned u32x4 __attribute__((ext_vector_type(4)));
constexpr int BM = 256, BK = 64, HALF = 128, HTB = HALF * BK * 2  , STAGE_BYTES = 8 * HTB, NXCD = 8, WGM = 8;

__host__ __device__ __forceinline__ int lds_byte(int r, int c) { const int st = (r >> 4) * 2 + (c >> 5), rr = r & 15, cc = c & 31, ob = rr * 64 + cc * 2; return st * 1024 + (ob ^ (((ob >> 9) & 1) << 5)); }
__host__ __device__ __forceinline__ void stage_rc(int b, int& R, int& C) { const int st = b / 1024, sb = b % 1024, swz = sb ^ (((sb >> 9) & 1) << 5); R = (st >> 1) * 16 + swz / 64; C = (st & 1) * 32 + (swz % 64) / 2; }
__host__ __device__ __forceinline__ int perm32(int rho) { const int n = rho >> 4, i = rho & 15; return 8 * (i >> 2) + 4 * n + (i & 3); }

struct Unit { int pm, pn; };
struct Gemm { const bf16_t* A; const bf16_t* Bt; int M, N, K; };

struct StaticOrder {
    int nM, nN, nwg, G, c;
    __host__ __device__ void init(int M, int N, int G_, int c_) { nM = M / BM; nN = N / BM; nwg = nM * nN; G = G_; c = c_; }
    __host__ __device__ bool next(int i, Unit& u) const {
        const long L = (long)i * G + c; if (L >= nwg) return false;
        int wgid = (int)L; { const int q = nwg / NXCD, r = nwg % NXCD, xcd = wgid % NXCD, off = wgid / NXCD; wgid = (xcd < r ? xcd * (q + 1) : r * (q + 1) + (xcd - r) * q) + off; }
        const int nig = WGM * nN, gid = wgid / nig, fm = gid * WGM, gsz = (nM - fm) < WGM ? (nM - fm) : WGM;
        u.pm = fm + ((wgid % nig) % gsz); u.pn = (wgid % nig) / gsz; return true;
    }
    __device__ __forceinline__ void a_ready(const Unit&) const {}
    __device__ __forceinline__ void done(const Unit&) const {}
};

__device__ __forceinline__ unsigned cvt_pk_bf16(float lo, float hi) { unsigned r; asm volatile("v_cvt_pk_bf16_f32 %0, %1, %2" : "=v"(r) : "v"(lo), "v"(hi)); return r; }
typedef float f32x2 __attribute__((ext_vector_type(2)));
template <class Epi, class Sched, bool ALIGN_EPI = false, bool SP2 = false>
__device__ __forceinline__ void gemm_phase(PG8_LAS unsigned char* lds, const Gemm g, const Sched& S, const Epi& E) {
    const int tid = threadIdx.x, wid = __builtin_amdgcn_readfirstlane(tid >> 6), lane = tid & 63, wr = wid >> 2, wc = wid & 3, fr = lane & 15, fq = lane >> 4;
    const int K = g.K, nt = K / BK;
    unsigned voffA[2], voffB[2];
#pragma unroll
    for (int i = 0; i < 2; ++i) { int R, C; stage_rc(tid * 16 + i * 8192, R, C); const int Rb = Epi::PERM ? ((R & ~31) + perm32(R & 31)) : R;
        voffA[i] = (unsigned)(R * K + C) * 2u; voffB[i] = (unsigned)(Rb * K + C) * 2u; }
    const size_t kstep = (size_t)(BK * 2);
    const size_t hstep = (size_t)HALF * K * 2;
    const size_t tstep = 2 * hstep;
    const unsigned ldsw = (unsigned)wid * 1024u;
    const int aoff = lds_byte(wr * 64 + fr, fq * 8), boff = lds_byte(wc * 32 + fr, fq * 8);
#define PG8_SA(b, h) (((b) * 2 + (h)) * HTB)
#define PG8_SB(b, h) ((4 + (b) * 2 + (h)) * HTB)
#define PG8_STAGE(bufoff, gbase, voff) do { _Pragma("unroll") for (int _i = 0; _i < 2; ++_i) \
        __builtin_amdgcn_global_load_lds((const unsigned*)((const char*)(gbase) + (voff)[_i]), (PG8_LAS unsigned*)(lds + (bufoff) + ldsw + _i * 8192), 16, 0, 0); } while (0)
#define PG8_LDA(dst, b, h) do { _Pragma("unroll") for (int m = 0; m < 4; ++m) _Pragma("unroll") for (int k = 0; k < 2; ++k) dst[m][k] = *(const PG8_LAS bf16x8*)(lds + PG8_SA(b, h) + aoff + m * 2048 + k * 1024); } while (0)
#define PG8_LDB(dst, b, h) do { _Pragma("unroll") for (int n = 0; n < 2; ++n) _Pragma("unroll") for (int k = 0; k < 2; ++k) dst[n][k] = *(const PG8_LAS bf16x8*)(lds + PG8_SB(b, h) + boff + n * 2048 + k * 1024); } while (0)
#define PG8_MMA(ai, bj, At, Bt) do { __builtin_amdgcn_s_setprio(1); _Pragma("unroll") for (int m = 0; m < 4; ++m) _Pragma("unroll") for (int n = 0; n < 2; ++n) _Pragma("unroll") for (int k = 0; k < 2; ++k) \
        acc[ai][bj][m][n] = __builtin_amdgcn_mfma_f32_16x16x32_bf16(Bt[n][k], At[m][k], acc[ai][bj][m][n], 0, 0, 0); __builtin_amdgcn_s_setprio(0); } while (0)
#define PG8_WAIT_V(n) asm volatile("s_waitcnt vmcnt(" #n ")" ::: "memory")
#define PG8_WAIT_L(n) asm volatile("s_waitcnt lgkmcnt(" #n ")" ::: "memory")
#define PG8_BAR __builtin_amdgcn_s_barrier()
#define PG8_SCHED __builtin_amdgcn_sched_barrier(0)
    Unit cur, nxt; int ui = 0;
    if (!S.next(0, cur)) return;
    f32x4 acc[2][2][4][2];
#pragma unroll
    for (int a = 0; a < 2; ++a)
#pragma unroll
        for (int b = 0; b < 2; ++b)
#pragma unroll
            for (int m = 0; m < 4; ++m)
#pragma unroll
                for (int n = 0; n < 2; ++n) acc[a][b][m][n] = (f32x4){0.f, 0.f, 0.f, 0.f};
    bf16x8 At[4][2], B0[2][2], B1[2][2];
    const char* cA = (const char*)g.A + (size_t)cur.pm * tstep; const char* cB = (const char*)g.Bt + (size_t)cur.pn * tstep;
    S.a_ready(cur);
    if constexpr (SP2) {
        PG8_STAGE(PG8_SB(0, 0), cB, voffB); PG8_STAGE(PG8_SB(0, 1), cB + hstep, voffB); PG8_STAGE(PG8_SA(0, 0), cA, voffA); PG8_STAGE(PG8_SA(0, 1), cA + hstep, voffA);
        if (wr == 1) PG8_BAR;
        PG8_WAIT_V(2); PG8_BAR;
        PG8_STAGE(PG8_SB(1, 0), cB + kstep, voffB); PG8_STAGE(PG8_SA(1, 0), cA + kstep, voffA); PG8_STAGE(PG8_SB(1, 1), cB + hstep + kstep, voffB);
        PG8_WAIT_V(6); PG8_BAR;
    } else {
        PG8_STAGE(PG8_SB(0, 0), cB, voffB); PG8_STAGE(PG8_SA(0, 0), cA, voffA); PG8_STAGE(PG8_SB(0, 1), cB + hstep, voffB); PG8_STAGE(PG8_SA(0, 1), cA + hstep, voffA);
        if (wr == 1) PG8_BAR;
        PG8_WAIT_V(4); PG8_BAR;
        PG8_STAGE(PG8_SB(1, 0), cB + kstep, voffB); PG8_STAGE(PG8_SA(1, 0), cA + kstep, voffA); PG8_STAGE(PG8_SB(1, 1), cB + hstep + kstep, voffB);
        PG8_WAIT_V(6); PG8_BAR;
    }
    for (;;) {
        const bool has_next = S.next(ui + 1, nxt);
        const char* nA = has_next ? (const char*)g.A + (size_t)nxt.pm * tstep : cA; const char* nB = has_next ? (const char*)g.Bt + (size_t)nxt.pn * tstep : cB;
        for (int t = 0; t < nt; t += 2) {
            const bool last = (t == nt - 2);
            const char* a1 = cA + (size_t)(t + 1) * kstep;
            const char* a2 = last ? nA : cA + (size_t)(t + 2) * kstep; const char* b2 = last ? nB : cB + (size_t)(t + 2) * kstep;
            const char* a3 = a2 + kstep; const char* b3 = b2 + kstep;
            if (last && has_next) S.a_ready(nxt);
            if constexpr (SP2) {
            PG8_LDB(B0, 0, 0); PG8_LDB(B1, 0, 1); PG8_SCHED; PG8_LDA(At, 0, 0); PG8_STAGE(PG8_SA(1, 1), a1 + hstep, voffA);
            PG8_WAIT_V(8); PG8_WAIT_L(0); PG8_BAR; PG8_MMA(0, 0, At, B0); PG8_MMA(0, 1, At, B1); PG8_BAR; PG8_SCHED;
            PG8_LDA(At, 0, 1); PG8_STAGE(PG8_SB(0, 0), b2, voffB); PG8_STAGE(PG8_SB(0, 1), b2 + hstep, voffB); PG8_STAGE(PG8_SA(0, 0), a2, voffA);
            PG8_WAIT_V(8); PG8_WAIT_L(0); PG8_BAR; PG8_MMA(1, 0, At, B0); PG8_MMA(1, 1, At, B1); PG8_BAR; PG8_SCHED;
            PG8_LDB(B0, 1, 0); PG8_LDB(B1, 1, 1); PG8_SCHED; PG8_LDA(At, 1, 0); PG8_STAGE(PG8_SA(0, 1), a2 + hstep, voffA);
            PG8_WAIT_V(8); PG8_WAIT_L(0); PG8_BAR; PG8_MMA(0, 0, At, B0); PG8_MMA(0, 1, At, B1); PG8_BAR; PG8_SCHED;
            PG8_LDA(At, 1, 1); PG8_STAGE(PG8_SB(1, 0), b3, voffB); PG8_STAGE(PG8_SB(1, 1), b3 + hstep, voffB); PG8_STAGE(PG8_SA(1, 0), a3, voffA);
            PG8_WAIT_V(8); PG8_WAIT_L(0); PG8_BAR; PG8_MMA(1, 0, At, B0); PG8_MMA(1, 1, At, B1); PG8_BAR; PG8_SCHED;
            } else {
            PG8_LDB(B0, 0, 0); PG8_SCHED; PG8_LDA(At, 0, 0); PG8_STAGE(PG8_SA(1, 1), a1 + hstep, voffA);
            PG8_WAIT_L(8); PG8_BAR; PG8_WAIT_L(0); PG8_MMA(0, 0, At, B0); PG8_BAR; PG8_SCHED;
            PG8_LDB(B1, 0, 1); PG8_STAGE(PG8_SB(0, 0), b2, voffB);
            PG8_BAR; PG8_WAIT_L(0); PG8_MMA(0, 1, At, B1); PG8_BAR;
            PG8_LDA(At, 0, 1); PG8_STAGE(PG8_SA(0, 0), a2, voffA);
            PG8_BAR; PG8_WAIT_L(0); PG8_MMA(1, 0, At, B0); PG8_BAR; PG8_SCHED;
            PG8_STAGE(PG8_SB(0, 1), b2 + hstep, voffB);
            PG8_WAIT_V(6); PG8_BAR; PG8_MMA(1, 1, At, B1); PG8_BAR;
            PG8_LDB(B0, 1, 0); PG8_SCHED; PG8_LDA(At, 1, 0); PG8_STAGE(PG8_SA(0, 1), a2 + hstep, voffA);
            PG8_WAIT_L(8); PG8_BAR; PG8_WAIT_L(0); PG8_MMA(0, 0, At, B0); PG8_BAR; PG8_SCHED;
            PG8_LDB(B1, 1, 1); PG8_STAGE(PG8_SB(1, 0), b3, voffB);
            PG8_BAR; PG8_WAIT_L(0); PG8_MMA(0, 1, At, B1); PG8_BAR;
            PG8_LDA(At, 1, 1); PG8_STAGE(PG8_SA(1, 0), a3, voffA);
            PG8_BAR; PG8_WAIT_L(0); PG8_MMA(1, 0, At, B0); PG8_BAR; PG8_SCHED;
            PG8_STAGE(PG8_SB(1, 1), b3 + hstep, voffB);
            PG8_WAIT_V(6); PG8_BAR; PG8_MMA(1, 1, At, B1); PG8_BAR;
            }
        }
        if constexpr (ALIGN_EPI) { if (wr == 0) PG8_BAR; }
        if constexpr (!Epi::AFTER_DRAIN) { E(acc, cur, wr, wc, fr, fq); S.done(cur); }
        if (!has_next) break;
#pragma unroll
        for (int a = 0; a < 2; ++a)
#pragma unroll
            for (int b = 0; b < 2; ++b)
#pragma unroll
                for (int m = 0; m < 4; ++m)
#pragma unroll
                    for (int n = 0; n < 2; ++n) acc[a][b][m][n] = (f32x4){0.f, 0.f, 0.f, 0.f};
        cur = nxt; cA = nA; cB = nB; ++ui;
        if constexpr (ALIGN_EPI) { if (wr == 1) PG8_BAR; }
    }
    PG8_WAIT_V(0);
    if constexpr (!ALIGN_EPI) { if (wr == 0) PG8_BAR; }
    PG8_BAR;
    if constexpr (Epi::AFTER_DRAIN) { E.fused(acc, cur, wr, wc, fr, fq, lds, wid, lane); S.done(cur); }
#undef PG8_SA
#undef PG8_SB
#undef PG8_STAGE
#undef PG8_LDA
#undef PG8_LDB
#undef PG8_MMA
#undef PG8_WAIT_V
#undef PG8_WAIT_L
#undef PG8_BAR
#undef PG8_SCHED
}
}

namespace pg8 {
__device__ __forceinline__ float silu_f(float x) { return x * __builtin_amdgcn_rcpf(1.0f + __expf(-x)); }
__device__ __forceinline__ float bflo_f(unsigned u) { return __uint_as_float(u << 16); }
__device__ __forceinline__ float bfhi_f(unsigned u) { return __uint_as_float(u & 0xffff0000u); }

struct EpiSwiglu {
    static constexpr bool PERM = true, AFTER_DRAIN = false;
    bf16_t* O; int ldc;
    __device__ __forceinline__ void operator()(const f32x4 (&acc)[2][2][4][2], const Unit& u, int wr, int wc, int fr, int fq) const {
        const int row0 = u.pm * BM + wr * 64 + fr, col0 = u.pn * HALF + wc * 32 + 8 * fq;
#pragma unroll
        for (int ai = 0; ai < 2; ++ai)
#pragma unroll
            for (int m = 0; m < 4; ++m) {
                bf16_t* rowp = O + (size_t)(row0 + ai * HALF + m * 16) * ldc + col0;
                const f32x4 g0 = acc[ai][0][m][0], g1 = acc[ai][0][m][1], u0 = acc[ai][1][m][0], u1 = acc[ai][1][m][1];
                u32x4 w;
                w.x = cvt_pk_bf16(silu_f(g0[0]) * u0[0], silu_f(g0[1]) * u0[1]);
                w.y = cvt_pk_bf16(silu_f(g0[2]) * u0[2], silu_f(g0[3]) * u0[3]);
                w.z = cvt_pk_bf16(silu_f(g1[0]) * u1[0], silu_f(g1[1]) * u1[1]);
                w.w = cvt_pk_bf16(silu_f(g1[2]) * u1[2], silu_f(g1[3]) * u1[3]);
                *(u32x4*)rowp = w;
            }
    }
};

template <bool RES_BF16> struct EpiRes {
    static constexpr bool PERM = true, AFTER_DRAIN = false;
    const void* res; bf16_t* out; float alpha, scale;
    __device__ __forceinline__ void operator()(const f32x4 (&acc)[2][2][4][2], const Unit& u, int wr, int wc, int fr, int fq) const {
#pragma unroll
        for (int ai = 0; ai < 2; ++ai)
#pragma unroll
            for (int m = 0; m < 4; ++m) {
                const int row = u.pm * BM + wr * 64 + fr + ai * HALF + m * 16;
#pragma unroll
                for (int bj = 0; bj < 2; ++bj) {
                    const int col = u.pn * BM + bj * HALF + wc * 32 + 8 * fq; const size_t off = (size_t)row * 1024 + col;
                    f32x4 r0, r1;
                    if (RES_BF16) { const u32x4 rw = *(const u32x4*)((const bf16_t*)res + off);
                        r0 = (f32x4){bflo_f(rw.x), bfhi_f(rw.x), bflo_f(rw.y), bfhi_f(rw.y)}; r1 = (f32x4){bflo_f(rw.z), bfhi_f(rw.z), bflo_f(rw.w), bfhi_f(rw.w)}; }
                    else { r0 = *(const f32x4*)((const float*)res + off); r1 = *(const f32x4*)((const float*)res + off + 4); }
                    const f32x4 o0 = r0 * alpha + acc[ai][bj][m][0] * scale, o1 = r1 * alpha + acc[ai][bj][m][1] * scale;
                    u32x4 w; w.x = cvt_pk_bf16(o0[0], o0[1]); w.y = cvt_pk_bf16(o0[2], o0[3]); w.z = cvt_pk_bf16(o1[0], o1[1]); w.w = cvt_pk_bf16(o1[2], o1[3]);
                    *(u32x4*)(out + off) = w;
                }
            }
    }
};

struct EpiProj {
    static constexpr bool PERM = true, AFTER_DRAIN = false;
    bf16_t* P; float* SM;
    __device__ __forceinline__ void operator()(const f32x4 (&acc)[2][2][4][2], const Unit& u, int wr, int wc, int fr, int fq) const {
        const int row0 = u.pm * BM + wr * 64 + fr;
        if (u.pn < 14) {
            const int col0 = u.pn * BM + wc * 32 + 8 * fq;
#pragma unroll
            for (int ai = 0; ai < 2; ++ai)
#pragma unroll
                for (int m = 0; m < 4; ++m) { bf16_t* rowp = P + (size_t)(row0 + ai * HALF + m * 16) * 3584 + col0;
#pragma unroll
                    for (int bj = 0; bj < 2; ++bj) { const f32x4 v0 = acc[ai][bj][m][0], v1 = acc[ai][bj][m][1];
                        u32x4 w; w.x = cvt_pk_bf16(v0[0], v0[1]); w.y = cvt_pk_bf16(v0[2], v0[3]); w.z = cvt_pk_bf16(v1[0], v1[1]); w.w = cvt_pk_bf16(v1[2], v1[3]);
                        *(u32x4*)(rowp + bj * HALF) = w; } }
        } else if (wc == 0) {
#pragma unroll
            for (int ai = 0; ai < 2; ++ai)
#pragma unroll
                for (int m = 0; m < 4; ++m) { float* rowp = SM + (size_t)(row0 + ai * HALF + m * 16) * 32 + 8 * fq;
                    *(f32x4*)rowp = acc[ai][0][m][0]; *(f32x4*)(rowp + 4) = acc[ai][0][m][1]; }
        }
    }
};
}
#define XB_TMO      128
#define XB_XCNT(j)  (256  + 64 * (j))
#define XB_XSUB(j)  (1280 + 64 * (j))
#define XB_XGEN(j)  (2304 + 64 * (j))
#define XB_TOP      3328
#define XB_TOPGEN   3392
#define XCD_BAR_WORDS 3456
#define XB_SPIN_CAP (1u << 18)

__device__ __forceinline__ unsigned xb_ld(unsigned* p)              { return __hip_atomic_load(p, __ATOMIC_RELAXED, __HIP_MEMORY_SCOPE_AGENT); }
__device__ __forceinline__ unsigned xb_add(unsigned* p, unsigned v) { return __hip_atomic_fetch_add(p, v, __ATOMIC_RELAXED, __HIP_MEMORY_SCOPE_AGENT); }
__device__ __forceinline__ unsigned xb_xcc_id() { return (unsigned)__builtin_amdgcn_s_getreg((3 << 11) | 20) & 0xFu; }
#define XB_SPIN(cond, bar) do { unsigned _sp = 0; while (cond) { __builtin_amdgcn_s_sleep(1); \
    if ((++_sp & 255u) == 0u) { if (xb_ld(&(bar)[XB_TMO])) break; if (_sp > XB_SPIN_CAP) { atomicAdd(&(bar)[XB_TMO], 1u); break; } } } } while (0)

struct XcdBarrier {
    unsigned* bar; unsigned x;
    volatile LAS unsigned* st;
};

__device__ __forceinline__ XcdBarrier xcd_barrier_post(unsigned* bar, volatile LAS unsigned* st) {
    XcdBarrier b; b.bar = bar; b.x = xb_xcc_id(); b.st = st;
    if (threadIdx.x == 0) (void)xb_add(&bar[XB_XCNT(b.x)], 1u);
    return b;
}
__device__ __forceinline__ void xcd_barrier_complete(unsigned* bar, unsigned x, unsigned& nloc, unsigned& nx) {
    const unsigned G = gridDim.x * gridDim.y * gridDim.z;
    unsigned sum, cnt, mine, sp = 0u;
    for (;;) {
        sum = 0u; cnt = 0u; mine = 0u;
#pragma unroll
        for (unsigned j = 0; j < 16; ++j) { const unsigned c = xb_ld(&bar[XB_XCNT(j)]); sum += c; cnt += (c > 0u) ? 1u : 0u; mine = (j == x) ? c : mine; }
        if (sum == G) break;
        __builtin_amdgcn_s_sleep(1);
        if ((++sp & 255u) == 0u) { if (xb_ld(&bar[XB_TMO])) break; if (sp > XB_SPIN_CAP) { atomicAdd(&bar[XB_TMO], 1u); break; } }
    }
    nloc = mine > 0u ? mine : 1u; nx = cnt > 0u ? cnt : 1u;
}

__device__ __forceinline__ void xcd_barrier(const XcdBarrier& b) {
    asm volatile("s_waitcnt vmcnt(0)" ::: "memory");
    __syncthreads();
    if (threadIdx.x == 0) {
        unsigned* bar = b.bar;
        __builtin_amdgcn_s_waitcnt(0);
        unsigned nloc = b.st[0], nx = b.st[1];
        if (nloc == 0u) { xcd_barrier_complete(bar, b.x, nloc, nx); b.st[0] = nloc; b.st[1] = nx; }
        const unsigned old = xb_add(&bar[XB_XSUB(b.x)], 1u);
        const unsigned gen = old / nloc;
        if (old + 1u == (gen + 1u) * nloc) {
            __builtin_amdgcn_fence(__ATOMIC_RELEASE, "agent");
            asm volatile("s_waitcnt vmcnt(0)" ::: "memory");
            const unsigned og = xb_add(&bar[XB_TOP], 1u);
            const unsigned tg = og / nx;
            if (og + 1u == (tg + 1u) * nx) xb_add(&bar[XB_TOPGEN], 1u);
            else XB_SPIN(xb_ld(&bar[XB_TOPGEN]) == tg, bar);
            __builtin_amdgcn_fence(__ATOMIC_ACQUIRE, "agent");
            xb_add(&bar[XB_XGEN(b.x)], 1u);
            asm volatile("s_waitcnt vmcnt(0)" ::: "memory");
        } else {
            XB_SPIN(xb_ld(&bar[XB_XGEN(b.x)]) == gen, bar);
            __builtin_amdgcn_fence(__ATOMIC_ACQUIRE, "agent");
            asm volatile("s_waitcnt vmcnt(0)" ::: "memory");
        }
    }
    __syncthreads();
}

typedef unsigned short bf16;
typedef unsigned u32x4 __attribute__((ext_vector_type(4)));
typedef unsigned u32x2 __attribute__((ext_vector_type(2)));
typedef float f32x4 __attribute__((ext_vector_type(4)));
typedef short bf16x8 __attribute__((ext_vector_type(8)));
typedef float f32x2_t __attribute__((ext_vector_type(2)));
typedef __bf16 bf16x2_t __attribute__((ext_vector_type(2)));

constexpr int M = 32768, D = 1024, FF = 2816, NGU = 2 * FF, NPROJ = 3840, PW = 3584, SEQ = 8192, NCHK = 128, NCH = 2048;
constexpr int WIN_N = 3608;
constexpr float ALPHA = 1.189207115002721f;
constexpr float LN_EPS = 1e-5f, RMS_EPS = 1e-6f;
constexpr size_t MiB = 1u << 20;
constexpr size_t WS_WGU1 = 1 * MiB, WS_WD1 = 12 * MiB, WS_WIN = 18 * MiB, WS_WOUT = 26 * MiB, WS_WGU2 = 28 * MiB, WS_WD2 = 39 * MiB, WS_SMALL = 45 * MiB;
constexpr size_t WS_HP = 49 * MiB;
constexpr size_t WS_XB = 273 * MiB;
constexpr size_t WS_MIX = 337 * MiB;
constexpr size_t WS_DW = 401 * MiB, WS_DQ = 433 * MiB, WS_DK = 465 * MiB, WS_GE = 497 * MiB, WS_DGL = 498 * MiB, WS_END = 512 * MiB;
constexpr size_t OS_DU = 0, OS_GQ = 32 * MiB, OS_GA = 48 * MiB, OS_GK = 64 * MiB, OS_GV = 80 * MiB, OS_DQK = 112 * MiB;
constexpr int LDS_BYTES = 147456;
constexpr int NP_GDN = 8, NP_GLA = 4, NSL = 1;

__device__ __forceinline__ unsigned pk2(float lo, float hi) { f32x2_t v = {lo, hi}; bf16x2_t b = __builtin_convertvector(v, bf16x2_t); return __builtin_bit_cast(unsigned, b); }
__device__ __forceinline__ unsigned short f2bf(float f) { return (unsigned short)(pk2(f, 0.f) & 0xffffu); }
__device__ __forceinline__ float bf2f(unsigned short h) { return __uint_as_float((unsigned)h << 16); }
__device__ __forceinline__ float bflo(unsigned u) { return __uint_as_float(u << 16); }
__device__ __forceinline__ float bfhi(unsigned u) { return __uint_as_float(u & 0xffff0000u); }
__device__ __forceinline__ float silu(float x) { return x * __builtin_amdgcn_rcpf(1.0f + __expf(-x)); }
__device__ __forceinline__ int kperm(int a) { return (a & ~31) | (((a >> 2) & 3) << 3) | (((a >> 4) & 1) << 2) | (a & 3); }
__device__ __forceinline__ float wave_sum(float v) {
#pragma unroll
    for (int o = 1; o < 64; o <<= 1) v += __shfl_xor(v, o);
    return v;
}
template <class T> __device__ __forceinline__ T opaque_v(T p) { asm volatile("" : "+v"(p)); return p; }
#define WG_BAR() do { asm volatile("s_waitcnt lgkmcnt(0)" ::: "memory"); __builtin_amdgcn_s_barrier(); asm volatile("" ::: "memory"); } while (0)
#define MFMA16(a, b, c) __builtin_amdgcn_mfma_f32_16x16x32_bf16((a), (b), (c), 0, 0, 0)
__device__ __forceinline__ bf16x8 pack8(const f32x4& lo, const f32x4& hi) {
    u32x4 p; p.x = pk2(lo[0], lo[1]); p.y = pk2(lo[2], lo[3]); p.z = pk2(hi[0], hi[1]); p.w = pk2(hi[2], hi[3]); return __builtin_bit_cast(bf16x8, p);
}

#ifndef XREP_PHASE
#define XREP_PHASE -1
#define XREP_N 1
#define XREP_SYNC 0
#endif
struct Args { const float* in[22]; float* out; unsigned char* ws; int ph_lo, ph_hi, coop, pad; };

struct ColGU { const float* g; const float* u; __device__ __forceinline__ const float* operator()(int d) const { const int t = d >> 8, w = d & 255;
    const uintptr_t gp = (uintptr_t)g, up = (uintptr_t)u; const uintptr_t base = gp + (uintptr_t)((w >> 7) & 1) * (up - gp); return (const float*)base + t * 128 + (w & 127); } };
struct ColPlain { const float* w; __device__ __forceinline__ const float* operator()(int d) const { return w + d; } };
struct ColWin { const float* w; __device__ __forceinline__ const float* operator()(int d) const {
    if (d < 2048) return w + d; if (d < 3584) return w + d + 8; if (d < 3592) return w + d - 1536; if (d < 3608) return w + d; return nullptr; } };

template <class ColPtr>
__device__ __forceinline__ void transpose_item(const ColPtr& cp, int nsrc, int K, bf16* WT, LAS float* scr, int kb, int nb, int lane) {
    const int k0 = 64 * kb, n0 = 32 * nb;
    const float* colp = cp(n0 + (lane & 31));
#pragma unroll 8
    for (int i = 0; i < 32; ++i) { const int kk = 2 * i + (lane >> 5); scr[kk * 33 + (lane & 31)] = colp ? colp[(size_t)(k0 + kk) * nsrc] : 0.f; }
    asm volatile("s_waitcnt lgkmcnt(0)" ::: "memory");
    const int c = lane & 7;
#pragma unroll
    for (int j = 0; j < 4; ++j) { const int n = (lane >> 3) + 8 * j; const LAS float* s = scr + (8 * c) * 33 + n;
        u32x4 o; o.x = pk2(s[0 * 33], s[1 * 33]); o.y = pk2(s[2 * 33], s[3 * 33]); o.z = pk2(s[4 * 33], s[5 * 33]); o.w = pk2(s[6 * 33], s[7 * 33]);
        *(u32x4*)(WT + (size_t)(n0 + n) * K + k0 + 8 * c) = o; }
    asm volatile("s_waitcnt lgkmcnt(0)" ::: "memory");
}

__device__ __forceinline__ void prologue(const Args& a, LAS unsigned char* lds, int gw, int NGW, int wave, int lane, int part) {
    unsigned char* ws = a.ws;
    LAS float* scr = (LAS float*)(lds + wave * 16384);
    constexpr int I_GU = 16 * (NGU / 32), I_D = (FF / 64) * (D / 32), I_IN = 16 * (NPROJ / 32), I_O = 16 * (D / 32);
    if (part == 0) {
        constexpr int NITEMS = I_GU + I_D + I_IN;
        for (int it = gw; it < NITEMS; it += NGW) {
            int r = it;
            if (r < I_GU) { ColGU c{a.in[1], a.in[2]}; transpose_item(c, FF, D, (bf16*)(ws + WS_WGU1), scr, r / (NGU / 32), r % (NGU / 32), lane); continue; } r -= I_GU;
            if (r < I_D) { ColPlain c{a.in[3]}; transpose_item(c, D, FF, (bf16*)(ws + WS_WD1), scr, r / (D / 32), r % (D / 32), lane); continue; } r -= I_D;
            { ColWin c{a.in[6]}; transpose_item(c, WIN_N, D, (bf16*)(ws + WS_WIN), scr, r / (NPROJ / 32), r % (NPROJ / 32), lane); }
        }
    } else {
        constexpr int NITEMS = I_GU + I_D + I_O;
        for (int it = gw; it < NITEMS; it += NGW) {
            int r = it;
            if (r < I_GU) { ColGU c{a.in[17], a.in[18]}; transpose_item(c, FF, D, (bf16*)(ws + WS_WGU2), scr, r / (NGU / 32), r % (NGU / 32), lane); continue; } r -= I_GU;
            if (r < I_D) { ColPlain c{a.in[19]}; transpose_item(c, D, FF, (bf16*)(ws + WS_WD2), scr, r / (D / 32), r % (D / 32), lane); continue; } r -= I_D;
            { ColPlain c{a.in[14]}; transpose_item(c, D, D, (bf16*)(ws + WS_WOUT), scr, r / (D / 32), r % (D / 32), lane); }
        }
        return;
    }
    const float* x = a.in[0]; bf16* xb = (bf16*)(ws + WS_XB);
    const size_t nthr = (size_t)NGW * 64, t0 = (size_t)gw * 64 + lane;
    for (size_t i = t0; i < (size_t)M * D / 8; i += nthr) {
        const f32x4 v0 = *(const f32x4*)(x + i * 8), v1 = *(const f32x4*)(x + i * 8 + 4);
        u32x4 o; o.x = pk2(v0[0], v0[1]); o.y = pk2(v0[2], v0[3]); o.z = pk2(v1[0], v1[1]); o.w = pk2(v1[2], v1[3]);
        *(u32x4*)(xb + i * 8) = o;
    }
}

__device__ __forceinline__ void ln_phase(const bf16* Y, float* Xf, bf16* Xb, const float* g, const float* b, int gw, int NGW, int lane) {
    float gv[16], bv[16];
#pragma unroll
    for (int j = 0; j < 2; ++j)
#pragma unroll
        for (int e = 0; e < 8; ++e) { gv[8 * j + e] = g[512 * j + 8 * lane + e]; bv[8 * j + e] = b[512 * j + 8 * lane + e]; }
#pragma unroll 2
    for (int m = gw; m < M; m += NGW) {
        const u32x4* yr = (const u32x4*)(Y + (size_t)m * D) + lane;
        const u32x4 y0 = yr[0], y1 = yr[64];
        float v[16]; float s = 0.f;
#pragma unroll
        for (int e = 0; e < 4; ++e) { v[2 * e] = bflo(y0[e]); v[2 * e + 1] = bfhi(y0[e]); v[8 + 2 * e] = bflo(y1[e]); v[9 + 2 * e] = bfhi(y1[e]); }
#pragma unroll
        for (int e = 0; e < 16; ++e) s += v[e];
        const float mean = wave_sum(s) * (1.f / D); float s2 = 0.f;
#pragma unroll
        for (int e = 0; e < 16; ++e) { v[e] -= mean; s2 += v[e] * v[e]; }
        const float rstd = 1.0f / sqrtf(wave_sum(s2) * (1.f / D) + LN_EPS);
#pragma unroll
        for (int e = 0; e < 16; ++e) v[e] = v[e] * rstd * gv[e] + bv[e];
        if (Xf) {
            f32x4* o = (f32x4*)(Xf + (size_t)m * D + 8 * lane);
            o[0] = (f32x4){v[0], v[1], v[2], v[3]}; o[1] = (f32x4){v[4], v[5], v[6], v[7]};
            o[128] = (f32x4){v[8], v[9], v[10], v[11]}; o[129] = (f32x4){v[12], v[13], v[14], v[15]};
        }
        if (Xb) {
            u32x4* o = (u32x4*)(Xb + (size_t)m * D) + lane;
            o[0] = (u32x4){pk2(v[0], v[1]), pk2(v[2], v[3]), pk2(v[4], v[5]), pk2(v[6], v[7])};
            o[64] = (u32x4){pk2(v[8], v[9]), pk2(v[10], v[11]), pk2(v[12], v[13]), pk2(v[14], v[15])};
        }
    }
}

__device__ __forceinline__ void gnorm_phase(bf16* MIX, const bf16* P, const float* wa, const float* wb, int gw, int NGW, int lane) {
    const int hd = lane >> 3, cc = (lane & 7) * 16;
    const float* wn = (hd < 4 ? wa : wb) + cc;
    float wv[16];
#pragma unroll
    for (int j = 0; j < 16; ++j) wv[j] = wn[j];
    const int gcol = (hd < 4 ? 1536 : 3072) + (hd & 3) * 128 + cc;
    for (int m = gw; m < M; m += NGW) {
        bf16* op = MIX + (size_t)m * D + lane * 16;
        const u32x4 o0 = *(const u32x4*)op, o1 = *(const u32x4*)(op + 8);
        const u32x4 g0 = *(const u32x4*)(P + (size_t)m * PW + gcol), g1 = *(const u32x4*)(P + (size_t)m * PW + gcol + 8);
        float o[16], g[16];
#pragma unroll
        for (int j = 0; j < 4; ++j) { o[2 * j] = bflo(o0[j]); o[2 * j + 1] = bfhi(o0[j]); o[8 + 2 * j] = bflo(o1[j]); o[9 + 2 * j] = bfhi(o1[j]);
                                      g[2 * j] = bflo(g0[j]); g[2 * j + 1] = bfhi(g0[j]); g[8 + 2 * j] = bflo(g1[j]); g[9 + 2 * j] = bfhi(g1[j]); }
        float ss = 0.f;
#pragma unroll
        for (int j = 0; j < 16; ++j) ss += o[j] * o[j];
        ss += __shfl_xor(ss, 1); ss += __shfl_xor(ss, 2); ss += __shfl_xor(ss, 4);
        const float rs = 1.0f / sqrtf(ss * (1.f / 128.f) + RMS_EPS);
        u32x4 r0, r1;
#pragma unroll
        for (int j = 0; j < 4; ++j) {
            r0[j] = pk2(o[2 * j] * rs * wv[2 * j] * silu(g[2 * j]), o[2 * j + 1] * rs * wv[2 * j + 1] * silu(g[2 * j + 1]));
            r1[j] = pk2(o[8 + 2 * j] * rs * wv[8 + 2 * j] * silu(g[8 + 2 * j]), o[9 + 2 * j] * rs * wv[9 + 2 * j] * silu(g[9 + 2 * j]));
        }
        *(u32x4*)op = r0; *(u32x4*)(op + 8) = r1;
    }
}

constexpr int PK_KN = 0, PK_QN = 17408, PK_RHS = 34816, PK_QF = 100352, PK_SC = 133120;
#ifndef PROBE_MASK
#define PROBE_MASK 0
#define PROBE_DIV 10
#endif
#define ACC_T0() unsigned long long t0_ = 0; if (PROBE_MASK >> 13) { if (blockIdx.x == 0 && threadIdx.x == 0) t0_ = __builtin_amdgcn_s_memrealtime(); }
#define ACC_ADD(slot) do { if (PROBE_MASK >> 13) { if (blockIdx.x == 0 && threadIdx.x == 0) { const unsigned long long t1_ = __builtin_amdgcn_s_memrealtime(); unsigned long long* A_ = (unsigned long long*)(a.ws + 32768) + 32 + (slot); *A_ += t1_ - t0_; t0_ = t1_; } } } while (0)
struct GdnPf { unsigned x[3][11]; f32x2_t w[3][4]; float s0, s1, dtb, alog; };
__device__ __forceinline__ void gdn_pf_load(GdnPf& f, const Args& a, int item, int tid) {
    const int n = item & 127, bh = item >> 7, h = bh & 3, b = bh >> 2, t0 = b * SEQ + n * 64;
    const int c2 = tid & 63, rg = tid >> 6;
    const bf16* P = (const bf16*)(a.ws + WS_HP);
    const float* cw = a.in[7];
#pragma unroll
    for (int mat = 0; mat < 3; ++mat) {
        const int ch = mat * 512 + h * 128 + 2 * c2;
#pragma unroll
        for (int i = 0; i < 11; ++i) { const int row = rg * 8 - 3 + i; const bool ok = !(n == 0 && row < 0);
            f.x[mat][i] = ok ? *(const unsigned*)(P + (size_t)(t0 + row) * PW + ch) : 0u; }
#pragma unroll
        for (int j = 0; j < 4; ++j) f.w[mat][j] = *(const f32x2_t*)(cw + j * 1536 + ch);
    }
    const float* sm = (const float*)(a.ws + WS_SMALL) + (size_t)(t0 + (tid & 63)) * 32;
    f.s0 = sm[h]; f.s1 = sm[4 + h]; f.dtb = a.in[9][h]; f.alog = a.in[8][h];
}
__device__ __forceinline__ void gdn_prep_item(const Args& a, LAS unsigned char* lds_in, int item, int tid_in, const GdnPf& f) {
    const int tid = opaque_v(tid_in); LAS unsigned char* lds = opaque_v(lds_in);
    const int bh = item >> 7, h = bh & 3;
    const int ci = item;
    const int lane = tid & 63, wid = tid >> 6;
    unsigned char* ws = a.ws;
    LAS float* RHS = opaque_v((LAS float*)(lds + PK_RHS)); LAS float* QF = opaque_v((LAS float*)(lds + PK_QF)); LAS float* AM = QF; LAS float* SC = opaque_v((LAS float*)(lds + PK_SC));
    LAS unsigned char* KNp = opaque_v(lds + PK_KN); LAS unsigned char* QNp = opaque_v(lds + PK_QN);
    bf16* DW = (bf16*)(ws + WS_DW) + (size_t)ci * 8192; bf16* DQ = (bf16*)(ws + WS_DQ) + (size_t)ci * 8192; bf16* DK = (bf16*)(ws + WS_DK) + (size_t)ci * 8192;
    bf16* DQK = (bf16*)((unsigned char*)a.out + OS_DQK) + (size_t)ci * 4096; bf16* DU = (bf16*)((unsigned char*)a.out + OS_DU) + (size_t)ci * 8192;
    float* DGL = (float*)(ws + WS_DGL);
    ACC_T0();
    if (tid < 64) {
        const float be = __builtin_amdgcn_rcpf(1.0f + __expf(-f.s0));
        const float xx = f.s1 + f.dtb;
        const float sp = xx > 20.f ? xx : log1pf(__expf(xx));
        float G = -__expf(f.alog) * sp;
#pragma unroll
        for (int o = 1; o < 64; o <<= 1) { const float t = __shfl_up(G, o); if (lane >= o) G += t; }
        const float Gl = __shfl(G, 63);
        SC[tid] = G; SC[64 + tid] = be; SC[128 + tid] = __expf(G); SC[192 + tid] = __expf(Gl - G);
        if (tid == 63) DGL[ci] = __expf(G);
    }
    {
        const int c2 = tid & 63, rg = tid >> 6;
#pragma unroll
        for (int mat = 0; mat < 3; ++mat) {
            float xa[11], xb[11];
#pragma unroll
            for (int i = 0; i < 11; ++i) { xa[i] = bflo(f.x[mat][i]); xb[i] = bfhi(f.x[mat][i]); }
            LAS float* dstp = (mat == 0 ? QF + rg * 8 * 128 : RHS + rg * 8 * 256 + (mat == 1 ? 128 : 0)) + 2 * c2; const int dstr = mat == 0 ? 128 : 256;
#pragma unroll
            for (int r = 0; r < 8; ++r) {
                const float ya = f.w[mat][0].x * xa[r] + f.w[mat][1].x * xa[r + 1] + f.w[mat][2].x * xa[r + 2] + f.w[mat][3].x * xa[r + 3];
                const float yb = f.w[mat][0].y * xb[r] + f.w[mat][1].y * xb[r + 1] + f.w[mat][2].y * xb[r + 2] + f.w[mat][3].y * xb[r + 3];
                *(LAS f32x2_t*)(dstp + r * dstr) = (f32x2_t){silu(ya), silu(yb)};
            }
        }
    }
    WG_BAR(); ACC_ADD(2);
    {
        const int l5 = tid & 31, rbase = tid >> 5;
        const int g32 = l5 >> 3, hi = (l5 >> 2) & 1, q4 = l5 & 3;
#pragma unroll
        for (int aa = 0; aa < 4; ++aa) {
            const int r = rbase + 16 * aa;
            const float be = SC[64 + r], eg = SC[128 + r];
            f32x4 qv = *(const LAS f32x4*)(QF + r * 128 + 4 * l5), kv = *(const LAS f32x4*)(RHS + r * 256 + 128 + 4 * l5), vv = *(const LAS f32x4*)(RHS + r * 256 + 4 * l5);
            float sq = (qv[0] * qv[0] + qv[1] * qv[1]) + (qv[2] * qv[2] + qv[3] * qv[3]), sk = (kv[0] * kv[0] + kv[1] * kv[1]) + (kv[2] * kv[2] + kv[3] * kv[3]);
#pragma unroll
            for (int o = 1; o < 32; o <<= 1) { sq += __shfl_xor(sq, o); sk += __shfl_xor(sk, o); }
            const float rq = __builtin_amdgcn_rsqf(sq + RMS_EPS) * 0.08838834764831845f, rk = __builtin_amdgcn_rsqf(sk + RMS_EPS);
            qv = qv * rq; kv = kv * rk;
            *(LAS f32x4*)(RHS + r * 256 + 128 + 4 * l5) = kv * (be * eg);
            *(LAS f32x4*)(RHS + r * 256 + 4 * l5) = vv * be;
            u32x2 kw, qw; kw.x = pk2(kv[0], kv[1]); kw.y = pk2(kv[2], kv[3]); qw.x = pk2(qv[0], qv[1]); qw.y = pk2(qv[2], qv[3]);
            *(LAS u32x2*)(KNp + r * 272 + 8 * l5) = kw; *(LAS u32x2*)(QNp + r * 272 + 8 * l5) = qw;
            u32x2 mine; mine.x = pk2(qv[0] * eg, qv[1] * eg); mine.y = pk2(qv[2] * eg, qv[3] * eg);
            u32x2 oth; oth.x = __shfl_xor(mine.x, 4); oth.y = __shfl_xor(mine.y, 4);
            if ((aa >> 1) == hi) { const int rr = r; u32x4 w = hi == 0 ? (u32x4){mine.x, mine.y, oth.x, oth.y} : (u32x4){oth.x, oth.y, mine.x, mine.y};
                *(u32x4*)(DQ + rr * 128 + g32 * 32 + 8 * q4) = w; }
        }
    }
    WG_BAR(); ACC_ADD(3);
    {
        const int cb = wid & 3; const bool isqk = wid >= 4; const int r = lane & 15, q = lane >> 4;
        const LAS unsigned char* Ab = isqk ? QNp : KNp;
        bf16x8 bv[4];
#pragma unroll
        for (int s = 0; s < 4; ++s) bv[s] = *(const LAS bf16x8*)(KNp + (16 * cb + r) * 272 + s * 64 + q * 16);
        const int jj = 16 * cb + r; const float Gj = SC[jj];
#pragma unroll 1
        for (int rb = 0; rb < 4; ++rb) {
            f32x4 acc = (f32x4){0.f, 0.f, 0.f, 0.f};
            if (rb >= cb) {
#pragma unroll
                for (int s = 0; s < 4; ++s) { const bf16x8 av = *(const LAS bf16x8*)(Ab + (16 * rb + r) * 272 + s * 64 + q * 16); acc = MFMA16(av, bv[s], acc); }
            }
#pragma unroll
            for (int i = 0; i < 4; ++i) {
                const int ii = 16 * rb + 4 * q + i; const float d = __expf(fminf(SC[ii] - Gj, 0.f));
                if (isqk) { DQK[ii * 64 + kperm(jj)] = f2bf((jj <= ii) ? acc[i] * d : 0.f); }
                else if (rb >= cb) { AM[ii * 68 + jj] = (jj < ii) ? SC[64 + ii] * acc[i] * d : 0.f; }
            }
        }
    }
    WG_BAR(); ACC_ADD(4);
    if (tid >= 256 && tid < 384) {
        const int c = tid - 256;
#pragma unroll 1
        for (int k8 = 0; k8 < 8; ++k8) {
            float v[8];
#pragma unroll
            for (int e = 0; e < 8; ++e) v[e] = bf2f(*(const LAS unsigned short*)(KNp + (8 * k8 + e) * 272 + c * 2)) * SC[192 + 8 * k8 + e];
            const int m = k8 & 3, pos0 = 32 * (k8 >> 2) + 16 * (m & 1) + 4 * (m >> 1);
            u32x2 w0, w1; w0.x = pk2(v[0], v[1]); w0.y = pk2(v[2], v[3]); w1.x = pk2(v[4], v[5]); w1.y = pk2(v[6], v[7]);
            *(u32x2*)(DK + c * 64 + pos0) = w0; *(u32x2*)(DK + c * 64 + pos0 + 8) = w1;
        }
    }
#pragma unroll 1
    for (int J = 0; J < 4; ++J) {
        if (tid < 256) {
            const int c = tid; LAS float* rj = RHS + c + J * 16 * 256; const LAS float* aj = AM + (J * 16) * 68 + J * 16; const int pc = kperm(c & 127);
            float x[16];
#pragma unroll
            for (int r = 0; r < 16; ++r) x[r] = rj[r * 256];
#pragma unroll
            for (int hf = 0; hf < 2; ++hf) {
                f32x4 ad[8][4];
#pragma unroll
                for (int r8 = 0; r8 < 8; ++r8)
#pragma unroll
                    for (int jb = 0; jb < (8 * hf + r8 + 3) / 4; ++jb) ad[r8][jb] = *(const LAS f32x4*)(aj + (8 * hf + r8) * 68 + 4 * jb);
#pragma unroll
                for (int r8 = 0; r8 < 8; ++r8) {
                    const int r = 8 * hf + r8; f32x2_t a2 = (f32x2_t){x[r], 0.f};
#pragma unroll
                    for (int m = 0; m < r / 2; ++m)
                        a2 -= ((m & 1) ? __builtin_shufflevector(ad[r8][m >> 1], ad[r8][m >> 1], 2, 3) : __builtin_shufflevector(ad[r8][m >> 1], ad[r8][m >> 1], 0, 1)) * (f32x2_t){x[2 * m], x[2 * m + 1]};
                    float acc = a2.x + a2.y;
                    if (r & 1) acc -= ad[r8][(r - 1) >> 2][(r - 1) & 3] * x[r - 1];
                    x[r] = acc;
                }
            }
            if (J < 3) {
#pragma unroll
                for (int r = 0; r < 16; ++r) rj[r * 256] = x[r];
            }
            if (c < 128) {
#pragma unroll
                for (int k8 = 0; k8 < 2; ++k8) { u32x4 w; w.x = pk2(x[8 * k8], x[8 * k8 + 1]); w.y = pk2(x[8 * k8 + 2], x[8 * k8 + 3]); w.z = pk2(x[8 * k8 + 4], x[8 * k8 + 5]); w.w = pk2(x[8 * k8 + 6], x[8 * k8 + 7]);
                    *(u32x4*)(DU + c * 64 + 16 * J + 8 * k8) = w; }
            } else {
#pragma unroll
                for (int r = 0; r < 16; ++r) DW[(16 * J + r) * 128 + pc] = f2bf(x[r]);
            }
        }
        WG_BAR();
        if (J < 3) {
            const int c16 = lane & 15, q = lane >> 4, nblk = (3 - J) * 16;
#pragma unroll 2
            for (int blk = wid; blk < nblk; blk += 8) {
                const int rb = J + 1 + (blk >> 4), cb = blk & 15;
                LAS float* cp = RHS + (16 * rb + 4 * q) * 256 + 16 * cb + c16;
                const LAS float* ap = AM + (16 * rb + c16) * 68 + 16 * J + q;
                const LAS float* bp = RHS + (16 * J + q) * 256 + 16 * cb + c16;
                f32x4 acc = (f32x4){cp[0], cp[256], cp[512], cp[768]};
#pragma unroll
                for (int s4 = 0; s4 < 4; ++s4) acc = __builtin_amdgcn_mfma_f32_16x16x4f32(-ap[4 * s4], bp[4 * s4 * 256], acc, 0, 0, 0);
                cp[0] = acc[0]; cp[256] = acc[1]; cp[512] = acc[2]; cp[768] = acc[3];
            }
            WG_BAR();
        }
    }
    ACC_ADD(5);
}

constexpr int GK_QT = 0, GK_KT = 9216, GK_PS = 18432, GK_LR = 20480;
struct GlaPf { f32x4 lr; unsigned v[8]; unsigned short q[8], k[8]; float wg[16]; float bg; };
__device__ __forceinline__ void gla_pf_load(GlaPf& f, const Args& a, int item, int tid) {
    const int n = item & 127, bh = item >> 7, h = bh & 3, b = bh >> 2, t0 = b * SEQ + n * 64;
    const bf16* P = (const bf16*)(a.ws + WS_HP);
    const float* SMALL = (const float*)(a.ws + WS_SMALL);
    f.lr = *(const f32x4*)(SMALL + (size_t)(t0 + ((tid & 255) >> 2)) * 32 + 8 + (tid & 3) * 4);
    const int dvp = tid & 63, tg = tid >> 6;
#pragma unroll
    for (int j = 0; j < 8; ++j) f.v[j] = *(const unsigned*)(P + (size_t)(t0 + tg * 8 + j) * PW + 2560 + h * 128 + 2 * dvp);
    const int k = tid & 63, rg = tid >> 6;
#pragma unroll
    for (int i = 0; i < 8; ++i) { f.q[i] = P[(size_t)(t0 + rg * 8 + i) * PW + 2048 + h * 64 + k]; f.k[i] = P[(size_t)(t0 + rg * 8 + i) * PW + 2304 + h * 64 + k]; }
#pragma unroll
    for (int j = 0; j < 16; ++j) f.wg[j] = a.in[11][j * 256 + h * 64 + k];
    f.bg = a.in[12][h * 64 + k];
}
__device__ __forceinline__ void gla_prep_item(const Args& a, LAS unsigned char* lds_in, int item, int tid_in, const GlaPf& f) {
    const int tid = opaque_v(tid_in); LAS unsigned char* lds = opaque_v(lds_in);
    const int ci = item;
    const int lane = tid & 63, wid = tid >> 6;
    unsigned char* ws = a.ws;
    unsigned char* os = (unsigned char*)a.out;
    bf16* GQ = (bf16*)(os + OS_GQ) + (size_t)ci * 4096; bf16* GA = (bf16*)(os + OS_GA) + (size_t)ci * 4096; bf16* GK = (bf16*)(os + OS_GK) + (size_t)ci * 4096;
    bf16* GV = (bf16*)(os + OS_GV) + (size_t)ci * 8192; float* GE = (float*)(ws + WS_GE) + (size_t)ci * 64;
    LAS float* PS = (LAS float*)(lds + GK_PS); LAS float* LR = (LAS float*)(lds + GK_LR);
    if (tid < 256) *(LAS f32x4*)(LR + tid * 4) = f.lr;
    {
        const int dvp = tid & 63, tg = tid >> 6;
        u32x4 w0, w1;
#pragma unroll
        for (int m = 0; m < 4; ++m) { w0[m] = (f.v[2 * m] & 0xffffu) | (f.v[2 * m + 1] << 16); w1[m] = (f.v[2 * m] >> 16) | (f.v[2 * m + 1] & 0xffff0000u); }
        *(u32x4*)(GV + (2 * dvp) * 64 + tg * 8) = w0; *(u32x4*)(GV + (2 * dvp + 1) * 64 + tg * 8) = w1;
    }
    WG_BAR();
    const int k = tid & 63, rg = tid >> 6;
    float lg[8];
    {
        float run = 0.f;
#pragma unroll
        for (int i = 0; i < 8; ++i) {
            const int r = rg * 8 + i; float x = f.bg;
#pragma unroll
            for (int j = 0; j < 16; ++j) x += LR[r * 16 + j] * f.wg[j];
            const float ls = fminf(x, 0.f) - __logf(1.0f + __expf(-fabsf(x)));
            run += ls * (1.0f / 16.0f); lg[i] = run;
        }
        PS[rg * 64 + k] = run;
    }
    WG_BAR();
    {
        float off = 0.f, tot = 0.f;
#pragma unroll
        for (int g2 = 0; g2 < 8; ++g2) { const float v = PS[g2 * 64 + k]; if (g2 < rg) off += v; tot += v; }
        float kd[8];
#pragma unroll
        for (int i = 0; i < 8; ++i) {
            const int r = rg * 8 + i; const float bc = lg[i] + off;
            const float qraw = bf2f(f.q[i]), kraw = bf2f(f.k[i]);
            const float qt = qraw * 0.125f * __expf(bc), kt = kraw * __expf(-bc);
            kd[i] = kraw * __expf(tot - bc);
            const unsigned short qb = f2bf(qt);
            *(LAS unsigned short*)(lds + GK_QT + r * 144 + k * 2) = qb; *(LAS unsigned short*)(lds + GK_KT + r * 144 + k * 2) = f2bf(kt);
            GQ[r * 64 + kperm(k)] = qb;
        }
        u32x4 w; w.x = pk2(kd[0], kd[1]); w.y = pk2(kd[2], kd[3]); w.z = pk2(kd[4], kd[5]); w.w = pk2(kd[6], kd[7]);
        *(u32x4*)(GK + k * 64 + rg * 8) = w;
        if (rg == 0) GE[k] = __expf(tot);
    }
    WG_BAR();
    if (wid < 4) {
        const int rb = wid, r = lane & 15, q = lane >> 4;
        f32x4 acc[4];
#pragma unroll
        for (int cb = 0; cb < 4; ++cb) acc[cb] = (f32x4){0.f, 0.f, 0.f, 0.f};
#pragma unroll
        for (int s = 0; s < 2; ++s) {
            const bf16x8 av = *(const LAS bf16x8*)(lds + GK_QT + (16 * rb + r) * 144 + s * 64 + q * 16);
#pragma unroll
            for (int cb = 0; cb < 4; ++cb) { const bf16x8 bv = *(const LAS bf16x8*)(lds + GK_KT + (16 * cb + r) * 144 + s * 64 + q * 16); acc[cb] = MFMA16(av, bv, acc[cb]); }
        }
#pragma unroll
        for (int cb = 0; cb < 4; ++cb)
#pragma unroll
            for (int i = 0; i < 4; ++i) { const int ii = 16 * rb + 4 * q + i, jj = 16 * cb + r; GA[ii * 64 + jj] = f2bf(jj <= ii ? acc[cb][i] : 0.f); }
    }
    WG_BAR();
}

constexpr int SB_W = 0, SB_Q = 17408, SB_K = 34816, SB_QK = 53248, SB_U = 62464, SB_BYTES = 62464 + 16 * 144;
constexpr int GB_Q = 0, GB_A = 9216, GB_K = 18432, GB_V = 27648, GB_E = 27648 + 64 * 144, GB_BYTES = GB_E + 256;


template <int NPART> __device__ __forceinline__ void gdn_scan(const Args& a, LAS unsigned char* lds_in, int bh, int part, int tid_in) {
    constexpr int CW = 128 / NPART, NCWAVE = CW / (16 * NSL), NLOAD = 512 - 64 * NCWAVE, NPIECE = 3584 + CW * 8, GDN_KP = (NPIECE + NLOAD - 1) / NLOAD;
    static_assert(CW == 16, "GDN stage buffer holds a 16-column U slice");
    const int tid = opaque_v(tid_in); LAS unsigned char* lds = opaque_v(lds_in);
    const int lane = tid & 63, wid = tid >> 6, c = lane & 15, q = lane >> 4, h = bh & 3, b = bh >> 2;
    unsigned char* ws = a.ws; unsigned char* os = (unsigned char*)a.out;
    if (wid >= NCWAVE) {
        const int lt = tid - 64 * NCWAVE;
        const u32x4* src[GDN_KP]; int cst[GDN_KP]; int dst[GDN_KP]; bool ok[GDN_KP];
#pragma unroll
        for (int k = 0; k < GDN_KP; ++k) {
            const int p = lt + k * NLOAD; ok[k] = p < NPIECE; const int pc = ok[k] ? p : 0; const int arr = pc < 3584 ? (pc >> 10) : 4, pp = pc < 3584 ? (pc & 1023) : pc - 3584;
            const unsigned char* base = arr == 0 ? ws + WS_DW : arr == 1 ? ws + WS_DQ : arr == 2 ? ws + WS_DK : arr == 3 ? os + OS_DQK : os + OS_DU;
            cst[k] = arr == 3 ? 512 : 1024;
            src[k] = (const u32x4*)base + (size_t)bh * 128 * cst[k] + pp + (arr == 4 ? part * CW * 8 : 0);
            dst[k] = arr < 2 ? (arr == 0 ? SB_W : SB_Q) + (pp >> 4) * 272 + (pp & 15) * 16 : (arr == 2 ? SB_K : arr == 3 ? SB_QK : SB_U) + (pp >> 3) * 144 + (pp & 7) * 16;
        }
        u32x4 sa[GDN_KP], sb[GDN_KP], sc[GDN_KP], sd[GDN_KP];
#define L_LOAD(set, n) do { const int n_ = (n) < NCHK ? (n) : NCHK - 1; _Pragma("unroll") for (int k = 0; k < GDN_KP; ++k) set[k] = src[k][(size_t)n_ * cst[k]]; } while (0)
#define L_STORE(set, buf) do { LAS unsigned char* B_ = lds + (buf) * SB_BYTES; _Pragma("unroll") for (int k = 0; k < GDN_KP; ++k) if (ok[k]) *(LAS u32x4*)(B_ + dst[k]) = set[k]; } while (0)
        L_LOAD(sa, 0); L_STORE(sa, 0); L_LOAD(sa, 1); L_LOAD(sb, 2); L_LOAD(sc, 3); L_LOAD(sd, 4);
        WG_BAR();
        for (int n = 0; n < NCHK; n += 4) {
            L_STORE(sa, 1); L_LOAD(sa, n + 5); WG_BAR();
            L_STORE(sb, 0); L_LOAD(sb, n + 6); WG_BAR();
            L_STORE(sc, 1); L_LOAD(sc, n + 7); WG_BAR();
            L_STORE(sd, 0); L_LOAD(sd, n + 8); WG_BAR();
        }
#undef L_LOAD
#undef L_STORE
        return;
    }
    const float* DGL = (const float*)(ws + WS_DGL) + bh * 128;
    bf16* MIX = (bf16*)(ws + WS_MIX);
    const int dv0 = part * CW + 16 * NSL * wid + c;
    f32x4 S[NSL][8]; bf16x8 Sb[NSL][4];
#pragma unroll
    for (int sl = 0; sl < NSL; ++sl) {
#pragma unroll
        for (int i = 0; i < 8; ++i) S[sl][i] = (f32x4){0.f, 0.f, 0.f, 0.f};
#pragma unroll
        for (int i = 0; i < 4; ++i) Sb[sl][i] = (bf16x8){0, 0, 0, 0, 0, 0, 0, 0};
    }
    float gln = DGL[0];
    WG_BAR();
    for (int n = 0; n < NCHK; ++n) {
        const int nn = n + 1 < NCHK ? n + 1 : n;
        const LAS unsigned char* B = lds + (n & 1) * SB_BYTES;
        const float gl = gln; gln = DGL[nn];
        u32x2 uc[NSL][4];
#pragma unroll
        for (int sl = 0; sl < NSL; ++sl)
#pragma unroll
            for (int rb = 0; rb < 4; ++rb) uc[sl][rb] = *(const LAS u32x2*)(B + SB_U + (16 * (NSL * wid + sl) + c) * 144 + (16 * rb + 4 * q) * 2);
        static_assert(NSL == 1, "hand-pipelined step assumes one slice per wave");
        bf16x8 wf[4][4], qf[4][4];
#pragma unroll
        for (int s = 0; s < 4; ++s)
#pragma unroll
            for (int rb = 0; rb < 4; ++rb) wf[s][rb] = *(const LAS bf16x8*)(B + SB_W + (16 * rb + c) * 272 + s * 64 + q * 16);
#pragma unroll
        for (int s = 0; s < 4; ++s)
#pragma unroll
            for (int rb = 0; rb < 4; ++rb) qf[s][rb] = *(const LAS bf16x8*)(B + SB_Q + (16 * rb + c) * 272 + s * 64 + q * 16);
        __builtin_amdgcn_sched_barrier(0);
        f32x4 aO[4], aW[4];
#pragma unroll
        for (int rb = 0; rb < 4; ++rb) { aO[rb] = (f32x4){0.f, 0.f, 0.f, 0.f}; aW[rb] = (f32x4){0.f, 0.f, 0.f, 0.f}; }
#pragma unroll
        for (int s = 0; s < 4; ++s)
#pragma unroll
            for (int rb = 0; rb < 4; ++rb) aW[rb] = MFMA16(wf[s][rb], Sb[0][s], aW[rb]);
        __builtin_amdgcn_sched_barrier(0);
        bf16x8 kf[8][2];
#pragma unroll
        for (int rb = 0; rb < 8; ++rb)
#pragma unroll
            for (int s = 0; s < 2; ++s) kf[rb][s] = *(const LAS bf16x8*)(B + SB_K + (16 * rb + c) * 144 + s * 64 + q * 16);
        __builtin_amdgcn_sched_barrier(0);
#pragma unroll
        for (int s = 0; s < 4; ++s)
#pragma unroll
            for (int rb = 0; rb < 4; ++rb) aO[rb] = MFMA16(qf[s][rb], Sb[0][s], aO[rb]);
        __builtin_amdgcn_sched_barrier(0);
        bf16x8 gf[2][4];
#pragma unroll
        for (int s = 0; s < 2; ++s)
#pragma unroll
            for (int rb = 0; rb < 4; ++rb) gf[s][rb] = *(const LAS bf16x8*)(B + SB_QK + (16 * rb + c) * 144 + s * 64 + q * 16);
        bf16x8 Vb[2];
        {
            f32x4 vn[4];
#pragma unroll
            for (int rb = 0; rb < 4; ++rb) vn[rb] = (f32x4){bflo(uc[0][rb].x), bfhi(uc[0][rb].x), bflo(uc[0][rb].y), bfhi(uc[0][rb].y)} - aW[rb];
            Vb[0] = pack8(vn[0], vn[1]); Vb[1] = pack8(vn[2], vn[3]);
        }
        __builtin_amdgcn_sched_barrier(0);
#pragma unroll
        for (int rb = 0; rb < 8; ++rb) S[0][rb] = S[0][rb] * gl;
#pragma unroll
        for (int s = 0; s < 2; ++s)
#pragma unroll
            for (int rb = 0; rb < 8; ++rb) S[0][rb] = MFMA16(kf[rb][s], Vb[s], S[0][rb]);
#pragma unroll
        for (int s = 0; s < 2; ++s)
#pragma unroll
            for (int rb = 0; rb < 4; ++rb) aO[rb] = MFMA16(gf[s][rb], Vb[s], aO[rb]);
#pragma unroll
        for (int s = 0; s < 4; ++s) Sb[0][s] = pack8(S[0][2 * s], S[0][2 * s + 1]);
        {
            bf16* op = MIX + (size_t)(b * SEQ + n * 64 + 4 * q) * D + h * 128 + dv0;
#pragma unroll
            for (int rb = 0; rb < 4; ++rb)
#pragma unroll
                for (int i = 0; i < 4; ++i) op[(size_t)(16 * rb + i) * D] = f2bf(aO[rb][i]);
        }
        WG_BAR();
    }
}

template <int NPART> __device__ __forceinline__ void gla_scan(const Args& a, LAS unsigned char* lds_in, int bh, int part, int tid_in) {
    constexpr int CW = 128 / NPART, NCWAVE = CW / (16 * NSL), NLOAD = 512 - 64 * NCWAVE, NPIECE = 1536 + CW * 8 + 16, GLA_KP = (NPIECE + NLOAD - 1) / NLOAD;
    static_assert(CW <= 64, "GLA stage buffer holds at most a 64-column V slice");
    const int tid = opaque_v(tid_in); LAS unsigned char* lds = opaque_v(lds_in);
    const int lane = tid & 63, wid = tid >> 6, c = lane & 15, q = lane >> 4, h = bh & 3, b = bh >> 2;
    unsigned char* ws = a.ws; unsigned char* os = (unsigned char*)a.out;
    if (wid >= NCWAVE) {
        const int lt = tid - 64 * NCWAVE;
        const u32x4* src[GLA_KP]; int cst[GLA_KP]; int dst[GLA_KP]; bool ok[GLA_KP];
#pragma unroll
        for (int k = 0; k < GLA_KP; ++k) {
            const int p = lt + k * NLOAD; ok[k] = p < NPIECE; const int pc = ok[k] ? p : 0;
            const int arr = pc < 1536 ? (pc >> 9) : (pc < 1536 + CW * 8 ? 3 : 4), pp = pc < 1536 ? (pc & 511) : (arr == 3 ? pc - 1536 : pc - 1536 - CW * 8);
            const unsigned char* base = arr == 0 ? os + OS_GQ : arr == 1 ? os + OS_GA : arr == 2 ? os + OS_GK : arr == 3 ? os + OS_GV : ws + WS_GE;
            cst[k] = arr < 3 ? 512 : arr == 3 ? 1024 : 16;
            src[k] = (const u32x4*)base + (size_t)bh * 128 * cst[k] + pp + (arr == 3 ? part * CW * 8 : 0);
            dst[k] = arr == 4 ? GB_E + pp * 16 : (arr == 0 ? GB_Q : arr == 1 ? GB_A : arr == 2 ? GB_K : GB_V) + (pp >> 3) * 144 + (pp & 7) * 16;
        }
        u32x4 sa[GLA_KP], sb[GLA_KP], sc[GLA_KP], sd[GLA_KP];
#define L_LOAD(set, n) do { const int n_ = (n) < NCHK ? (n) : NCHK - 1; _Pragma("unroll") for (int k = 0; k < GLA_KP; ++k) set[k] = src[k][(size_t)n_ * cst[k]]; } while (0)
#define L_STORE(set, buf) do { LAS unsigned char* B_ = lds + (buf) * GB_BYTES; _Pragma("unroll") for (int k = 0; k < GLA_KP; ++k) if (ok[k]) *(LAS u32x4*)(B_ + dst[k]) = set[k]; } while (0)
        L_LOAD(sa, 0); L_STORE(sa, 0); L_LOAD(sa, 1); L_LOAD(sb, 2); L_LOAD(sc, 3); L_LOAD(sd, 4);
        WG_BAR();
        for (int n = 0; n < NCHK; n += 4) {
            L_STORE(sa, 1); L_LOAD(sa, n + 5); WG_BAR();
            L_STORE(sb, 0); L_LOAD(sb, n + 6); WG_BAR();
            L_STORE(sc, 1); L_LOAD(sc, n + 7); WG_BAR();
            L_STORE(sd, 0); L_LOAD(sd, n + 8); WG_BAR();
        }
#undef L_LOAD
#undef L_STORE
        return;
    }
    bf16* MIX = (bf16*)(ws + WS_MIX);
    const int dv0 = part * CW + 16 * NSL * wid + c;
    f32x4 S[NSL][4]; bf16x8 Sb[NSL][2];
#pragma unroll
    for (int sl = 0; sl < NSL; ++sl) {
#pragma unroll
        for (int i = 0; i < 4; ++i) S[sl][i] = (f32x4){0.f, 0.f, 0.f, 0.f};
#pragma unroll
        for (int i = 0; i < 2; ++i) Sb[sl][i] = (bf16x8){0, 0, 0, 0, 0, 0, 0, 0};
    }
    WG_BAR();
    for (int n = 0; n < NCHK; ++n) {
        const LAS unsigned char* B = lds + (n & 1) * GB_BYTES;
        bf16x8 Vb[NSL][2]; f32x4 eb[4];
#pragma unroll
        for (int sl = 0; sl < NSL; ++sl)
#pragma unroll
            for (int s = 0; s < 2; ++s) Vb[sl][s] = *(const LAS bf16x8*)(B + GB_V + (16 * (NSL * wid + sl) + c) * 144 + (32 * s + 8 * q) * 2);
#pragma unroll
        for (int rb = 0; rb < 4; ++rb) eb[rb] = *(const LAS f32x4*)(B + GB_E + (16 * rb + 4 * q) * 4);
        f32x4 aO[NSL][4];
#pragma unroll
        for (int sl = 0; sl < NSL; ++sl)
#pragma unroll
            for (int rb = 0; rb < 4; ++rb) aO[sl][rb] = (f32x4){0.f, 0.f, 0.f, 0.f};
#pragma unroll
        for (int s = 0; s < 2; ++s)
#pragma unroll
            for (int rb = 0; rb < 4; ++rb) {
                const bf16x8 qv = *(const LAS bf16x8*)(B + GB_Q + (16 * rb + c) * 144 + s * 64 + q * 16);
                const bf16x8 av = *(const LAS bf16x8*)(B + GB_A + (16 * rb + c) * 144 + s * 64 + q * 16);
#pragma unroll
                for (int sl = 0; sl < NSL; ++sl) { aO[sl][rb] = MFMA16(qv, Sb[sl][s], aO[sl][rb]); aO[sl][rb] = MFMA16(av, Vb[sl][s], aO[sl][rb]); }
            }
#pragma unroll
        for (int rb = 0; rb < 4; ++rb) {
#pragma unroll
            for (int sl = 0; sl < NSL; ++sl) S[sl][rb] = S[sl][rb] * eb[rb];
#pragma unroll
            for (int s = 0; s < 2; ++s) {
                const bf16x8 kv = *(const LAS bf16x8*)(B + GB_K + (16 * rb + c) * 144 + s * 64 + q * 16);
#pragma unroll
                for (int sl = 0; sl < NSL; ++sl) S[sl][rb] = MFMA16(kv, Vb[sl][s], S[sl][rb]);
            }
        }
#pragma unroll
        for (int sl = 0; sl < NSL; ++sl) {
#pragma unroll
            for (int s = 0; s < 2; ++s) Sb[sl][s] = pack8(S[sl][2 * s], S[sl][2 * s + 1]);
            bf16* op = MIX + (size_t)(b * SEQ + n * 64 + 4 * q) * D + 512 + h * 128 + dv0 + 16 * sl;
#pragma unroll
            for (int rb = 0; rb < 4; ++rb)
#pragma unroll
                for (int i = 0; i < 4; ++i) op[(size_t)(16 * rb + i) * D] = f2bf(aO[sl][rb][i]);
        }
        WG_BAR();
    }
}

__global__ void __launch_bounds__(512, 2) fwd_kernel(Args a) {
    extern __shared__ __attribute__((aligned(16))) unsigned char lds_raw[];
    LAS unsigned char* lds = (LAS unsigned char*)lds_raw;
    const int tid = threadIdx.x, lane = tid & 63, wave = __builtin_amdgcn_readfirstlane(tid >> 6);
    const int G = gridDim.x, bx = blockIdx.x;
    const int vcu = (G % 8 == 0) ? (bx % 8) * (G / 8) + bx / 8 : bx;
    const int gw = vcu * 8 + wave, NGW = G * 8;
    unsigned char* ws = a.ws;
    const int lo = a.ph_lo, hi = a.ph_hi;
    volatile LAS unsigned* bst = (volatile LAS unsigned*)(lds + LDS_BYTES - 64);
    if (tid < 2) bst[tid] = 0u;
    __syncthreads();
    XcdBarrier bar; bar.bar = (unsigned*)ws; bar.x = 0; bar.st = bst;
    if (a.coop == 1) bar = xcd_barrier_post((unsigned*)ws, bst);
#define IN(k) (lo <= (k) && (k) < hi)
#define REPEAT(k) _Pragma("unroll 1") for (int rep_ = 0; rep_ < ((k) == XREP_PHASE ? a.pad : 1); ++rep_)
#ifndef PROBE_MASK
#define PROBE_MASK 0
#define PROBE_DIV 10
#endif
    unsigned long long* TS = (unsigned long long*)(ws + 32768);
    if (PROBE_MASK && bx == 0 && tid == 0) { TS[0] = __builtin_amdgcn_s_memrealtime(); for (int k = 0; k < 16; ++k) TS[32 + k] = 0; }
#define STAMP(k) do { if (PROBE_MASK && bx == 0 && tid == 0) TS[(k) + 1] = __builtin_amdgcn_s_memrealtime(); } while (0)
#define SEAM(k) do { if (IN(k) && IN((k) + 1)) { if (a.coop == 1) xcd_barrier(bar); else if (a.coop == 2) cg::this_grid().sync(); } STAMP(k); } while (0)
    bf16* XB = (bf16*)(ws + WS_XB); bf16* HB = (bf16*)(ws + WS_HP); bf16* MIX = (bf16*)(ws + WS_MIX);
    float* SMALL = (float*)(ws + WS_SMALL);

    if (IN(0)) REPEAT(0) { prologue(a, lds, gw, NGW, wave, lane, 0); } SEAM(0);
    if (IN(1)) REPEAT(1) {
        pg8::Gemm g{XB, (const bf16*)(ws + WS_WGU1), M, NGU, D}; pg8::StaticOrder S; S.init(M, NGU, G, bx);
        pg8::EpiSwiglu E{HB, FF};
        pg8::gemm_phase<pg8::EpiSwiglu, pg8::StaticOrder, true, true>(lds, g, S, E);
    } SEAM(1);
    if (IN(2)) REPEAT(2) {
        pg8::Gemm g{HB, (const bf16*)(ws + WS_WD1), M, D, FF}; pg8::StaticOrder S; S.init(M, D, G, bx);
        pg8::EpiRes<false> E{a.in[0], (bf16*)a.out, ALPHA, 0.5f};
        pg8::gemm_phase<pg8::EpiRes<false>, pg8::StaticOrder, true, true>(lds, g, S, E);
    } SEAM(2);
    if (IN(3)) REPEAT(3) { ln_phase((const bf16*)a.out, nullptr, XB, a.in[4], a.in[5], gw, NGW, lane); } SEAM(3);
    if (IN(4)) REPEAT(4) {
        pg8::Gemm g{XB, (const bf16*)(ws + WS_WIN), M, NPROJ, D}; pg8::StaticOrder S; S.init(M, NPROJ, G, bx);
        pg8::EpiProj E{HB, SMALL};
        pg8::gemm_phase<pg8::EpiProj, pg8::StaticOrder, true, true>(lds, g, S, E);
    } SEAM(4);
    if (IN(5)) REPEAT(5) {
        {
            GdnPf pf; int it = bx; if (it < NCH) gdn_pf_load(pf, a, it, tid);
            ACC_T0();
#pragma unroll 1
            for (; it < NCH; it += G) { const GdnPf cur = pf; if (it + G < NCH) gdn_pf_load(pf, a, it + G, tid); gdn_prep_item(a, lds, it, tid, cur); }
            ACC_ADD(0);
        }
        {
            GlaPf pf; int it = bx; if (it < NCH) gla_pf_load(pf, a, it, tid);
            ACC_T0();
#pragma unroll 1
            for (; it < NCH; it += G) { const GlaPf cur = pf; if (it + G < NCH) gla_pf_load(pf, a, it + G, tid); gla_prep_item(a, lds, it, tid, cur); }
            ACC_ADD(1);
        }
    } SEAM(5);
    if (IN(6)) REPEAT(6) {
        const int xcd = bx & 7, slot = bx >> 3;
        constexpr int NSCAN = 2 * NP_GDN + 2 * NP_GLA;
        if (slot < 2 * NP_GDN) gdn_scan<NP_GDN>(a, lds, xcd * 2 + slot / NP_GDN, slot % NP_GDN, tid);
        else if (slot < NSCAN) { const int s2 = slot - 2 * NP_GDN; gla_scan<NP_GLA>(a, lds, xcd * 2 + s2 / NP_GLA, s2 % NP_GLA, tid); }
        else {
            const int nidle = G - 8 * NSCAN, idx = (slot - NSCAN) * 8 + xcd;
            prologue(a, lds, idx * 8 + wave, nidle * 8, wave, lane, 1);
        }
    } SEAM(6);
    if (IN(7)) { gnorm_phase(MIX, HB, a.in[10], a.in[13], gw, NGW, lane); } SEAM(7);
    if (IN(8)) REPEAT(8) {
        pg8::Gemm g{MIX, (const bf16*)(ws + WS_WOUT), M, D, D}; pg8::StaticOrder S; S.init(M, D, G, bx);
        pg8::EpiRes<true> E{XB, (bf16*)a.out, ALPHA, 1.0f};
        pg8::gemm_phase<pg8::EpiRes<true>, pg8::StaticOrder, true, true>(lds, g, S, E);
    } SEAM(8);
    if (IN(9)) { ln_phase((const bf16*)a.out, nullptr, XB, a.in[15], a.in[16], gw, NGW, lane); } SEAM(9);
    if (IN(10)) {
        pg8::Gemm g{XB, (const bf16*)(ws + WS_WGU2), M, NGU, D}; pg8::StaticOrder S; S.init(M, NGU, G, bx);
        pg8::EpiSwiglu E{HB, FF};
        pg8::gemm_phase<pg8::EpiSwiglu, pg8::StaticOrder, true, true>(lds, g, S, E);
    } SEAM(10);
    if (IN(11)) {
        pg8::Gemm g{HB, (const bf16*)(ws + WS_WD2), M, D, FF}; pg8::StaticOrder S; S.init(M, D, G, bx);
        pg8::EpiRes<true> E{XB, MIX, ALPHA, 0.5f};
        pg8::gemm_phase<pg8::EpiRes<true>, pg8::StaticOrder, true, true>(lds, g, S, E);
    } SEAM(11);
    if (IN(12)) { ln_phase(MIX, a.out, nullptr, a.in[20], a.in[21], gw, NGW, lane); }
    if (a.coop == 1) for (int i_ = 0; i_ < XREP_SYNC; ++i_) xcd_barrier(bar);
    if (PROBE_MASK && bx == 0) {
        asm volatile("s_waitcnt vmcnt(0)" ::: "memory"); __syncthreads();
        if (tid == 0) TS[13] = __builtin_amdgcn_s_memrealtime();
        __syncthreads();
        unsigned long long tot = 0;
        for (int k = 0; k < 13; ++k) if ((PROBE_MASK >> k) & 1) tot += __hip_atomic_load(&TS[k + 1], __ATOMIC_RELAXED, __HIP_MEMORY_SCOPE_AGENT) - __hip_atomic_load(&TS[k], __ATOMIC_RELAXED, __HIP_MEMORY_SCOPE_AGENT);
        for (int k = 0; k < 16; ++k) if ((PROBE_MASK >> (13 + k)) & 1) tot += __hip_atomic_load(&TS[32 + k], __ATOMIC_RELAXED, __HIP_MEMORY_SCOPE_AGENT);
        int T = (int)(tot / PROBE_DIV); if (T > 8192) T = 8192;
        for (int i = tid; i < T; i += 512) a.out[i] += 0.1f;
    }
#undef IN
#undef SEAM
}

constexpr int NPHASE = 13;
#ifndef MK_MULTI
#define MK_MULTI 0
#endif
extern "C" void kernel_launch(void* const* d_in, const int* in_sizes, int n_in, void* d_out, int out_size, void* d_ws, size_t ws_size, hipStream_t stream) {
    static int grid = 0;
    if (grid == 0) {
        if (n_in != 22 || out_size != M * D || ws_size < WS_END) { fprintf(stderr, "kernel_launch: unexpected shapes (n_in %d out %d ws %zu)\n", n_in, out_size, ws_size); grid = -1; return; }
        int dev = 0, cus = 0, per_cu = 0;
        hipGetDevice(&dev); hipDeviceGetAttribute(&cus, hipDeviceAttributeMultiprocessorCount, dev);
        if (hipFuncSetAttribute((const void*)fwd_kernel, hipFuncAttributeMaxDynamicSharedMemorySize, LDS_BYTES) != hipSuccess) { fprintf(stderr, "kernel_launch: hipFuncSetAttribute failed\n"); grid = -1; return; }
        hipOccupancyMaxActiveBlocksPerMultiprocessor(&per_cu, (const void*)fwd_kernel, 512, LDS_BYTES);
        (void)hipGetLastError();
        if (per_cu < 1) per_cu = 1;
        grid = cus * 1;
        fprintf(stderr, "kernel_launch: cus %d per_cu %d grid %d\n", cus, per_cu, grid);
    }
    if (grid < 0) return;
    Args a{};
    for (int i = 0; i < 22; ++i) a.in[i] = (const float*)d_in[i];
    a.out = (float*)d_out; a.ws = (unsigned char*)d_ws; a.pad = XREP_N;
#if MK_MULTI
    for (int p = 0; p < NPHASE; ++p) { a.ph_lo = p; a.ph_hi = p + 1; a.coop = 0; hipLaunchKernelGGL(fwd_kernel, dim3(grid), dim3(512), LDS_BYTES, stream, a); }
#else
    if (hipMemsetAsync(d_ws, 0, 65536, stream) != hipSuccess) { fprintf(stderr, "kernel_launch: memset failed\n"); return; }
    a.ph_lo = 0; a.ph_hi = NPHASE; a.coop = 1;
    void* args[] = {&a};
    hipError_t e = hipLaunchCooperativeKernel((const void*)fwd_kernel, dim3(grid), dim3(512), args, LDS_BYTES, stream);
    if (e != hipSuccess) fprintf(stderr, "cooperative launch failed: %s (grid %d)\n", hipGetErrorString(e), grid);
#endif
}
```

```cpp
#include <hip/hip_runtime.h>
#include <hip/hip_cooperative_groups.h>
#include <cstdio>
#include <cstdint>
namespace cg = cooperative_groups;
#define LAS __attribute__((address_space(3)))
namespace pg8 {
#define PG8_LAS __attribute__((address_space(3)))
typedef unsigned short bf16_t;
typedef short bf16x8 __attribute__((ext_vector_type(8)));
typedef float f32x4 __attribute__((ext_vector_type(4)));
typedef unsigned u32x4 __attribute__((ext_vector_type(4)));
constexpr int BM = 256, BK = 64, HALF = 128, HTB = HALF * BK * 2  , STAGE_BYTES = 8 * HTB, NXCD = 8, WGM = 8;

__host__ __device__ __forceinline__ int lds_byte(int r, int c) { const int st = (r >> 4) * 2 + (c >> 5), rr = r & 15, cc = c & 31, ob = rr * 64 + cc * 2; return st * 1024 + (ob ^ (((ob >> 9) & 1) << 5)); }
__host__ __device__ __forceinline__ void stage_rc(int b, int& R, int& C) { const int st = b / 1024, sb = b % 1024, swz = sb ^ (((sb >> 9) & 1) << 5); R = (st >> 1) * 16 + swz / 64; C = (st & 1) * 32 + (swz % 64) / 2; }
__host__ __device__ __forceinline__ int perm32(int rho) { const int n = rho >> 4, i = rho & 15; return 8 * (i >> 2) + 4 * n + (i & 3); }

struct Unit { int pm, pn; };
struct Gemm { const bf16_t* A; const bf16_t* Bt; int M, N, K; };

struct StaticOrder {
    int nM, nN, nwg, G, c;
    __host__ __device__ void init(int M, int N, int G_, int c_) { nM = M / BM; nN = N / BM; nwg = nM * nN; G = G_; c = c_; }
    __host__ __device__ bool next(int i, Unit& u) const {
        const long L = (long)i * G + c; if (L >= nwg) return false;
        int wgid = (int)L; { const int q = nwg / NXCD, r = nwg % NXCD, xcd = wgid % NXCD, off = wgid / NXCD; wgid = (xcd < r ? xcd * (q + 1) : r * (q + 1) + (xcd - r) * q) + off; }
        const int nig = WGM * nN, gid = wgid / nig, fm = gid * WGM, gsz = (nM - fm) < WGM ? (nM - fm) : WGM;
        u.pm = fm + ((wgid % nig) % gsz); u.pn = (wgid % nig) / gsz; return true;
    }
    __device__ __forceinline__ void a_ready(const Unit&) const {}
    __device__ __forceinline__ void done(const Unit&) const {}
};

__device__ __forceinline__ unsigned cvt_pk_bf16(float lo, float hi) { unsigned r; asm volatile("v_cvt_pk_bf16_f32 %0, %1, %2" : "=v"(r) : "v"(lo), "v"(hi)); return r; }
typedef float f32x2 __attribute__((ext_vector_type(2)));
template <class Epi, class Sched, bool ALIGN_EPI = false, bool SP2 = false>
__device__ __forceinline__ void gemm_phase(PG8_LAS unsigned char* lds, const Gemm g, const Sched& S, const Epi& E) {
    const int tid = threadIdx.x, wid = __builtin_amdgcn_readfirstlane(tid >> 6), lane = tid & 63, wr = wid >> 2, wc = wid & 3, fr = lane & 15, fq = lane >> 4;
    const int K = g.K, nt = K / BK;
    unsigned voffA[2], voffB[2];
#pragma unroll
    for (int i = 0; i < 2; ++i) { int R, C; stage_rc(tid * 16 + i * 8192, R, C); const int Rb = Epi::PERM ? ((R & ~31) + perm32(R & 31)) : R;
        voffA[i] = (unsigned)(R * K + C) * 2u; voffB[i] = (unsigned)(Rb * K + C) * 2u; }
    const size_t kstep = (size_t)(BK * 2);
    const size_t hstep = (size_t)HALF * K * 2;
    const size_t tstep = 2 * hstep;
    const unsigned ldsw = (unsigned)wid * 1024u;
    const int aoff = lds_byte(wr * 64 + fr, fq * 8), boff = lds_byte(wc * 32 + fr, fq * 8);
#define PG8_SA(b, h) (((b) * 2 + (h)) * HTB)
#define PG8_SB(b, h) ((4 + (b) * 2 + (h)) * HTB)
#define PG8_STAGE(bufoff, gbase, voff) do { _Pragma("unroll") for (int _i = 0; _i < 2; ++_i) \
        __builtin_amdgcn_global_load_lds((const unsigned*)((const char*)(gbase) + (voff)[_i]), (PG8_LAS unsigned*)(lds + (bufoff) + ldsw + _i * 8192), 16, 0, 0); } while (0)
#define PG8_LDA(dst, b, h) do { _Pragma("unroll") for (int m = 0; m < 4; ++m) _Pragma("unroll") for (int k = 0; k < 2; ++k) dst[m][k] = *(const PG8_LAS bf16x8*)(lds + PG8_SA(b, h) + aoff + m * 2048 + k * 1024); } while (0)
#define PG8_LDB(dst, b, h) do { _Pragma("unroll") for (int n = 0; n < 2; ++n) _Pragma("unroll") for (int k = 0; k < 2; ++k) dst[n][k] = *(const PG8_LAS bf16x8*)(lds + PG8_SB(b, h) + boff + n * 2048 + k * 1024); } while (0)
#define PG8_MMA(ai, bj, At, Bt) do { __builtin_amdgcn_s_setprio(1); _Pragma("unroll") for (int m = 0; m < 4; ++m) _Pragma("unroll") for (int n = 0; n < 2; ++n) _Pragma("unroll") for (int k = 0; k < 2; ++k) \
        acc[ai][bj][m][n] = __builtin_amdgcn_mfma_f32_16x16x32_bf16(Bt[n][k], At[m][k], acc[ai][bj][m][n], 0, 0, 0); __builtin_amdgcn_s_setprio(0); } while (0)
#define PG8_WAIT_V(n) asm volatile("s_waitcnt vmcnt(" #n ")" ::: "memory")
#define PG8_WAIT_L(n) asm volatile("s_waitcnt lgkmcnt(" #n ")" ::: "memory")
#define PG8_BAR __builtin_amdgcn_s_barrier()
#define PG8_SCHED __builtin_amdgcn_sched_barrier(0)
    Unit cur, nxt; int ui = 0;
    if (!S.next(0, cur)) return;
    f32x4 acc[2][2][4][2];
#pragma unroll
    for (int a = 0; a < 2; ++a)
#pragma unroll
        for (int b = 0; b < 2; ++b)
#pragma unroll
            for (int m = 0; m < 4; ++m)
#pragma unroll
                for (int n = 0; n < 2; ++n) acc[a][b][m][n] = (f32x4){0.f, 0.f, 0.f, 0.f};
    bf16x8 At[4][2], B0[2][2], B1[2][2];
    const char* cA = (const char*)g.A + (size_t)cur.pm * tstep; const char* cB = (const char*)g.Bt + (size_t)cur.pn * tstep;
    S.a_ready(cur);
    if constexpr (SP2) {
        PG8_STAGE(PG8_SB(0, 0), cB, voffB); PG8_STAGE(PG8_SB(0, 1), cB + hstep, voffB); PG8_STAGE(PG8_SA(0, 0), cA, voffA); PG8_STAGE(PG8_SA(0, 1), cA + hstep, voffA);
        if (wr == 1) PG8_BAR;
        PG8_WAIT_V(2); PG8_BAR;
        PG8_STAGE(PG8_SB(1, 0), cB + kstep, voffB); PG8_STAGE(PG8_SA(1, 0), cA + kstep, voffA); PG8_STAGE(PG8_SB(1, 1), cB + hstep + kstep, voffB);
        PG8_WAIT_V(6); PG8_BAR;
    } else {
        PG8_STAGE(PG8_SB(0, 0), cB, voffB); PG8_STAGE(PG8_SA(0, 0), cA, voffA); PG8_STAGE(PG8_SB(0, 1), cB + hstep, voffB); PG8_STAGE(PG8_SA(0, 1), cA + hstep, voffA);
        if (wr == 1) PG8_BAR;
        PG8_WAIT_V(4); PG8_BAR;
        PG8_STAGE(PG8_SB(1, 0), cB + kstep, voffB); PG8_STAGE(PG8_SA(1, 0), cA + kstep, voffA); PG8_STAGE(PG8_SB(1, 1), cB + hstep + kstep, voffB);
        PG8_WAIT_V(6); PG8_BAR;
    }
    for (;;) {
        const bool has_next = S.next(ui + 1, nxt);
        const char* nA = has_next ? (const char*)g.A + (size_t)nxt.pm * tstep : cA; const char* nB = has_next ? (const char*)g.Bt + (size_t)nxt.pn * tstep : cB;
        for (int t = 0; t < nt; t += 2) {
            const bool last = (t == nt - 2);
            const char* a1 = cA + (size_t)(t + 1) * kstep;
            const char* a2 = last ? nA : cA + (size_t)(t + 2) * kstep; const char* b2 = last ? nB : cB + (size_t)(t + 2) * kstep;
            const char* a3 = a2 + kstep; const char* b3 = b2 + kstep;
            if (last && has_next) S.a_ready(nxt);
            if constexpr (SP2) {
            PG8_LDB(B0, 0, 0); PG8_LDB(B1, 0, 1); PG8_SCHED; PG8_LDA(At, 0, 0); PG8_STAGE(PG8_SA(1, 1), a1 + hstep, voffA);
            PG8_WAIT_V(8); PG8_WAIT_L(0); PG8_BAR; PG8_MMA(0, 0, At, B0); PG8_MMA(0, 1, At, B1); PG8_BAR; PG8_SCHED;
            PG8_LDA(At, 0, 1); PG8_STAGE(PG8_SB(0, 0), b2, voffB); PG8_STAGE(PG8_SB(0, 1), b2 + hstep, voffB); PG8_STAGE(PG8_SA(0, 0), a2, voffA);
            PG8_WAIT_V(8); PG8_WAIT_L(0); PG8_BAR; PG8_MMA(1, 0, At, B0); PG8_MMA(1, 1, At, B1); PG8_BAR; PG8_SCHED;
            PG8_LDB(B0, 1, 0); PG8_LDB(B1, 1, 1); PG8_SCHED; PG8_LDA(At, 1, 0); PG8_STAGE(PG8_SA(0, 1), a2 + hstep, voffA);
            PG8_WAIT_V(8); PG8_WAIT_L(0); PG8_BAR; PG8_MMA(0, 0, At, B0); PG8_MMA(0, 1, At, B1); PG8_BAR; PG8_SCHED;
            PG8_LDA(At, 1, 1); PG8_STAGE(PG8_SB(1, 0), b3, voffB); PG8_STAGE(PG8_SB(1, 1), b3 + hstep, voffB); PG8_STAGE(PG8_SA(1, 0), a3, voffA);
            PG8_WAIT_V(8); PG8_WAIT_L(0); PG8_BAR; PG8_MMA(1, 0, At, B0); PG8_MMA(1, 1, At, B1); PG8_BAR; PG8_SCHED;
            } else {
            PG8_LDB(B0, 0, 0); PG8_SCHED; PG8_LDA(At, 0, 0); PG8_STAGE(PG8_SA(1, 1), a1 + hstep, voffA);
            PG8_WAIT_L(8); PG8_BAR; PG8_WAIT_L(0); PG8_MMA(0, 0, At, B0); PG8_BAR; PG8_SCHED;
            PG8_LDB(B1, 0, 1); PG8_STAGE(PG8_SB(0, 0), b2, voffB);
            PG8_BAR; PG8_WAIT_L(0); PG8_MMA(0, 1, At, B1); PG8_BAR;
            PG8_LDA(At, 0, 1); PG8_STAGE(PG8_SA(0, 0), a2, voffA);
            PG8_BAR; PG8_WAIT_L(0); PG8_MMA(1, 0, At, B0); PG8_BAR; PG8_SCHED;
            PG8_STAGE(PG8_SB(0, 1), b2 + hstep, voffB);
            PG8_WAIT_V(6); PG8_BAR; PG8_MMA(1, 1, At, B1); PG8_BAR;
            PG8_LDB(B0, 1, 0); PG8_SCHED; PG8_LDA(At, 1, 0); PG8_STAGE(PG8_SA(0, 1), a2 + hstep, voffA);
            PG8_WAIT_L(8); PG8_BAR; PG8_WAIT_L(0); PG8_MMA(0, 0, At, B0); PG8_BAR; PG8_SCHED;
            PG8_LDB(B1, 1, 1); PG8_STAGE(PG8_SB(1, 0), b3, voffB);
            PG8_BAR; PG8_WAIT_L(0); PG8_MMA(0, 1, At, B1); PG8_BAR;
            PG8_LDA(At, 1, 1); PG8_STAGE(PG8_SA(1, 0), a3, voffA);
            PG8_BAR; PG8_WAIT_L(0); PG8_MMA(1, 0, At, B0); PG8_BAR; PG8_SCHED;
            PG8_STAGE(PG8_SB(1, 1), b3 + hstep, voffB);
            PG8_WAIT_V(6); PG8_BAR; PG8_MMA(1, 1, At, B1); PG8_BAR;
            }
        }
        if constexpr (ALIGN_EPI) { if (wr == 0) PG8_BAR; }
        if constexpr (!Epi::AFTER_DRAIN) { E(acc, cur, wr, wc, fr, fq); S.done(cur); }
        if (!has_next) break;
#pragma unroll
        for (int a = 0; a < 2; ++a)
#pragma unroll
            for (int b = 0; b < 2; ++b)
#pragma unroll
                for (int m = 0; m < 4; ++m)
#pragma unroll
                    for (int n = 0; n < 2; ++n) acc[a][b][m][n] = (f32x4){0.f, 0.f, 0.f, 0.f};
        cur = nxt; cA = nA; cB = nB; ++ui;
        if constexpr (ALIGN_EPI) { if (wr == 1) PG8_BAR; }
    }
    PG8_WAIT_V(0);
    if constexpr (!ALIGN_EPI) { if (wr == 0) PG8_BAR; }
    PG8_BAR;
    if constexpr (Epi::AFTER_DRAIN) { E.fused(acc, cur, wr, wc, fr, fq, lds, wid, lane); S.done(cur); }
#undef PG8_SA
#undef PG8_SB
#undef PG8_STAGE
#undef PG8_LDA
#undef PG8_LDB
#undef PG8_MMA
#undef PG8_WAIT_V
#undef PG8_WAIT_L
#undef PG8_BAR
#undef PG8_SCHED
}
}

namespace pg8 {
__device__ __forceinline__ float silu_f(float x) { return x * __builtin_amdgcn_rcpf(1.0f + __expf(-x)); }
__device__ __forceinline__ float bflo_f(unsigned u) { return __uint_as_float(u << 16); }
__device__ __forceinline__ float bfhi_f(unsigned u) { return __uint_as_float(u & 0xffff0000u); }

struct EpiSwiglu {
    static constexpr bool PERM = true, AFTER_DRAIN = false;
    bf16_t* O; int ldc;
    __device__ __forceinline__ void operator()(const f32x4 (&acc)[2][2][4][2], const Unit& u, int wr, int wc, int fr, int fq) const {
        const int row0 = u.pm * BM + wr * 64 + fr, col0 = u.pn * HALF + wc * 32 + 8 * fq;
#pragma unroll
        for (int ai = 0; ai < 2; ++ai)
#pragma unroll
            for (int m = 0; m < 4; ++m) {
                bf16_t* rowp = O + (size_t)(row0 + ai * HALF + m * 16) * ldc + col0;
                const f32x4 g0 = acc[ai][0][m][0], g1 = acc[ai][0][m][1], u0 = acc[ai][1][m][0], u1 = acc[ai][1][m][1];
                u32x4 w;
                w.x = cvt_pk_bf16(silu_f(g0[0]) * u0[0], silu_f(g0[1]) * u0[1]);
                w.y = cvt_pk_bf16(silu_f(g0[2]) * u0[2], silu_f(g0[3]) * u0[3]);
                w.z = cvt_pk_bf16(silu_f(g1[0]) * u1[0], silu_f(g1[1]) * u1[1]);
                w.w = cvt_pk_bf16(silu_f(g1[2]) * u1[2], silu_f(g1[3]) * u1[3]);
                *(u32x4*)rowp = w;
            }
    }
};

template <bool RES_BF16> struct EpiRes {
    static constexpr bool PERM = true, AFTER_DRAIN = false;
    const void* res; bf16_t* out; float alpha, scale;
    __device__ __forceinline__ void operator()(const f32x4 (&acc)[2][2][4][2], const Unit& u, int wr, int wc, int fr, int fq) const {
#pragma unroll
        for (int ai = 0; ai < 2; ++ai)
#pragma unroll
            for (int m = 0; m < 4; ++m) {
                const int row = u.pm * BM + wr * 64 + fr + ai * HALF + m * 16;
#pragma unroll
                for (int bj = 0; bj < 2; ++bj) {
                    const int col = u.pn * BM + bj * HALF + wc * 32 + 8 * fq; const size_t off = (size_t)row * 1024 + col;
                    f32x4 r0, r1;
                    if (RES_BF16) { const u32x4 rw = *(const u32x4*)((const bf16_t*)res + off);
                        r0 = (f32x4){bflo_f(rw.x), bfhi_f(rw.x), bflo_f(rw.y), bfhi_f(rw.y)}; r1 = (f32x4){bflo_f(rw.z), bfhi_f(rw.z), bflo_f(rw.w), bfhi_f(rw.w)}; }
                    else { r0 = *(const f32x4*)((const float*)res + off); r1 = *(const f32x4*)((const float*)res + off + 4); }
                    const f32x4 o0 = r0 * alpha + acc[ai][bj][m][0] * scale, o1 = r1 * alpha + acc[ai][bj][m][1] * scale;
                    u32x4 w; w.x = cvt_pk_bf16(o0[0], o0[1]); w.y = cvt_pk_bf16(o0[2], o0[3]); w.z = cvt_pk_bf16(o1[0], o1[1]); w.w = cvt_pk_bf16(o1[2], o1[3]);
                    *(u32x4*)(out + off) = w;
                }
            }
    }
};

struct EpiProj {
    static constexpr bool PERM = true, AFTER_DRAIN = false;
    bf16_t* P; float* SM;
    __device__ __forceinline__ void operator()(const f32x4 (&acc)[2][2][4][2], const Unit& u, int wr, int wc, int fr, int fq) const {
        const int row0 = u.pm * BM + wr * 64 + fr;
        if (u.pn < 14) {
            const int col0 = u.pn * BM + wc * 32 + 8 * fq;
#pragma unroll
            for (int ai = 0; ai < 2; ++ai)
#pragma unroll
                for (int m = 0; m < 4; ++m) { bf16_t* rowp = P + (size_t)(row0 + ai * HALF + m * 16) * 3584 + col0;
#pragma unroll
                    for (int bj = 0; bj < 2; ++bj) { const f32x4 v0 = acc[ai][bj][m][0], v1 = acc[ai][bj][m][1];
                        u32x4 w; w.x = cvt_pk_bf16(v0[0], v0[1]); w.y = cvt_pk_bf16(v0[2], v0[3]); w.z = cvt_pk_bf16(v1[0], v1[1]); w.w = cvt_pk_bf16(v1[2], v1[3]);
                        *(u32x4*)(rowp + bj * HALF) = w; } }
        } else if (wc == 0) {
#pragma unroll
            for (int ai = 0; ai < 2; ++ai)
#pragma unroll
                for (int m = 0; m < 4; ++m) { float* rowp = SM + (size_t)(row0 + ai * HALF + m * 16) * 32 + 8 * fq;
                    *(f32x4*)rowp = acc[ai][0][m][0]; *(f32x4*)(rowp + 4) = acc[ai][0][m][1]; }
        }
    }
};
}
#define XB_TMO      128
#define XB_XCNT(j)  (256  + 64 * (j))
#define XB_XSUB(j)  (1280 + 64 * (j))
#define XB_XGEN(j)  (2304 + 64 * (j))
#define XB_TOP      3328
#define XB_TOPGEN   3392
#define XCD_BAR_WORDS 3456
#define XB_SPIN_CAP (1u << 18)

__device__ __forceinline__ unsigned xb_ld(unsigned* p)              { return __hip_atomic_load(p, __ATOMIC_RELAXED, __HIP_MEMORY_SCOPE_AGENT); }
__device__ __forceinline__ unsigned xb_add(unsigned* p, unsigned v) { return __hip_atomic_fetch_add(p, v, __ATOMIC_RELAXED, __HIP_MEMORY_SCOPE_AGENT); }
__device__ __forceinline__ unsigned xb_xcc_id() { return (unsigned)__builtin_amdgcn_s_getreg((3 << 11) | 20) & 0xFu; }
#define XB_SPIN(cond, bar) do { unsigned _sp = 0; while (cond) { __builtin_amdgcn_s_sleep(1); \
    if ((++_sp & 255u) == 0u) { if (xb_ld(&(bar)[XB_TMO])) break; if (_sp > XB_SPIN_CAP) { atomicAdd(&(bar)[XB_TMO], 1u); break; } } } } while (0)

struct XcdBarrier {
    unsigned* bar; unsigned x;
    volatile LAS unsigned* st;
};

__device__ __forceinline__ XcdBarrier xcd_barrier_post(unsigned* bar, volatile LAS unsigned* st) {
    XcdBarrier b; b.bar = bar; b.x = xb_xcc_id(); b.st = st;
    if (threadIdx.x == 0) (void)xb_add(&bar[XB_XCNT(b.x)], 1u);
    return b;
}
__device__ __forceinline__ void xcd_barrier_complete(unsigned* bar, unsigned x, unsigned& nloc, unsigned& nx) {
    const unsigned G = gridDim.x * gridDim.y * gridDim.z;
    unsigned sum, cnt, mine, sp = 0u;
    for (;;) {
        sum = 0u; cnt = 0u; mine = 0u;
#pragma unroll
        for (unsigned j = 0; j < 16; ++j) { const unsigned c = xb_ld(&bar[XB_XCNT(j)]); sum += c; cnt += (c > 0u) ? 1u : 0u; mine = (j == x) ? c : mine; }
        if (sum == G) break;
        __builtin_amdgcn_s_sleep(1);
        if ((++sp & 255u) == 0u) { if (xb_ld(&bar[XB_TMO])) break; if (sp > XB_SPIN_CAP) { atomicAdd(&bar[XB_TMO], 1u); break; } }
    }
    nloc = mine > 0u ? mine : 1u; nx = cnt > 0u ? cnt : 1u;
}

__device__ __forceinline__ void xcd_barrier(const XcdBarrier& b) {
    asm volatile("s_waitcnt vmcnt(0)" ::: "memory");
    __syncthreads();
    if (threadIdx.x == 0) {
        unsigned* bar = b.bar;
        __builtin_amdgcn_s_waitcnt(0);
        unsigned nloc = b.st[0], nx = b.st[1];
        if (nloc == 0u) { xcd_barrier_complete(bar, b.x, nloc, nx); b.st[0] = nloc; b.st[1] = nx; }
        const unsigned old = xb_add(&bar[XB_XSUB(b.x)], 1u);
        const unsigned gen = old / nloc;
        if (old + 1u == (gen + 1u) * nloc) {
            __builtin_amdgcn_fence(__ATOMIC_RELEASE, "agent");
            asm volatile("s_waitcnt vmcnt(0)" ::: "memory");
            const unsigned og = xb_add(&bar[XB_TOP], 1u);
            const unsigned tg = og / nx;
            if (og + 1u == (tg + 1u) * nx) xb_add(&bar[XB_TOPGEN], 1u);
            else XB_SPIN(xb_ld(&bar[XB_TOPGEN]) == tg, bar);
            __builtin_amdgcn_fence(__ATOMIC_ACQUIRE, "agent");
            xb_add(&bar[XB_XGEN(b.x)], 1u);
            asm volatile("s_waitcnt vmcnt(0)" ::: "memory");
        } else {
            XB_SPIN(xb_ld(&bar[XB_XGEN(b.x)]) == gen, bar);
            __builtin_amdgcn_fence(__ATOMIC_ACQUIRE, "agent");
            asm volatile("s_waitcnt vmcnt(0)" ::: "memory");
        }
    }
    __syncthreads();
}

typedef unsigned short bf16;
typedef unsigned u32x4 __attribute__((ext_vector_type(4)));
typedef unsigned u32x2 __attribute__((ext_vector_type(2)));
typedef float f32x4 __attribute__((ext_vector_type(4)));
typedef short bf16x8 __attribute__((ext_vector_type(8)));
typedef float f32x2_t __attribute__((ext_vector_type(2)));
typedef __bf16 bf16x2_t __attribute__((ext_vector_type(2)));

constexpr int M = 32768, D = 1024, FF = 2816, NGU = 2 * FF, NPROJ = 3840, PW = 3584, SEQ = 8192, NCHK = 128, NCH = 2048;
constexpr int WIN_N = 3608;
constexpr float ALPHA = 1.189207115002721f;
constexpr float LN_EPS = 1e-5f, RMS_EPS = 1e-6f;
constexpr size_t MiB = 1u << 20;
constexpr size_t WS_WGU1 = 1 * MiB, WS_WD1 = 12 * MiB, WS_WIN = 18 * MiB, WS_WOUT = 26 * MiB, WS_WGU2 = 28 * MiB, WS_WD2 = 39 * MiB, WS_SMALL = 45 * MiB;
constexpr size_t WS_HP = 49 * MiB;
constexpr size_t WS_XB = 273 * MiB;
constexpr size_t WS_MIX = 337 * MiB;
constexpr size_t WS_DW = 401 * MiB, WS_DQ = 433 * MiB, WS_DK = 465 * MiB, WS_GE = 497 * MiB, WS_DGL = 498 * MiB, WS_END = 512 * MiB;
constexpr size_t OS_DU = 0, OS_GQ = 32 * MiB, OS_GA = 48 * MiB, OS_GK = 64 * MiB, OS_GV = 80 * MiB, OS_DQK = 112 * MiB;
constexpr int LDS_BYTES = 147456;
constexpr int NP_GDN = 8, NP_GLA = 4, NSL = 1;

__device__ __forceinline__ unsigned pk2(float lo, float hi) { f32x2_t v = {lo, hi}; bf16x2_t b = __builtin_convertvector(v, bf16x2_t); return __builtin_bit_cast(unsigned, b); }
__device__ __forceinline__ unsigned short f2bf(float f) { return (unsigned short)(pk2(f, 0.f) & 0xffffu); }
__device__ __forceinline__ float bf2f(unsigned short h) { return __uint_as_float((unsigned)h << 16); }
__device__ __forceinline__ float bflo(unsigned u) { return __uint_as_float(u << 16); }
__device__ __forceinline__ float bfhi(unsigned u) { return __uint_as_float(u & 0xffff0000u); }
__device__ __forceinline__ float silu(float x) { return x * __builtin_amdgcn_rcpf(1.0f + __expf(-x)); }
__device__ __forceinline__ int kperm(int a) { return (a & ~31) | (((a >> 2) & 3) << 3) | (((a >> 4) & 1) << 2) | (a & 3); }
__device__ __forceinline__ float wave_sum(float v) {
#pragma unroll
    for (int o = 1; o < 64; o <<= 1) v += __shfl_xor(v, o);
    return v;
}
template <class T> __device__ __forceinline__ T opaque_v(T p) { asm volatile("" : "+v"(p)); return p; }
#define WG_BAR() do { asm volatile("s_waitcnt lgkmcnt(0)" ::: "memory"); __builtin_amdgcn_s_barrier(); asm volatile("" ::: "memory"); } while (0)
#define MFMA16(a, b, c) __builtin_amdgcn_mfma_f32_16x16x32_bf16((a), (b), (c), 0, 0, 0)
__device__ __forceinline__ bf16x8 pack8(const f32x4& lo, const f32x4& hi) {
    u32x4 p; p.x = pk2(lo[0], lo[1]); p.y = pk2(lo[2], lo[3]); p.z = pk2(hi[0], hi[1]); p.w = pk2(hi[2], hi[3]); return __builtin_bit_cast(bf16x8, p);
}

#ifndef XREP_PHASE
#define XREP_PHASE -1
#define XREP_N 1
#define XREP_SYNC 0
#endif
struct Args { const float* in[22]; float* out; unsigned char* ws; int ph_lo, ph_hi, coop, pad; };

struct ColGU { const float* g; const float* u; __device__ __forceinline__ const float* operator()(int d) const { const int t = d >> 8, w = d & 255;
    const uintptr_t gp = (uintptr_t)g, up = (uintptr_t)u; const uintptr_t base = gp + (uintptr_t)((w >> 7) & 1) * (up - gp); return (const float*)base + t * 128 + (w & 127); } };
struct ColPlain { const float* w; __device__ __forceinline__ const float* operator()(int d) const { return w + d; } };
struct ColWin { const float* w; __device__ __forceinline__ const float* operator()(int d) const {
    if (d < 2048) return w + d; if (d < 3584) return w + d + 8; if (d < 3592) return w + d - 1536; if (d < 3608) return w + d; return nullptr; } };

template <class ColPtr>
__device__ __forceinline__ void transpose_item(const ColPtr& cp, int nsrc, int K, bf16* WT, LAS float* scr, int kb, int nb, int lane) {
    const int k0 = 64 * kb, n0 = 32 * nb;
    const float* colp = cp(n0 + (lane & 31));
    float tv[32];
#pragma unroll
    for (int i = 0; i < 32; ++i) { const int kk = 2 * i + (lane >> 5); tv[i] = colp ? colp[(size_t)(k0 + kk) * nsrc] : 0.f; }
#pragma unroll
    for (int i = 0; i < 32; ++i) { const int kk = 2 * i + (lane >> 5); scr[kk * 33 + (lane & 31)] = tv[i]; }
    asm volatile("s_waitcnt lgkmcnt(0)" ::: "memory");
    const int c = lane & 7;
#pragma unroll
    for (int j = 0; j < 4; ++j) { const int n = (lane >> 3) + 8 * j; const LAS float* s = scr + (8 * c) * 33 + n;
        u32x4 o; o.x = pk2(s[0 * 33], s[1 * 33]); o.y = pk2(s[2 * 33], s[3 * 33]); o.z = pk2(s[4 * 33], s[5 * 33]); o.w = pk2(s[6 * 33], s[7 * 33]);
        *(u32x4*)(WT + (size_t)(n0 + n) * K + k0 + 8 * c) = o; }
    asm volatile("s_waitcnt lgkmcnt(0)" ::: "memory");
}

__device__ __forceinline__ void prologue(const Args& a, LAS unsigned char* lds, int gw, int NGW, int wave, int lane, int part) {
    unsigned char* ws = a.ws;
    LAS float* scr = (LAS float*)(lds + wave * 16384);
    constexpr int I_GU = 16 * (NGU / 32), I_D = (FF / 64) * (D / 32), I_IN = 16 * (NPROJ / 32), I_O = 16 * (D / 32);
    if (part == 0) {
        constexpr int NITEMS = I_GU + I_D + I_IN;
        for (int it = gw; it < NITEMS; it += NGW) {
            int r = it;
            if (r < I_GU) { ColGU c{a.in[1], a.in[2]}; transpose_item(c, FF, D, (bf16*)(ws + WS_WGU1), scr, r / (NGU / 32), r % (NGU / 32), lane); continue; } r -= I_GU;
            if (r < I_D) { ColPlain c{a.in[3]}; transpose_item(c, D, FF, (bf16*)(ws + WS_WD1), scr, r / (D / 32), r % (D / 32), lane); continue; } r -= I_D;
            { ColWin c{a.in[6]}; transpose_item(c, WIN_N, D, (bf16*)(ws + WS_WIN), scr, r / (NPROJ / 32), r % (NPROJ / 32), lane); }
        }
    } else {
        constexpr int NITEMS = I_GU + I_D + I_O;
        for (int it = gw; it < NITEMS; it += NGW) {
            int r = it;
            if (r < I_GU) { ColGU c{a.in[17], a.in[18]}; transpose_item(c, FF, D, (bf16*)(ws + WS_WGU2), scr, r / (NGU / 32), r % (NGU / 32), lane); continue; } r -= I_GU;
            if (r < I_D) { ColPlain c{a.in[19]}; transpose_item(c, D, FF, (bf16*)(ws + WS_WD2), scr, r / (D / 32), r % (D / 32), lane); continue; } r -= I_D;
            { ColPlain c{a.in[14]}; transpose_item(c, D, D, (bf16*)(ws + WS_WOUT), scr, r / (D / 32), r % (D / 32), lane); }
        }
        return;
    }
    const float* x = a.in[0]; bf16* xb = (bf16*)(ws + WS_XB);
    const size_t nthr = (size_t)NGW * 64, t0 = (size_t)gw * 64 + lane;
    for (size_t i = t0; i < (size_t)M * D / 8; i += nthr) {
        const f32x4 v0 = *(const f32x4*)(x + i * 8), v1 = *(const f32x4*)(x + i * 8 + 4);
        u32x4 o; o.x = pk2(v0[0], v0[1]); o.y = pk2(v0[2], v0[3]); o.z = pk2(v1[0], v1[1]); o.w = pk2(v1[2], v1[3]);
        *(u32x4*)(xb + i * 8) = o;
    }
}

__device__ __forceinline__ void ln_phase(const bf16* Y, float* Xf, bf16* Xb, const float* g, const float* b, int gw, int NGW, int lane) {
    float gv[16], bv[16];
#pragma unroll
    for (int j = 0; j < 2; ++j)
#pragma unroll
        for (int e = 0; e < 8; ++e) { gv[8 * j + e] = g[512 * j + 8 * lane + e]; bv[8 * j + e] = b[512 * j + 8 * lane + e]; }
#pragma unroll 2
    for (int m = gw; m < M; m += NGW) {
        const u32x4* yr = (const u32x4*)(Y + (size_t)m * D) + lane;
        const u32x4 y0 = yr[0], y1 = yr[64];
        float v[16]; float s = 0.f;
#pragma unroll
        for (int e = 0; e < 4; ++e) { v[2 * e] = bflo(y0[e]); v[2 * e + 1] = bfhi(y0[e]); v[8 + 2 * e] = bflo(y1[e]); v[9 + 2 * e] = bfhi(y1[e]); }
#pragma unroll
        for (int e = 0; e < 16; ++e) s += v[e];
        const float mean = wave_sum(s) * (1.f / D); float s2 = 0.f;
#pragma unroll
        for (int e = 0; e < 16; ++e) { v[e] -= mean; s2 += v[e] * v[e]; }
        const float rstd = 1.0f / sqrtf(wave_sum(s2) * (1.f / D) + LN_EPS);
#pragma unroll
        for (int e = 0; e < 16; ++e) v[e] = v[e] * rstd * gv[e] + bv[e];
        if (Xf) {
            f32x4* o = (f32x4*)(Xf + (size_t)m * D + 8 * lane);
            o[0] = (f32x4){v[0], v[1], v[2], v[3]}; o[1] = (f32x4){v[4], v[5], v[6], v[7]};
            o[128] = (f32x4){v[8], v[9], v[10], v[11]}; o[129] = (f32x4){v[12], v[13], v[14], v[15]};
        }
        if (Xb) {
            u32x4* o = (u32x4*)(Xb + (size_t)m * D) + lane;
            o[0] = (u32x4){pk2(v[0], v[1]), pk2(v[2], v[3]), pk2(v[4], v[5]), pk2(v[6], v[7])};
            o[64] = (u32x4){pk2(v[8], v[9]), pk2(v[10], v[11]), pk2(v[12], v[13]), pk2(v[14], v[15])};
        }
    }
}

__device__ __forceinline__ void gnorm_phase(bf16* MIX, const bf16* P, const float* wa, const float* wb, int gw, int NGW, int lane) {
    const int hd = lane >> 3, cc = (lane & 7) * 16;
    const float* wn = (hd < 4 ? wa : wb) + cc;
    float wv[16];
#pragma unroll
    for (int j = 0; j < 16; ++j) wv[j] = wn[j];
    const int gcol = (hd < 4 ? 1536 : 3072) + (hd & 3) * 128 + cc;
    for (int m = gw; m < M; m += NGW) {
        bf16* op = MIX + (size_t)m * D + lane * 16;
        const u32x4 o0 = *(const u32x4*)op, o1 = *(const u32x4*)(op + 8);
        const u32x4 g0 = *(const u32x4*)(P + (size_t)m * PW + gcol), g1 = *(const u32x4*)(P + (size_t)m * PW + gcol + 8);
        float o[16], g[16];
#pragma unroll
        for (int j = 0; j < 4; ++j) { o[2 * j] = bflo(o0[j]); o[2 * j + 1] = bfhi(o0[j]); o[8 + 2 * j] = bflo(o1[j]); o[9 + 2 * j] = bfhi(o1[j]);
                                      g[2 * j] = bflo(g0[j]); g[2 * j + 1] = bfhi(g0[j]); g[8 + 2 * j] = bflo(g1[j]); g[9 + 2 * j] = bfhi(g1[j]); }
        float ss = 0.f;
#pragma unroll
        for (int j = 0; j < 16; ++j) ss += o[j] * o[j];
        ss += __shfl_xor(ss, 1); ss += __shfl_xor(ss, 2); ss += __shfl_xor(ss, 4);
        const float rs = 1.0f / sqrtf(ss * (1.f / 128.f) + RMS_EPS);
        u32x4 r0, r1;
#pragma unroll
        for (int j = 0; j < 4; ++j) {
            r0[j] = pk2(o[2 * j] * rs * wv[2 * j] * silu(g[2 * j]), o[2 * j + 1] * rs * wv[2 * j + 1] * silu(g[2 * j + 1]));
            r1[j] = pk2(o[8 + 2 * j] * rs * wv[8 + 2 * j] * silu(g[8 + 2 * j]), o[9 + 2 * j] * rs * wv[9 + 2 * j] * silu(g[9 + 2 * j]));
        }
        *(u32x4*)op = r0; *(u32x4*)(op + 8) = r1;
    }
}

constexpr int PK_KN = 0, PK_QN = 17408, PK_RHS = 34816, PK_QF = 100352, PK_SC = 133120;
#ifndef PROBE_MASK
#define PROBE_MASK 0
#define PROBE_DIV 10
#endif
#define ACC_T0() unsigned long long t0_ = 0; if (PROBE_MASK >> 13) { if (blockIdx.x == 0 && threadIdx.x == 0) t0_ = __builtin_amdgcn_s_memrealtime(); }
#define ACC_ADD(slot) do { if (PROBE_MASK >> 13) { if (blockIdx.x == 0 && threadIdx.x == 0) { const unsigned long long t1_ = __builtin_amdgcn_s_memrealtime(); unsigned long long* A_ = (unsigned long long*)(a.ws + 32768) + 32 + (slot); *A_ += t1_ - t0_; t0_ = t1_; } } } while (0)
struct GdnPf { unsigned x[3][11]; f32x2_t w[3][4]; float s0, s1, dtb, alog; };
__device__ __forceinline__ void gdn_pf_load(GdnPf& f, const Args& a, int item, int tid) {
    const int n = item & 127, bh = item >> 7, h = bh & 3, b = bh >> 2, t0 = b * SEQ + n * 64;
    const int c2 = tid & 63, rg = tid >> 6;
    const bf16* P = (const bf16*)(a.ws + WS_HP);
    const float* cw = a.in[7];
#pragma unroll
    for (int mat = 0; mat < 3; ++mat) {
        const int ch = mat * 512 + h * 128 + 2 * c2;
#pragma unroll
        for (int i = 0; i < 11; ++i) { const int row = rg * 8 - 3 + i; const bool ok = !(n == 0 && row < 0);
            f.x[mat][i] = ok ? *(const unsigned*)(P + (size_t)(t0 + row) * PW + ch) : 0u; }
#pragma unroll
        for (int j = 0; j < 4; ++j) f.w[mat][j] = *(const f32x2_t*)(cw + j * 1536 + ch);
    }
    const float* sm = (const float*)(a.ws + WS_SMALL) + (size_t)(t0 + (tid & 63)) * 32;
    f.s0 = sm[h]; f.s1 = sm[4 + h]; f.dtb = a.in[9][h]; f.alog = a.in[8][h];
}
__device__ __forceinline__ void gdn_prep_item(const Args& a, LAS unsigned char* lds_in, int item, int tid_in, const GdnPf& f) {
    const int tid = opaque_v(tid_in); LAS unsigned char* lds = opaque_v(lds_in);
    const int bh = item >> 7, h = bh & 3;
    const int ci = item;
    const int lane = tid & 63, wid = tid >> 6;
    unsigned char* ws = a.ws;
    LAS float* RHS = opaque_v((LAS float*)(lds + PK_RHS)); LAS float* QF = opaque_v((LAS float*)(lds + PK_QF)); LAS float* AM = QF; LAS float* SC = opaque_v((LAS float*)(lds + PK_SC));
    LAS unsigned char* KNp = opaque_v(lds + PK_KN); LAS unsigned char* QNp = opaque_v(lds + PK_QN);
    bf16* DW = (bf16*)(ws + WS_DW) + (size_t)ci * 8192; bf16* DQ = (bf16*)(ws + WS_DQ) + (size_t)ci * 8192; bf16* DK = (bf16*)(ws + WS_DK) + (size_t)ci * 8192;
    bf16* DQK = (bf16*)((unsigned char*)a.out + OS_DQK) + (size_t)ci * 4096; bf16* DU = (bf16*)((unsigned char*)a.out + OS_DU) + (size_t)ci * 8192;
    float* DGL = (float*)(ws + WS_DGL);
    ACC_T0();
    if (tid < 64) {
        const float be = __builtin_amdgcn_rcpf(1.0f + __expf(-f.s0));
        const float xx = f.s1 + f.dtb;
        const float sp = xx > 20.f ? xx : log1pf(__expf(xx));
        float G = -__expf(f.alog) * sp;
#pragma unroll
        for (int o = 1; o < 64; o <<= 1) { const float t = __shfl_up(G, o); if (lane >= o) G += t; }
        const float Gl = __shfl(G, 63);
        SC[tid] = G; SC[64 + tid] = be; SC[128 + tid] = __expf(G); SC[192 + tid] = __expf(Gl - G);
        if (tid == 63) DGL[ci] = __expf(G);
    }
    {
        const int c2 = tid & 63, rg = tid >> 6;
#pragma unroll
        for (int mat = 0; mat < 3; ++mat) {
            float xa[11], xb[11];
#pragma unroll
            for (int i = 0; i < 11; ++i) { xa[i] = bflo(f.x[mat][i]); xb[i] = bfhi(f.x[mat][i]); }
            LAS float* dstp = (mat == 0 ? QF + rg * 8 * 128 : RHS + rg * 8 * 256 + (mat == 1 ? 128 : 0)) + 2 * c2; const int dstr = mat == 0 ? 128 : 256;
#pragma unroll
            for (int r = 0; r < 8; ++r) {
                const float ya = f.w[mat][0].x * xa[r] + f.w[mat][1].x * xa[r + 1] + f.w[mat][2].x * xa[r + 2] + f.w[mat][3].x * xa[r + 3];
                const float yb = f.w[mat][0].y * xb[r] + f.w[mat][1].y * xb[r + 1] + f.w[mat][2].y * xb[r + 2] + f.w[mat][3].y * xb[r + 3];
                *(LAS f32x2_t*)(dstp + r * dstr) = (f32x2_t){silu(ya), silu(yb)};
            }
        }
    }
    WG_BAR(); ACC_ADD(2);
    {
        const int l5 = tid & 31, rbase = tid >> 5;
        const int g32 = l5 >> 3, hi = (l5 >> 2) & 1, q4 = l5 & 3;
#pragma unroll
        for (int aa = 0; aa < 4; ++aa) {
            const int r = rbase + 16 * aa;
            const float be = SC[64 + r], eg = SC[128 + r];
            f32x4 qv = *(const LAS f32x4*)(QF + r * 128 + 4 * l5), kv = *(const LAS f32x4*)(RHS + r * 256 + 128 + 4 * l5), vv = *(const LAS f32x4*)(RHS + r * 256 + 4 * l5);
            float sq = (qv[0] * qv[0] + qv[1] * qv[1]) + (qv[2] * qv[2] + qv[3] * qv[3]), sk = (kv[0] * kv[0] + kv[1] * kv[1]) + (kv[2] * kv[2] + kv[3] * kv[3]);
#pragma unroll
            for (int o = 1; o < 32; o <<= 1) { sq += __shfl_xor(sq, o); sk += __shfl_xor(sk, o); }
            const float rq = __builtin_amdgcn_rsqf(sq + RMS_EPS) * 0.08838834764831845f, rk = __builtin_amdgcn_rsqf(sk + RMS_EPS);
            qv = qv * rq; kv = kv * rk;
            *(LAS f32x4*)(RHS + r * 256 + 128 + 4 * l5) = kv * (be * eg);
            *(LAS f32x4*)(RHS + r * 256 + 4 * l5) = vv * be;
            u32x2 kw, qw; kw.x = pk2(kv[0], kv[1]); kw.y = pk2(kv[2], kv[3]); qw.x = pk2(qv[0], qv[1]); qw.y = pk2(qv[2], qv[3]);
            *(LAS u32x2*)(KNp + r * 272 + 8 * l5) = kw; *(LAS u32x2*)(QNp + r * 272 + 8 * l5) = qw;
            u32x2 mine; mine.x = pk2(qv[0] * eg, qv[1] * eg); mine.y = pk2(qv[2] * eg, qv[3] * eg);
            u32x2 oth; oth.x = __shfl_xor(mine.x, 4); oth.y = __shfl_xor(mine.y, 4);
            if ((aa >> 1) == hi) { const int rr = r; u32x4 w = hi == 0 ? (u32x4){mine.x, mine.y, oth.x, oth.y} : (u32x4){oth.x, oth.y, mine.x, mine.y};
                *(u32x4*)(DQ + rr * 128 + g32 * 32 + 8 * q4) = w; }
        }
    }
    WG_BAR(); ACC_ADD(3);
    {
        const int cb = wid & 3; const bool isqk = wid >= 4; const int r = lane & 15, q = lane >> 4;
        const LAS unsigned char* Ab = isqk ? QNp : KNp;
        bf16x8 bv[4];
#pragma unroll
        for (int s = 0; s < 4; ++s) bv[s] = *(const LAS bf16x8*)(KNp + (16 * cb + r) * 272 + s * 64 + q * 16);
        const int jj = 16 * cb + r; const float Gj = SC[jj];
#pragma unroll 1
        for (int rb = 0; rb < 4; ++rb) {
            f32x4 acc = (f32x4){0.f, 0.f, 0.f, 0.f};
            if (rb >= cb) {
#pragma unroll
                for (int s = 0; s < 4; ++s) { const bf16x8 av = *(const LAS bf16x8*)(Ab + (16 * rb + r) * 272 + s * 64 + q * 16); acc = MFMA16(av, bv[s], acc); }
            }
#pragma unroll
            for (int i = 0; i < 4; ++i) {
                const int ii = 16 * rb + 4 * q + i; const float d = __expf(fminf(SC[ii] - Gj, 0.f));
                if (isqk) { DQK[ii * 64 + kperm(jj)] = f2bf((jj <= ii) ? acc[i] * d : 0.f); }
                else if (rb >= cb) { AM[ii * 68 + jj] = (jj < ii) ? SC[64 + ii] * acc[i] * d : 0.f; }
            }
        }
    }
    WG_BAR(); ACC_ADD(4);
    if (tid >= 256 && tid < 384) {
        const int c = tid - 256;
#pragma unroll 1
        for (int k8 = 0; k8 < 8; ++k8) {
            float v[8];
#pragma unroll
            for (int e = 0; e < 8; ++e) v[e] = bf2f(*(const LAS unsigned short*)(KNp + (8 * k8 + e) * 272 + c * 2)) * SC[192 + 8 * k8 + e];
            const int m = k8 & 3, pos0 = 32 * (k8 >> 2) + 16 * (m & 1) + 4 * (m >> 1);
            u32x2 w0, w1; w0.x = pk2(v[0], v[1]); w0.y = pk2(v[2], v[3]); w1.x = pk2(v[4], v[5]); w1.y = pk2(v[6], v[7]);
            *(u32x2*)(DK + c * 64 + pos0) = w0; *(u32x2*)(DK + c * 64 + pos0 + 8) = w1;
        }
    }
#pragma unroll 1
    for (int J = 0; J < 4; ++J) {
        if (tid < 256) {
            const int c = tid; LAS float* rj = RHS + c + J * 16 * 256; const LAS float* aj = AM + (J * 16) * 68 + J * 16; const int pc = kperm(c & 127);
            float x[16];
#pragma unroll
            for (int r = 0; r < 16; ++r) x[r] = rj[r * 256];
#pragma unroll
            for (int hf = 0; hf < 2; ++hf) {
                f32x4 ad[8][4];
#pragma unroll
                for (int r8 = 0; r8 < 8; ++r8)
#pragma unroll
                    for (int jb = 0; jb < (8 * hf + r8 + 3) / 4; ++jb) ad[r8][jb] = *(const LAS f32x4*)(aj + (8 * hf + r8) * 68 + 4 * jb);
#pragma unroll
                for (int r8 = 0; r8 < 8; ++r8) {
                    const int r = 8 * hf + r8; f32x2_t a2 = (f32x2_t){x[r], 0.f};
#pragma unroll
                    for (int m = 0; m < r / 2; ++m)
                        a2 -= ((m & 1) ? __builtin_shufflevector(ad[r8][m >> 1], ad[r8][m >> 1], 2, 3) : __builtin_shufflevector(ad[r8][m >> 1], ad[r8][m >> 1], 0, 1)) * (f32x2_t){x[2 * m], x[2 * m + 1]};
                    float acc = a2.x + a2.y;
                    if (r & 1) acc -= ad[r8][(r - 1) >> 2][(r - 1) & 3] * x[r - 1];
                    x[r] = acc;
                }
            }
            if (J < 3) {
#pragma unroll
                for (int r = 0; r < 16; ++r) rj[r * 256] = x[r];
            }
            if (c < 128) {
#pragma unroll
                for (int k8 = 0; k8 < 2; ++k8) { u32x4 w; w.x = pk2(x[8 * k8], x[8 * k8 + 1]); w.y = pk2(x[8 * k8 + 2], x[8 * k8 + 3]); w.z = pk2(x[8 * k8 + 4], x[8 * k8 + 5]); w.w = pk2(x[8 * k8 + 6], x[8 * k8 + 7]);
                    *(u32x4*)(DU + c * 64 + 16 * J + 8 * k8) = w; }
            } else {
#pragma unroll
                for (int r = 0; r < 16; ++r) DW[(16 * J + r) * 128 + pc] = f2bf(x[r]);
            }
        }
        WG_BAR();
        if (J < 3) {
            const int c16 = lane & 15, q = lane >> 4, nblk = (3 - J) * 16;
#pragma unroll 2
            for (int blk = wid; blk < nblk; blk += 8) {
                const int rb = J + 1 + (blk >> 4), cb = blk & 15;
                LAS float* cp = RHS + (16 * rb + 4 * q) * 256 + 16 * cb + c16;
                const LAS float* ap = AM + (16 * rb + c16) * 68 + 16 * J + q;
                const LAS float* bp = RHS + (16 * J + q) * 256 + 16 * cb + c16;
                f32x4 acc = (f32x4){cp[0], cp[256], cp[512], cp[768]};
#pragma unroll
                for (int s4 = 0; s4 < 4; ++s4) acc = __builtin_amdgcn_mfma_f32_16x16x4f32(-ap[4 * s4], bp[4 * s4 * 256], acc, 0, 0, 0);
                cp[0] = acc[0]; cp[256] = acc[1]; cp[512] = acc[2]; cp[768] = acc[3];
            }
            WG_BAR();
        }
    }
    ACC_ADD(5);
}

constexpr int GK_QT = 0, GK_KT = 9216, GK_PS = 18432, GK_LR = 20480;
struct GlaPf { f32x4 lr; unsigned v[8]; unsigned short q[8], k[8]; float wg[16]; float bg; };
__device__ __forceinline__ void gla_pf_load(GlaPf& f, const Args& a, int item, int tid) {
    const int n = item & 127, bh = item >> 7, h = bh & 3, b = bh >> 2, t0 = b * SEQ + n * 64;
    const bf16* P = (const bf16*)(a.ws + WS_HP);
    const float* SMALL = (const float*)(a.ws + WS_SMALL);
    f.lr = *(const f32x4*)(SMALL + (size_t)(t0 + ((tid & 255) >> 2)) * 32 + 8 + (tid & 3) * 4);
    const int dvp = tid & 63, tg = tid >> 6;
#pragma unroll
    for (int j = 0; j < 8; ++j) f.v[j] = *(const unsigned*)(P + (size_t)(t0 + tg * 8 + j) * PW + 2560 + h * 128 + 2 * dvp);
    const int k = tid & 63, rg = tid >> 6;
#pragma unroll
    for (int i = 0; i < 8; ++i) { f.q[i] = P[(size_t)(t0 + rg * 8 + i) * PW + 2048 + h * 64 + k]; f.k[i] = P[(size_t)(t0 + rg * 8 + i) * PW + 2304 + h * 64 + k]; }
#pragma unroll
    for (int j = 0; j < 16; ++j) f.wg[j] = a.in[11][j * 256 + h * 64 + k];
    f.bg = a.in[12][h * 64 + k];
}
__device__ __forceinline__ void gla_prep_item(const Args& a, LAS unsigned char* lds_in, int item, int tid_in, const GlaPf& f) {
    const int tid = opaque_v(tid_in); LAS unsigned char* lds = opaque_v(lds_in);
    const int ci = item;
    const int lane = tid & 63, wid = tid >> 6;
    unsigned char* ws = a.ws;
    unsigned char* os = (unsigned char*)a.out;
    bf16* GQ = (bf16*)(os + OS_GQ) + (size_t)ci * 4096; bf16* GA = (bf16*)(os + OS_GA) + (size_t)ci * 4096; bf16* GK = (bf16*)(os + OS_GK) + (size_t)ci * 4096;
    bf16* GV = (bf16*)(os + OS_GV) + (size_t)ci * 8192; float* GE = (float*)(ws + WS_GE) + (size_t)ci * 64;
    LAS float* PS = (LAS float*)(lds + GK_PS); LAS float* LR = (LAS float*)(lds + GK_LR);
    if (tid < 256) *(LAS f32x4*)(LR + tid * 4) = f.lr;
    {
        const int dvp = tid & 63, tg = tid >> 6;
        u32x4 w0, w1;
#pragma unroll
        for (int m = 0; m < 4; ++m) { w0[m] = (f.v[2 * m] & 0xffffu) | (f.v[2 * m + 1] << 16); w1[m] = (f.v[2 * m] >> 16) | (f.v[2 * m + 1] & 0xffff0000u); }
        *(u32x4*)(GV + (2 * dvp) * 64 + tg * 8) = w0; *(u32x4*)(GV + (2 * dvp + 1) * 64 + tg * 8) = w1;
    }
    WG_BAR();
    const int k = tid & 63, rg = tid >> 6;
    float lg[8];
    {
        float run = 0.f;
#pragma unroll
        for (int i = 0; i < 8; ++i) {
            const int r = rg * 8 + i; float x = f.bg;
#pragma unroll
            for (int j = 0; j < 16; ++j) x += LR[r * 16 + j] * f.wg[j];
            const float ls = fminf(x, 0.f) - __logf(1.0f + __expf(-fabsf(x)));
            run += ls * (1.0f / 16.0f); lg[i] = run;
        }
        PS[rg * 64 + k] = run;
    }
    WG_BAR();
    {
        float off = 0.f, tot = 0.f;
#pragma unroll
        for (int g2 = 0; g2 < 8; ++g2) { const float v = PS[g2 * 64 + k]; if (g2 < rg) off += v; tot += v; }
        float kd[8];
#pragma unroll
        for (int i = 0; i < 8; ++i) {
            const int r = rg * 8 + i; const float bc = lg[i] + off;
            const float qraw = bf2f(f.q[i]), kraw = bf2f(f.k[i]);
            const float qt = qraw * 0.125f * __expf(bc), kt = kraw * __expf(-bc);
            kd[i] = kraw * __expf(tot - bc);
            const unsigned short qb = f2bf(qt);
            *(LAS unsigned short*)(lds + GK_QT + r * 144 + k * 2) = qb; *(LAS unsigned short*)(lds + GK_KT + r * 144 + k * 2) = f2bf(kt);
            GQ[r * 64 + kperm(k)] = qb;
        }
        u32x4 w; w.x = pk2(kd[0], kd[1]); w.y = pk2(kd[2], kd[3]); w.z = pk2(kd[4], kd[5]); w.w = pk2(kd[6], kd[7]);
        *(u32x4*)(GK + k * 64 + rg * 8) = w;
        if (rg == 0) GE[k] = __expf(tot);
    }
    WG_BAR();
    if (wid < 4) {
        const int rb = wid, r = lane & 15, q = lane >> 4;
        f32x4 acc[4];
#pragma unroll
        for (int cb = 0; cb < 4; ++cb) acc[cb] = (f32x4){0.f, 0.f, 0.f, 0.f};
#pragma unroll
        for (int s = 0; s < 2; ++s) {
            const bf16x8 av = *(const LAS bf16x8*)(lds + GK_QT + (16 * rb + r) * 144 + s * 64 + q * 16);
#pragma unroll
            for (int cb = 0; cb < 4; ++cb) { const bf16x8 bv = *(const LAS bf16x8*)(lds + GK_KT + (16 * cb + r) * 144 + s * 64 + q * 16); acc[cb] = MFMA16(av, bv, acc[cb]); }
        }
#pragma unroll
        for (int cb = 0; cb < 4; ++cb)
#pragma unroll
            for (int i = 0; i < 4; ++i) { const int ii = 16 * rb + 4 * q + i, jj = 16 * cb + r; GA[ii * 64 + jj] = f2bf(jj <= ii ? acc[cb][i] : 0.f); }
    }
    WG_BAR();
}

constexpr int SB_W = 0, SB_Q = 17408, SB_K = 34816, SB_QK = 53248, SB_U = 62464, SB_G = 62464 + 16 * 144, SB_BYTES = SB_G + 16;
constexpr int GB_Q = 0, GB_A = 9216, GB_K = 18432, GB_V = 27648, GB_E = 27648 + 64 * 144, GB_BYTES = GB_E + 256;


template <int NPART> __device__ __forceinline__ void gdn_scan(const Args& a, LAS unsigned char* lds_in, int bh, int part, int tid_in) {
    constexpr int CW = 128 / NPART, NCWAVE = 2, NLOAD = 512 - 64 * NCWAVE, NPIECE = 3584 + CW * 8, GDN_KP = (NPIECE + NLOAD - 1) / NLOAD;
    constexpr int X_SB = 2 * SB_BYTES, X_VB = X_SB + 4096;
    static_assert(CW == 16, "GDN stage buffer holds a 16-column U slice");
    const int tid = opaque_v(tid_in); LAS unsigned char* lds = opaque_v(lds_in);
    const int lane = tid & 63, wid = tid >> 6, c = lane & 15, q = lane >> 4, h = bh & 3, b = bh >> 2;
    unsigned char* ws = a.ws; unsigned char* os = (unsigned char*)a.out;
    if (wid >= NCWAVE) {
        const int lt = tid - 64 * NCWAVE;
        const u32x4* src[GDN_KP]; int cst[GDN_KP]; int dst[GDN_KP]; bool ok[GDN_KP];
#pragma unroll
        for (int k = 0; k < GDN_KP; ++k) {
            const int p = lt + k * NLOAD; ok[k] = p < NPIECE; const int pc = ok[k] ? p : 0; const int arr = pc < 3584 ? (pc >> 10) : 4, pp = pc < 3584 ? (pc & 1023) : pc - 3584;
            const unsigned char* base = arr == 0 ? ws + WS_DW : arr == 1 ? ws + WS_DQ : arr == 2 ? ws + WS_DK : arr == 3 ? os + OS_DQK : os + OS_DU;
            cst[k] = arr == 3 ? 512 : 1024;
            src[k] = (const u32x4*)base + (size_t)bh * 128 * cst[k] + pp + (arr == 4 ? part * CW * 8 : 0);
            dst[k] = arr < 2 ? (arr == 0 ? SB_W : SB_Q) + (pp >> 4) * 272 + (pp & 15) * 16 : (arr == 2 ? SB_K : arr == 3 ? SB_QK : SB_U) + (pp >> 3) * 144 + (pp & 7) * 16;
        }
        u32x4 sa[GDN_KP], sb[GDN_KP], sc[GDN_KP], sd[GDN_KP];
        const float* DGLl = (const float*)(ws + WS_DGL) + bh * 128; float gq[4];
#define L_LOAD(set, n) do { const int n_ = (n) < NCHK ? (n) : NCHK - 1; _Pragma("unroll") for (int k = 0; k < GDN_KP; ++k) set[k] = src[k][(size_t)n_ * cst[k]]; gq[GI_##set] = DGLl[n_]; } while (0)
#define L_STORE(set, buf) do { LAS unsigned char* B_ = lds + (buf) * SB_BYTES; _Pragma("unroll") for (int k = 0; k < GDN_KP; ++k) if (ok[k]) *(LAS u32x4*)(B_ + dst[k]) = set[k]; if (lt == 0) *(LAS float*)(B_ + SB_G) = gq[GI_##set]; } while (0)
        enum { GI_sa = 0, GI_sb = 1, GI_sc = 2, GI_sd = 3 };
        L_LOAD(sa, 0); L_STORE(sa, 0); L_LOAD(sa, 1); L_LOAD(sb, 2); L_LOAD(sc, 3); L_LOAD(sd, 4);
        WG_BAR();
        for (int n = 0; n < NCHK; n += 4) {
            L_STORE(sa, 1); L_LOAD(sa, n + 5); WG_BAR(); WG_BAR();
            L_STORE(sb, 0); L_LOAD(sb, n + 6); WG_BAR(); WG_BAR();
            L_STORE(sc, 1); L_LOAD(sc, n + 7); WG_BAR(); WG_BAR();
            L_STORE(sd, 0); L_LOAD(sd, n + 8); WG_BAR(); WG_BAR();
        }
#undef L_LOAD
#undef L_STORE
        return;
    }
    bf16* MIX = (bf16*)(ws + WS_MIX);
    const int dv0 = part * CW + c;
    LAS unsigned char* xsb = lds + X_SB + lane * 16; LAS unsigned char* xvb = lds + X_VB + lane * 16;
    if (wid == 0) {
        f32x4 S[8]; bf16x8 Sb[4];
#pragma unroll
        for (int i = 0; i < 8; ++i) S[i] = (f32x4){0.f, 0.f, 0.f, 0.f};
#pragma unroll
        for (int i = 0; i < 4; ++i) { Sb[i] = (bf16x8){0, 0, 0, 0, 0, 0, 0, 0}; *(LAS bf16x8*)(xsb + i * 1024) = Sb[i]; }
        WG_BAR();
        for (int n = 0; n < NCHK; ++n) {
            const LAS unsigned char* B = lds + (n & 1) * SB_BYTES;
            const float gl = *(const LAS float*)(B + SB_G);
            u32x2 uc[4];
#pragma unroll
            for (int rb = 0; rb < 4; ++rb) uc[rb] = *(const LAS u32x2*)(B + SB_U + c * 144 + (16 * rb + 4 * q) * 2);
            bf16x8 wf[4][4], kf[8][2];
#pragma unroll
            for (int s = 0; s < 4; ++s)
#pragma unroll
                for (int rb = 0; rb < 4; ++rb) wf[s][rb] = *(const LAS bf16x8*)(B + SB_W + (16 * rb + c) * 272 + s * 64 + q * 16);
#pragma unroll
            for (int rb = 0; rb < 8; ++rb)
#pragma unroll
                for (int s = 0; s < 2; ++s) kf[rb][s] = *(const LAS bf16x8*)(B + SB_K + (16 * rb + c) * 144 + s * 64 + q * 16);
            __builtin_amdgcn_sched_barrier(0);
            f32x4 aW[4];
#pragma unroll
            for (int rb = 0; rb < 4; ++rb) aW[rb] = (f32x4){0.f, 0.f, 0.f, 0.f};
#pragma unroll
            for (int s = 0; s < 4; ++s)
#pragma unroll
                for (int rb = 0; rb < 4; ++rb) aW[rb] = MFMA16(wf[s][rb], Sb[s], aW[rb]);
#pragma unroll
            for (int rb = 0; rb < 8; ++rb) S[rb] = S[rb] * gl;
            bf16x8 Vb[2];
            {
                f32x4 vn[4];
#pragma unroll
                for (int rb = 0; rb < 4; ++rb) vn[rb] = (f32x4){bflo(uc[rb].x), bfhi(uc[rb].x), bflo(uc[rb].y), bfhi(uc[rb].y)} - aW[rb];
                Vb[0] = pack8(vn[0], vn[1]); Vb[1] = pack8(vn[2], vn[3]);
            }
            *(LAS bf16x8*)(xvb) = Vb[0]; *(LAS bf16x8*)(xvb + 1024) = Vb[1];
            WG_BAR();
#pragma unroll
            for (int s = 0; s < 2; ++s)
#pragma unroll
                for (int rb = 0; rb < 8; ++rb) S[rb] = MFMA16(kf[rb][s], Vb[s], S[rb]);
#pragma unroll
            for (int s = 0; s < 4; ++s) { Sb[s] = pack8(S[2 * s], S[2 * s + 1]); *(LAS bf16x8*)(xsb + s * 1024) = Sb[s]; }
            WG_BAR();
        }
    } else {
        WG_BAR();
        for (int n = 0; n < NCHK; ++n) {
            const LAS unsigned char* B = lds + (n & 1) * SB_BYTES;
            bf16x8 Sb[4], qf[4][4], gf[2][4];
#pragma unroll
            for (int s = 0; s < 4; ++s) Sb[s] = *(const LAS bf16x8*)(xsb + s * 1024);
#pragma unroll
            for (int s = 0; s < 4; ++s)
#pragma unroll
                for (int rb = 0; rb < 4; ++rb) qf[s][rb] = *(const LAS bf16x8*)(B + SB_Q + (16 * rb + c) * 272 + s * 64 + q * 16);
#pragma unroll
            for (int s = 0; s < 2; ++s)
#pragma unroll
                for (int rb = 0; rb < 4; ++rb) gf[s][rb] = *(const LAS bf16x8*)(B + SB_QK + (16 * rb + c) * 144 + s * 64 + q * 16);
            __builtin_amdgcn_sched_barrier(0);
            f32x4 aO[4];
#pragma unroll
            for (int rb = 0; rb < 4; ++rb) aO[rb] = (f32x4){0.f, 0.f, 0.f, 0.f};
#pragma unroll
            for (int s = 0; s < 4; ++s)
#pragma unroll
                for (int rb = 0; rb < 4; ++rb) aO[rb] = MFMA16(qf[s][rb], Sb[s], aO[rb]);
            WG_BAR();
            bf16x8 Vb[2]; Vb[0] = *(const LAS bf16x8*)(xvb); Vb[1] = *(const LAS bf16x8*)(xvb + 1024);
#pragma unroll
            for (int s = 0; s < 2; ++s)
#pragma unroll
                for (int rb = 0; rb < 4; ++rb) aO[rb] = MFMA16(gf[s][rb], Vb[s], aO[rb]);
            bf16* op = MIX + (size_t)(b * SEQ + n * 64 + 4 * q) * D + h * 128 + dv0;
#pragma unroll
            for (int rb = 0; rb < 4; ++rb)
#pragma unroll
                for (int i = 0; i < 4; ++i) op[(size_t)(16 * rb + i) * D] = f2bf(aO[rb][i]);
            WG_BAR();
        }
    }
}

template <int NPART> __device__ __forceinline__ void gla_scan(const Args& a, LAS unsigned char* lds_in, int bh, int part, int tid_in) {
    constexpr int CW = 128 / NPART, NCWAVE = CW / (16 * NSL), NLOAD = 512 - 64 * NCWAVE, NPIECE = 1536 + CW * 8 + 16, GLA_KP = (NPIECE + NLOAD - 1) / NLOAD;
    static_assert(CW <= 64, "GLA stage buffer holds at most a 64-column V slice");
    const int tid = opaque_v(tid_in); LAS unsigned char* lds = opaque_v(lds_in);
    const int lane = tid & 63, wid = tid >> 6, c = lane & 15, q = lane >> 4, h = bh & 3, b = bh >> 2;
    unsigned char* ws = a.ws; unsigned char* os = (unsigned char*)a.out;
    if (wid >= NCWAVE) {
        const int lt = tid - 64 * NCWAVE;
        const u32x4* src[GLA_KP]; int cst[GLA_KP]; int dst[GLA_KP]; bool ok[GLA_KP];
#pragma unroll
        for (int k = 0; k < GLA_KP; ++k) {
            const int p = lt + k * NLOAD; ok[k] = p < NPIECE; const int pc = ok[k] ? p : 0;
            const int arr = pc < 1536 ? (pc >> 9) : (pc < 1536 + CW * 8 ? 3 : 4), pp = pc < 1536 ? (pc & 511) : (arr == 3 ? pc - 1536 : pc - 1536 - CW * 8);
            const unsigned char* base = arr == 0 ? os + OS_GQ : arr == 1 ? os + OS_GA : arr == 2 ? os + OS_GK : arr == 3 ? os + OS_GV : ws + WS_GE;
            cst[k] = arr < 3 ? 512 : arr == 3 ? 1024 : 16;
            src[k] = (const u32x4*)base + (size_t)bh * 128 * cst[k] + pp + (arr == 3 ? part * CW * 8 : 0);
            dst[k] = arr == 4 ? GB_E + pp * 16 : (arr == 0 ? GB_Q : arr == 1 ? GB_A : arr == 2 ? GB_K : GB_V) + (pp >> 3) * 144 + (pp & 7) * 16;
        }
        u32x4 sa[GLA_KP], sb[GLA_KP], sc[GLA_KP], sd[GLA_KP];
#define L_LOAD(set, n) do { const int n_ = (n) < NCHK ? (n) : NCHK - 1; _Pragma("unroll") for (int k = 0; k < GLA_KP; ++k) set[k] = src[k][(size_t)n_ * cst[k]]; } while (0)
#define L_STORE(set, buf) do { LAS unsigned char* B_ = lds + (buf) * GB_BYTES; _Pragma("unroll") for (int k = 0; k < GLA_KP; ++k) if (ok[k]) *(LAS u32x4*)(B_ + dst[k]) = set[k]; } while (0)
        L_LOAD(sa, 0); L_STORE(sa, 0); L_LOAD(sa, 1); L_LOAD(sb, 2); L_LOAD(sc, 3); L_LOAD(sd, 4);
        WG_BAR();
        for (int n = 0; n < NCHK; n += 4) {
            L_STORE(sa, 1); L_LOAD(sa, n + 5); WG_BAR();
            L_STORE(sb, 0); L_LOAD(sb, n + 6); WG_BAR();
            L_STORE(sc, 1); L_LOAD(sc, n + 7); WG_BAR();
            L_STORE(sd, 0); L_LOAD(sd, n + 8); WG_BAR();
        }
#undef L_LOAD
#undef L_STORE
        return;
    }
    bf16* MIX = (bf16*)(ws + WS_MIX);
    const int dv0 = part * CW + 16 * NSL * wid + c;
    f32x4 S[NSL][4]; bf16x8 Sb[NSL][2];
#pragma unroll
    for (int sl = 0; sl < NSL; ++sl) {
#pragma unroll
        for (int i = 0; i < 4; ++i) S[sl][i] = (f32x4){0.f, 0.f, 0.f, 0.f};
#pragma unroll
        for (int i = 0; i < 2; ++i) Sb[sl][i] = (bf16x8){0, 0, 0, 0, 0, 0, 0, 0};
    }
    WG_BAR();
    for (int n = 0; n < NCHK; ++n) {
        const LAS unsigned char* B = lds + (n & 1) * GB_BYTES;
        bf16x8 Vb[NSL][2]; f32x4 eb[4];
#pragma unroll
        for (int sl = 0; sl < NSL; ++sl)
#pragma unroll
            for (int s = 0; s < 2; ++s) Vb[sl][s] = *(const LAS bf16x8*)(B + GB_V + (16 * (NSL * wid + sl) + c) * 144 + (32 * s + 8 * q) * 2);
#pragma unroll
        for (int rb = 0; rb < 4; ++rb) eb[rb] = *(const LAS f32x4*)(B + GB_E + (16 * rb + 4 * q) * 4);
        f32x4 aO[NSL][4];
#pragma unroll
        for (int sl = 0; sl < NSL; ++sl)
#pragma unroll
            for (int rb = 0; rb < 4; ++rb) aO[sl][rb] = (f32x4){0.f, 0.f, 0.f, 0.f};
#pragma unroll
        for (int s = 0; s < 2; ++s)
#pragma unroll
            for (int rb = 0; rb < 4; ++rb) {
                const bf16x8 qv = *(const LAS bf16x8*)(B + GB_Q + (16 * rb + c) * 144 + s * 64 + q * 16);
                const bf16x8 av = *(const LAS bf16x8*)(B + GB_A + (16 * rb + c) * 144 + s * 64 + q * 16);
#pragma unroll
                for (int sl = 0; sl < NSL; ++sl) { aO[sl][rb] = MFMA16(qv, Sb[sl][s], aO[sl][rb]); aO[sl][rb] = MFMA16(av, Vb[sl][s], aO[sl][rb]); }
            }
#pragma unroll
        for (int rb = 0; rb < 4; ++rb) {
#pragma unroll
            for (int sl = 0; sl < NSL; ++sl) S[sl][rb] = S[sl][rb] * eb[rb];
#pragma unroll
            for (int s = 0; s < 2; ++s) {
                const bf16x8 kv = *(const LAS bf16x8*)(B + GB_K + (16 * rb + c) * 144 + s * 64 + q * 16);
#pragma unroll
                for (int sl = 0; sl < NSL; ++sl) S[sl][rb] = MFMA16(kv, Vb[sl][s], S[sl][rb]);
            }
        }
#pragma unroll
        for (int sl = 0; sl < NSL; ++sl) {
#pragma unroll
            for (int s = 0; s < 2; ++s) Sb[sl][s] = pack8(S[sl][2 * s], S[sl][2 * s + 1]);
            bf16* op = MIX + (size_t)(b * SEQ + n * 64 + 4 * q) * D + 512 + h * 128 + dv0 + 16 * sl;
#pragma unroll
            for (int rb = 0; rb < 4; ++rb)
#pragma unroll
                for (int i = 0; i < 4; ++i) op[(size_t)(16 * rb + i) * D] = f2bf(aO[sl][rb][i]);
        }
        WG_BAR();
    }
}

__global__ void __launch_bounds__(512, 2) fwd_kernel(Args a) {
    extern __shared__ __attribute__((aligned(16))) unsigned char lds_raw[];
    LAS unsigned char* lds = (LAS unsigned char*)lds_raw;
    const int tid = threadIdx.x, lane = tid & 63, wave = __builtin_amdgcn_readfirstlane(tid >> 6);
    const int G = gridDim.x, bx = blockIdx.x;
    const int vcu = (G % 8 == 0) ? (bx % 8) * (G / 8) + bx / 8 : bx;
    const int gw = vcu * 8 + wave, NGW = G * 8;
    unsigned char* ws = a.ws;
    const int lo = a.ph_lo, hi = a.ph_hi;
    volatile LAS unsigned* bst = (volatile LAS unsigned*)(lds + LDS_BYTES - 64);
    if (tid < 2) bst[tid] = 0u;
    __syncthreads();
    XcdBarrier bar; bar.bar = (unsigned*)ws; bar.x = 0; bar.st = bst;
    if (a.coop == 1) bar = xcd_barrier_post((unsigned*)ws, bst);
#define IN(k) (lo <= (k) && (k) < hi)
#define REPEAT(k) _Pragma("unroll 1") for (int rep_ = 0; rep_ < ((k) == XREP_PHASE ? a.pad : 1); ++rep_)
#ifndef PROBE_MASK
#define PROBE_MASK 0
#define PROBE_DIV 10
#endif
    unsigned long long* TS = (unsigned long long*)(ws + 32768);
    if (PROBE_MASK && bx == 0 && tid == 0) { TS[0] = __builtin_amdgcn_s_memrealtime(); for (int k = 0; k < 16; ++k) TS[32 + k] = 0; }
#define STAMP(k) do { if (PROBE_MASK && bx == 0 && tid == 0) TS[(k) + 1] = __builtin_amdgcn_s_memrealtime(); } while (0)
#define SEAM(k) do { if (IN(k) && IN((k) + 1)) { if (a.coop == 1) xcd_barrier(bar); else if (a.coop == 2) cg::this_grid().sync(); } STAMP(k); } while (0)
    bf16* XB = (bf16*)(ws + WS_XB); bf16* HB = (bf16*)(ws + WS_HP); bf16* MIX = (bf16*)(ws + WS_MIX);
    float* SMALL = (float*)(ws + WS_SMALL);

    if (IN(0)) REPEAT(0) { prologue(a, lds, gw, NGW, wave, lane, 0); } SEAM(0);
    if (IN(1)) REPEAT(1) {
        pg8::Gemm g{XB, (const bf16*)(ws + WS_WGU1), M, NGU, D}; pg8::StaticOrder S; S.init(M, NGU, G, bx);
        pg8::EpiSwiglu E{HB, FF};
        pg8::gemm_phase<pg8::EpiSwiglu, pg8::StaticOrder, true, true>(lds, g, S, E);
    } SEAM(1);
    if (IN(2)) REPEAT(2) {
        pg8::Gemm g{HB, (const bf16*)(ws + WS_WD1), M, D, FF}; pg8::StaticOrder S; S.init(M, D, G, bx);
        pg8::EpiRes<false> E{a.in[0], (bf16*)a.out, ALPHA, 0.5f};
        pg8::gemm_phase<pg8::EpiRes<false>, pg8::StaticOrder, true, true>(lds, g, S, E);
    } SEAM(2);
    if (IN(3)) REPEAT(3) { ln_phase((const bf16*)a.out, nullptr, XB, a.in[4], a.in[5], gw, NGW, lane); } SEAM(3);
    if (IN(4)) REPEAT(4) {
        pg8::Gemm g{XB, (const bf16*)(ws + WS_WIN), M, NPROJ, D}; pg8::StaticOrder S; S.init(M, NPROJ, G, bx);
        pg8::EpiProj E{HB, SMALL};
        pg8::gemm_phase<pg8::EpiProj, pg8::StaticOrder, true, true>(lds, g, S, E);
    } SEAM(4);
    if (IN(5)) REPEAT(5) {
        {
            GdnPf pf; int it = bx; if (it < NCH) gdn_pf_load(pf, a, it, tid);
            ACC_T0();
#pragma unroll 1
            for (; it < NCH; it += G) { const GdnPf cur = pf; if (it + G < NCH) gdn_pf_load(pf, a, it + G, tid); gdn_prep_item(a, lds, it, tid, cur); }
            ACC_ADD(0);
        }
        {
            GlaPf pf; int it = bx; if (it < NCH) gla_pf_load(pf, a, it, tid);
            ACC_T0();
#pragma unroll 1
            for (; it < NCH; it += G) { const GlaPf cur = pf; if (it + G < NCH) gla_pf_load(pf, a, it + G, tid); gla_prep_item(a, lds, it, tid, cur); }
            ACC_ADD(1);
        }
    } SEAM(5);
    if (IN(6)) REPEAT(6) {
        const int xcd = bx & 7, slot = bx >> 3;
        constexpr int NSCAN = 2 * NP_GDN + 2 * NP_GLA;
        if (slot < 2 * NP_GDN) { ACC_T0(); gdn_scan<NP_GDN>(a, lds, xcd * 2 + slot / NP_GDN, slot % NP_GDN, tid); ACC_ADD(6); }
        else if (slot < NSCAN) { const int s2 = slot - 2 * NP_GDN; gla_scan<NP_GLA>(a, lds, xcd * 2 + s2 / NP_GLA, s2 % NP_GLA, tid); }
        else {
            const int nidle = G - 8 * NSCAN, idx = (slot - NSCAN) * 8 + xcd;
            prologue(a, lds, idx * 8 + wave, nidle * 8, wave, lane, 1);
        }
    } SEAM(6);
    if (IN(7)) { gnorm_phase(MIX, HB, a.in[10], a.in[13], gw, NGW, lane); } SEAM(7);
    if (IN(8)) REPEAT(8) {
        pg8::Gemm g{MIX, (const bf16*)(ws + WS_WOUT), M, D, D}; pg8::StaticOrder S; S.init(M, D, G, bx);
        pg8::EpiRes<true> E{XB, (bf16*)a.out, ALPHA, 1.0f};
        pg8::gemm_phase<pg8::EpiRes<true>, pg8::StaticOrder, true, true>(lds, g, S, E);
    } SEAM(8);
    if (IN(9)) { ln_phase((const bf16*)a.out, nullptr, XB, a.in[15], a.in[16], gw, NGW, lane); } SEAM(9);
    if (IN(10)) {
        pg8::Gemm g{XB, (const bf16*)(ws + WS_WGU2), M, NGU, D}; pg8::StaticOrder S; S.init(M, NGU, G, bx);
        pg8::EpiSwiglu E{HB, FF};
        pg8::gemm_phase<pg8::EpiSwiglu, pg8::StaticOrder, true, true>(lds, g, S, E);
    } SEAM(10);
    if (IN(11)) {
        pg8::Gemm g{HB, (const bf16*)(ws + WS_WD2), M, D, FF}; pg8::StaticOrder S; S.init(M, D, G, bx);
        pg8::EpiRes<true> E{XB, MIX, ALPHA, 0.5f};
        pg8::gemm_phase<pg8::EpiRes<true>, pg8::StaticOrder, true, true>(lds, g, S, E);
    } SEAM(11);
    if (IN(12)) { ln_phase(MIX, a.out, nullptr, a.in[20], a.in[21], gw, NGW, lane); }
    if (a.coop == 1) for (int i_ = 0; i_ < XREP_SYNC; ++i_) xcd_barrier(bar);
    if (PROBE_MASK && bx == 0) {
        asm volatile("s_waitcnt vmcnt(0)" ::: "memory"); __syncthreads();
        if (tid == 0) TS[13] = __builtin_amdgcn_s_memrealtime();
        __syncthreads();
        unsigned long long tot = 0;
        for (int k = 0; k < 13; ++k) if ((PROBE_MASK >> k) & 1) tot += __hip_atomic_load(&TS[k + 1], __ATOMIC_RELAXED, __HIP_MEMORY_SCOPE_AGENT) - __hip_atomic_load(&TS[k], __ATOMIC_RELAXED, __HIP_MEMORY_SCOPE_AGENT);
        for (int k = 0; k < 16; ++k) if ((PROBE_MASK >> (13 + k)) & 1) tot += __hip_atomic_load(&TS[32 + k], __ATOMIC_RELAXED, __HIP_MEMORY_SCOPE_AGENT);
        int T = (int)(tot / PROBE_DIV); if (T > 8192) T = 8192;
        for (int i = tid; i < T; i += 512) a.out[i] += 0.1f;
    }
#undef IN
#undef SEAM
}

constexpr int NPHASE = 13;
#ifndef MK_MULTI
#define MK_MULTI 0
#endif
extern "C" void kernel_launch(void* const* d_in, const int* in_sizes, int n_in, void* d_out, int out_size, void* d_ws, size_t ws_size, hipStream_t stream) {
    static int grid = 0;
    if (grid == 0) {
        if (n_in != 22 || out_size != M * D || ws_size < WS_END) { fprintf(stderr, "kernel_launch: unexpected shapes (n_in %d out %d ws %zu)\n", n_in, out_size, ws_size); grid = -1; return; }
        int dev = 0, cus = 0, per_cu = 0;
        hipGetDevice(&dev); hipDeviceGetAttribute(&cus, hipDeviceAttributeMultiprocessorCount, dev);
        if (hipFuncSetAttribute((const void*)fwd_kernel, hipFuncAttributeMaxDynamicSharedMemorySize, LDS_BYTES) != hipSuccess) { fprintf(stderr, "kernel_launch: hipFuncSetAttribute failed\n"); grid = -1; return; }
        hipOccupancyMaxActiveBlocksPerMultiprocessor(&per_cu, (const void*)fwd_kernel, 512, LDS_BYTES);
        (void)hipGetLastError();
        if (per_cu < 1) per_cu = 1;
        grid = cus * 1;
        fprintf(stderr, "kernel_launch: cus %d per_cu %d grid %d\n", cus, per_cu, grid);
    }
    if (grid < 0) return;
    Args a{};
    for (int i = 0; i < 22; ++i) a.in[i] = (const float*)d_in[i];
    a.out = (float*)d_out; a.ws = (unsigned char*)d_ws; a.pad = XREP_N;
#if MK_MULTI
    for (int p = 0; p < NPHASE; ++p) { a.ph_lo = p; a.ph_hi = p + 1; a.coop = 0; hipLaunchKernelGGL(fwd_kernel, dim3(grid), dim3(512), LDS_BYTES, stream, a); }
#else
    if (hipMemsetAsync(d_ws, 0, 65536, stream) != hipSuccess) { fprintf(stderr, "kernel_launch: memset failed\n"); return; }
    a.ph_lo = 0; a.ph_hi = NPHASE; a.coop = 1;
    void* args[] = {&a};
    hipError_t e = hipLaunchCooperativeKernel((const void*)fwd_kernel, dim3(grid), dim3(512), args, LDS_BYTES, stream);
    if (e != hipSuccess) fprintf(stderr, "cooperative launch failed: %s (grid %d)\n", hipGetErrorString(e), grid);
#endif
}
```
